# Optimizing an MI355X kernel written in HIP

```python
import math
import jax, jax.numpy as jnp
from jax import lax
import numpy as np

D_MODEL = 4096
BATCH = 8
SEQ = 2048
DEPTH = 2
DEC_BATCH = 8
DEC_SEQ = 64
PAST_LEN = 2048

CHUNK = 64
Q_BLOCK = 128
EPS = 1e-6

MLA_HEADS = 16
Q_LORA = 1024
KV_LORA = 512
NOPE_DIM = 128
ROPE_DIM = 64
V_DIM = 128
MLA_WIDTH = MLA_HEADS * V_DIM
ROPE_BASE = 10000.0
MLA_SCALE = (NOPE_DIM + ROPE_DIM) ** -0.5

SSM_HEADS = 32
SSM_HEADDIM = 64
SSM_INNER = SSM_HEADS * SSM_HEADDIM
SSM_GROUPS = 8
D_STATE = 128
CONV_W = 4
CONV_DIM = SSM_INNER + 2 * SSM_GROUPS * D_STATE
SSD_BLOCK = CHUNK

MIX_WIDTH = MLA_WIDTH + SSM_INNER
OFF_CKV = Q_LORA
OFF_KPE = OFF_CKV + KV_LORA
OFF_Z = OFF_KPE + ROPE_DIM
OFF_XBC = OFF_Z + SSM_INNER
OFF_DT = OFF_XBC + CONV_DIM
IN_WIDTH = OFF_DT + SSM_HEADS

N_MEM = 256
XA_HEADS = 4
XA_HEAD_DIM = 128
XA_WIDTH = XA_HEADS * XA_HEAD_DIM
XA_SCALE = XA_HEAD_DIM ** -0.5

D_FF = -(-8 * D_MODEL // (3 * 256)) * 256

kernel_name = "hybrid_mla_ssd_streaming_step"


def rms_norm(x, g):
    xf = x.astype(jnp.float32)
    y = xf * lax.rsqrt(jnp.mean(xf * xf, axis=-1, keepdims=True) + EPS)
    return (y * g.astype(jnp.float32)).astype(x.dtype)


def rope(x, pos):
    half = ROPE_DIM // 2
    inv = ROPE_BASE ** (-jnp.arange(half, dtype=jnp.float32) / half)
    ang = pos.astype(jnp.float32)[:, None] * inv[None, :]
    ang = ang.reshape(ang.shape[:1] + (1,) * (x.ndim - 3) + (half,))
    cos, sin = jnp.cos(ang), jnp.sin(ang)
    xf = x.astype(jnp.float32)
    x1, x2 = xf[..., :half], xf[..., half:]
    return jnp.concatenate([x1 * cos - x2 * sin, x1 * sin + x2 * cos], -1).astype(x.dtype)


def chunk_causal_attention(q, k, v, q_pos, k_pos, scale):
    Bsz, Sq, H, Dk = q.shape
    blk = min(Q_BLOCK, Sq)
    nb = Sq // blk
    qb = q.reshape(Bsz, nb, blk, H, Dk).transpose(1, 0, 2, 3, 4)
    pb = q_pos.reshape(nb, blk)
    k_chunk = k_pos // CHUNK

    def one_block(args):
        qi, pi = args
        s = jnp.einsum('bqhd,bkhd->bhqk', qi, k, preferred_element_type=jnp.float32) * scale
        mask = k_chunk[None, :] <= (pi // CHUNK)[:, None]
        s = jnp.where(mask[None, None], s, -jnp.inf)
        p = jax.nn.softmax(s, axis=-1).astype(v.dtype)
        return jnp.einsum('bhqk,bkhd->bqhd', p, v)

    out = lax.map(one_block, (qb, pb))
    return out.transpose(1, 0, 2, 3, 4).reshape(Bsz, Sq, H, v.shape[-1])


def ssd_scan(x, dt, A, Bm, Cm, h0):
    f32 = jnp.float32
    Bsz, L, H, P = x.shape
    G, N = Bm.shape[2], Bm.shape[3]
    R = H // G
    Q = min(SSD_BLOCK, L)
    C = L // Q
    xdt = (x.astype(f32) * dt[..., None]).reshape(Bsz, C, Q, G, R, P)
    a_cum = jnp.cumsum((dt * A).reshape(Bsz, C, Q, G, R), axis=2)
    Bc = Bm.astype(f32).reshape(Bsz, C, Q, G, N)
    Cc = Cm.astype(f32).reshape(Bsz, C, Q, G, N)
    seg = a_cum[:, :, :, None] - a_cum[:, :, None, :]
    causal = jnp.tril(jnp.ones((Q, Q), dtype=bool))
    decay = jnp.exp(jnp.where(causal[None, None, :, :, None, None], seg, -jnp.inf))
    cb = jnp.einsum('bcign,bcjgn->bcijg', Cc, Bc)
    y_diag = jnp.einsum('bcijg,bcijgr,bcjgrp->bcigrp', cb, decay, xdt)
    decay_end = jnp.exp(a_cum[:, :, -1:] - a_cum)
    states = jnp.einsum('bcjgn,bcjgr,bcjgrp->bcgrpn', Bc, decay_end, xdt)
    block_decay = jnp.exp(a_cum[:, :, -1])

    def step(h, inp):
        s, d = inp
        return d[..., None, None] * h + s, h

    h_init = h0.astype(f32).reshape(Bsz, G, R, P, N)
    h_final, h_in = lax.scan(step, h_init, (states.transpose(1, 0, 2, 3, 4, 5), block_decay.transpose(1, 0, 2, 3)))
    h_in = h_in.transpose(1, 0, 2, 3, 4, 5)
    y_off = jnp.einsum('bcign,bcigr,bcgrpn->bcigrp', Cc, jnp.exp(a_cum), h_in)
    y = (y_diag + y_off).reshape(Bsz, L, H, P)
    return y.astype(x.dtype), h_final.reshape(Bsz, H, P, N).astype(h0.dtype)


def token_mixer(h, pos, ckv_past, kpe_past, conv_past, ssm_past, lp):
    Bsz, L, _ = h.shape
    proj = h @ lp['w_in']
    c_q, c_kv, k_pe, z, xbc, dt = jnp.split(proj, [OFF_CKV, OFF_KPE, OFF_Z, OFF_XBC, OFF_DT], axis=-1)

    q = (rms_norm(c_q, lp['q_norm']) @ lp['w_uq']).reshape(Bsz, L, MLA_HEADS, NOPE_DIM + ROPE_DIM)
    q = jnp.concatenate([rms_norm(q[..., :NOPE_DIM], lp['qn_nope']),
                         rope(rms_norm(q[..., NOPE_DIM:], lp['qn_pe']), pos)], axis=-1)
    ckv_new = rms_norm(c_kv, lp['kv_norm'])
    kpe_new = rope(rms_norm(k_pe, lp['kn_pe']), pos)
    ckv_all = jnp.concatenate([ckv_past, ckv_new], axis=1)
    kpe_all = jnp.concatenate([kpe_past, kpe_new], axis=1)
    Sk = ckv_all.shape[1]
    kv = (ckv_all @ lp['w_ukv']).reshape(Bsz, Sk, MLA_HEADS, NOPE_DIM + V_DIM)
    k = jnp.concatenate([rms_norm(kv[..., :NOPE_DIM], lp['kn_nope']),
                         jnp.broadcast_to(kpe_all[:, :, None, :], (Bsz, Sk, MLA_HEADS, ROPE_DIM))], axis=-1)
    k_pos = jnp.concatenate([jnp.arange(Sk - L, dtype=jnp.int32), pos])
    attn = chunk_causal_attention(q, k, kv[..., NOPE_DIM:], pos, k_pos, MLA_SCALE).reshape(Bsz, L, MLA_WIDTH)

    xbc_all = jnp.concatenate([conv_past, xbc], axis=1)
    conv_new = xbc_all[:, -(CONV_W - 1):]
    conv = sum((xbc_all[:, i:i + L] * lp['conv_w'][i] for i in range(CONV_W)), lp['conv_b'])
    xbc_c = jax.nn.silu(conv)
    xs, Bm, Cm = jnp.split(xbc_c, [SSM_INNER, SSM_INNER + SSM_GROUPS * D_STATE], axis=-1)
    dt = jax.nn.softplus(dt.astype(jnp.float32) + lp['dt_bias'].astype(jnp.float32))
    A = -jnp.exp(lp['a_log'].astype(jnp.float32))
    xs_h = xs.reshape(Bsz, L, SSM_HEADS, SSM_HEADDIM)
    y, ssm_new = ssd_scan(xs_h, dt, A,
                          Bm.reshape(Bsz, L, SSM_GROUPS, D_STATE),
                          Cm.reshape(Bsz, L, SSM_GROUPS, D_STATE), ssm_past)
    y = (y + lp['d_skip'][:, None] * xs_h).reshape(Bsz, L, SSM_INNER) * jax.nn.silu(z)
    y = rms_norm(y.reshape(Bsz, L, SSM_GROUPS, SSM_INNER // SSM_GROUPS),
                 lp['ssm_norm'].reshape(SSM_GROUPS, -1)).reshape(Bsz, L, SSM_INNER)

    out = jnp.concatenate([attn, y], axis=-1) @ lp['w_o']
    return out, ckv_new, kpe_new, conv_new, ssm_new


def memory_kv(mem, lp):
    Bsz, M, _ = mem.shape
    mn = rms_norm(mem, lp['mem_norm'])
    k = rms_norm((mn @ lp['w_xk']).reshape(Bsz, M, XA_HEADS, XA_HEAD_DIM), lp['xa_norm_k'])
    v = (mn @ lp['w_xv']).reshape(Bsz, M, XA_HEADS, XA_HEAD_DIM)
    return k, v


def cross_attention(h, mem_k, mem_v, lp):
    Bsz, L, _ = h.shape
    q = rms_norm((h @ lp['w_xq']).reshape(Bsz, L, XA_HEADS, XA_HEAD_DIM), lp['xa_norm_q'])
    s = jnp.einsum('blhd,bmhd->bhlm', q, mem_k, preferred_element_type=jnp.float32) * XA_SCALE
    p = jax.nn.softmax(s, axis=-1).astype(mem_v.dtype)
    o = jnp.einsum('bhlm,bmhd->blhd', p, mem_v).reshape(Bsz, L, XA_WIDTH)
    return o @ lp['w_xo']


def swiglu(h, lp):
    return (jax.nn.silu(h @ lp['w_gate']) * (h @ lp['w_up'])) @ lp['w_down']


def block(x, pos, ckv_past, kpe_past, conv_past, ssm_past, mem_k, mem_v, lp):
    mix, ckv_new, kpe_new, conv_new, ssm_new = token_mixer(
        rms_norm(x, lp['norm_mix']), pos, ckv_past, kpe_past, conv_past, ssm_past, lp)
    x = x + mix
    x = x + cross_attention(rms_norm(x, lp['norm_xa']), mem_k, mem_v, lp)
    x = x + swiglu(rms_norm(x, lp['norm_ffn']), lp)
    return x, ckv_new, kpe_new, conv_new, ssm_new


def setup_inputs(seed: int = 0) -> dict:
    key = jax.random.key(seed)
    keys = jax.random.split(key, 64)
    counter = [0]
    f32 = jnp.float32

    def nk():
        k = keys[counter[0]]
        counter[0] += 1
        return k

    def nrm(shape, scale=1.0):
        return jax.random.normal(nk(), shape, f32) * scale

    def gain(shape):
        return 1.0 + 0.02 * jax.random.normal(nk(), shape, f32)

    Lz = DEPTH
    inp = {}
    inp['x_prompt'] = nrm((BATCH, SEQ, D_MODEL))
    inp['x_sample'] = nrm((DEC_BATCH, DEC_SEQ, D_MODEL))
    inp['mem_prompt'] = nrm((BATCH, N_MEM, D_MODEL))
    inp['cache_ckv'] = nrm((Lz, DEC_BATCH, PAST_LEN, KV_LORA))
    inp['cache_kpe'] = nrm((Lz, DEC_BATCH, PAST_LEN, ROPE_DIM))
    inp['state_conv'] = nrm((Lz, DEC_BATCH, CONV_W - 1, CONV_DIM))
    inp['state_ssm'] = nrm((Lz, DEC_BATCH, SSM_HEADS, SSM_HEADDIM, D_STATE), 0.5)
    inp['cache_mem_k'] = nrm((Lz, DEC_BATCH, N_MEM, XA_HEADS, XA_HEAD_DIM))
    inp['cache_mem_v'] = nrm((Lz, DEC_BATCH, N_MEM, XA_HEADS, XA_HEAD_DIM))
    inp['norm_mix'] = gain((Lz, D_MODEL))
    inp['w_in'] = nrm((Lz, D_MODEL, IN_WIDTH), D_MODEL ** -0.5)
    inp['q_norm'] = gain((Lz, Q_LORA))
    inp['w_uq'] = nrm((Lz, Q_LORA, MLA_HEADS * (NOPE_DIM + ROPE_DIM)), Q_LORA ** -0.5)
    inp['kv_norm'] = gain((Lz, KV_LORA))
    inp['w_ukv'] = nrm((Lz, KV_LORA, MLA_HEADS * (NOPE_DIM + V_DIM)), KV_LORA ** -0.5)
    inp['qn_nope'] = gain((Lz, NOPE_DIM))
    inp['qn_pe'] = gain((Lz, ROPE_DIM))
    inp['kn_nope'] = gain((Lz, NOPE_DIM))
    inp['kn_pe'] = gain((Lz, ROPE_DIM))
    inp['conv_w'] = nrm((Lz, CONV_W, CONV_DIM), CONV_W ** -0.5)
    inp['conv_b'] = nrm((Lz, CONV_DIM), 0.02)
    dt0 = jnp.exp(jax.random.uniform(nk(), (Lz, SSM_HEADS), f32, math.log(1e-3), math.log(1e-1)))
    inp['dt_bias'] = dt0 + jnp.log(-jnp.expm1(-dt0))
    inp['a_log'] = jnp.log(jax.random.uniform(nk(), (Lz, SSM_HEADS), f32, 1.0, 16.0))
    inp['d_skip'] = gain((Lz, SSM_HEADS))
    inp['ssm_norm'] = gain((Lz, SSM_INNER))
    inp['w_o'] = nrm((Lz, MIX_WIDTH, D_MODEL), MIX_WIDTH ** -0.5)
    inp['norm_xa'] = gain((Lz, D_MODEL))
    inp['mem_norm'] = gain((Lz, D_MODEL))
    inp['w_xq'] = nrm((Lz, D_MODEL, XA_WIDTH), D_MODEL ** -0.5)
    inp['w_xk'] = nrm((Lz, D_MODEL, XA_WIDTH), D_MODEL ** -0.5)
    inp['w_xv'] = nrm((Lz, D_MODEL, XA_WIDTH), D_MODEL ** -0.5)
    inp['xa_norm_q'] = gain((Lz, XA_HEAD_DIM))
    inp['xa_norm_k'] = gain((Lz, XA_HEAD_DIM))
    inp['w_xo'] = nrm((Lz, XA_WIDTH, D_MODEL), XA_WIDTH ** -0.5)
    inp['norm_ffn'] = gain((Lz, D_MODEL))
    inp['w_gate'] = nrm((Lz, D_MODEL, D_FF), D_MODEL ** -0.5)
    inp['w_up'] = nrm((Lz, D_MODEL, D_FF), D_MODEL ** -0.5)
    inp['w_down'] = nrm((Lz, D_FF, D_MODEL), D_FF ** -0.5)
    return inp


def reference(x_prompt, x_sample, mem_prompt, cache_ckv, cache_kpe, state_conv, state_ssm,
              cache_mem_k, cache_mem_v,
              norm_mix, w_in, q_norm, w_uq, kv_norm, w_ukv, qn_nope, qn_pe, kn_nope, kn_pe,
              conv_w, conv_b, dt_bias, a_log, d_skip, ssm_norm, w_o,
              norm_xa, mem_norm, w_xq, w_xk, w_xv, xa_norm_q, xa_norm_k, w_xo,
              norm_ffn, w_gate, w_up, w_down):
    Bp, S, _ = x_prompt.shape
    Bs, L, _ = x_sample.shape
    past = cache_ckv.shape[2]
    dtype = x_prompt.dtype
    pos_p = jnp.arange(S, dtype=jnp.int32)
    pos_s = past + jnp.arange(L, dtype=jnp.int32)
    ckv0 = jnp.zeros((Bp, 0, KV_LORA), dtype)
    kpe0 = jnp.zeros((Bp, 0, ROPE_DIM), dtype)
    conv0 = jnp.zeros((Bp, CONV_W - 1, CONV_DIM), dtype)
    ssm0 = jnp.zeros((Bp, SSM_HEADS, SSM_HEADDIM, D_STATE), dtype)

    hp, hs = x_prompt, x_sample
    ckv_p, kpe_p, conv_p, ssm_p, mk_p, mv_p = [], [], [], [], [], []
    ckv_s, kpe_s, conv_s, ssm_s = [], [], [], []
    for l in range(DEPTH):
        lp = dict(norm_mix=norm_mix[l], w_in=w_in[l], q_norm=q_norm[l], w_uq=w_uq[l],
                  kv_norm=kv_norm[l], w_ukv=w_ukv[l], qn_nope=qn_nope[l], qn_pe=qn_pe[l],
                  kn_nope=kn_nope[l], kn_pe=kn_pe[l], conv_w=conv_w[l], conv_b=conv_b[l],
                  dt_bias=dt_bias[l], a_log=a_log[l], d_skip=d_skip[l], ssm_norm=ssm_norm[l],
                  w_o=w_o[l], norm_xa=norm_xa[l], mem_norm=mem_norm[l], w_xq=w_xq[l],
                  w_xk=w_xk[l], w_xv=w_xv[l], xa_norm_q=xa_norm_q[l], xa_norm_k=xa_norm_k[l],
                  w_xo=w_xo[l], norm_ffn=norm_ffn[l], w_gate=w_gate[l], w_up=w_up[l],
                  w_down=w_down[l])
        mk, mv = memory_kv(mem_prompt, lp)
        hp, a, b, c, d = block(hp, pos_p, ckv0, kpe0, conv0, ssm0, mk, mv, lp)
        ckv_p.append(a); kpe_p.append(b); conv_p.append(c); ssm_p.append(d)
        mk_p.append(mk); mv_p.append(mv)
        hs, a, b, c, d = block(hs, pos_s, cache_ckv[l], cache_kpe[l], state_conv[l], state_ssm[l],
                               cache_mem_k[l], cache_mem_v[l], lp)
        ckv_s.append(a); kpe_s.append(b); conv_s.append(c); ssm_s.append(d)

    return (hp, hs,
            jnp.stack(ckv_p), jnp.stack(kpe_p), jnp.stack(conv_p), jnp.stack(ssm_p),
            jnp.stack(mk_p), jnp.stack(mv_p),
            jnp.stack(ckv_s), jnp.stack(kpe_s), jnp.stack(conv_s), jnp.stack(ssm_s))
```

```cpp
#include <hip/hip_runtime.h>
#include <cstdio>
#include <cstdint>

#define LAS __attribute__((address_space(3)))
#define GAS __attribute__((address_space(1)))
#define DI __device__ __forceinline__

namespace pg8 {
#define PG8_LAS __attribute__((address_space(3)))
typedef unsigned short bf16_t;
typedef short bf16x8 __attribute__((ext_vector_type(8)));
typedef float f32x4 __attribute__((ext_vector_type(4)));
typedef unsigned u32x4 __attribute__((ext_vector_type(4)));
constexpr int BM = 256, BK = 64, HALF = 128, HTB = HALF * BK * 2  , STAGE_BYTES = 8 * HTB, NXCD = 8, WGM = 8;

__host__ __device__ __forceinline__ int lds_byte(int r, int c) { const int st = (r >> 4) * 2 + (c >> 5), rr = r & 15, cc = c & 31, ob = rr * 64 + cc * 2; return st * 1024 + (ob ^ (((ob >> 9) & 1) << 5)); }
__host__ __device__ __forceinline__ void stage_rc(int b, int& R, int& C) { const int st = b / 1024, sb = b % 1024, swz = sb ^ (((sb >> 9) & 1) << 5); R = (st >> 1) * 16 + swz / 64; C = (st & 1) * 32 + (swz % 64) / 2; }
__host__ __device__ __forceinline__ int perm32(int rho) { const int n = rho >> 4, i = rho & 15; return 8 * (i >> 2) + 4 * n + (i & 3); }

struct Unit { int pm, pn, kt0, nt, split, np, part; };
struct Gemm { const bf16_t* A; const bf16_t* Bt; int M, N, K; };

struct StaticOrder {
    int nM, nN, nwg, G, c;
    __host__ __device__ void init(int M, int N, int G_, int c_) { nM = M / BM; nN = N / BM; nwg = nM * nN; G = G_; c = c_; }
    __host__ __device__ bool next(int i, Unit& u) const {
        const long L = (long)i * G + c; if (L >= nwg) return false;
        int wgid = (int)L; { const int q = nwg / NXCD, r = nwg % NXCD, xcd = wgid % NXCD, off = wgid / NXCD; wgid = (xcd < r ? xcd * (q + 1) : r * (q + 1) + (xcd - r) * q) + off; }
        const int nig = WGM * nN, gid = wgid / nig, fm = gid * WGM, gsz = (nM - fm) < WGM ? (nM - fm) : WGM;
        u.pm = fm + ((wgid % nig) % gsz); u.pn = (wgid % nig) / gsz; u.kt0 = 0; u.nt = 0; u.split = -1; u.np = 1; u.part = 0; return true;
    }
    __device__ __forceinline__ void a_ready(const Unit&) const {}
    __device__ __forceinline__ void done(const Unit&) const {}
};

__device__ __forceinline__ unsigned cvt_pk_bf16(float lo, float hi) { unsigned r; asm volatile("v_cvt_pk_bf16_f32 %0, %1, %2" : "=v"(r) : "v"(lo), "v"(hi)); return r; }

struct SplitOrder {
    int nM, nN, nwg, G, c, F, Rm, P, ntot, nbase, nextra;
    __device__ __forceinline__ void init(int M, int N, int K, int G_, int c_, bool allow_split) {
        nM = M / BM; nN = N / BM; nwg = nM * nN; G = G_; c = c_; ntot = K / BK; F = nwg / G; Rm = nwg - F * G; P = 1;
        if (allow_split && Rm > 0 && F > 0 && Rm <= 128) {     int p = G / Rm; if (p > 8) p = 8; const int pk = ntot / 4; if (p > pk) p = pk; if (p >= 2) P = p; }
        nbase = (ntot / P) & ~1; nextra = (ntot - nbase * P) / 2;
    }
    __device__ __forceinline__ void map(int L, Unit& u) const {
        int wgid = L; { const int q = nwg / NXCD, r = nwg % NXCD, xcd = wgid % NXCD, off = wgid / NXCD; wgid = (xcd < r ? xcd * (q + 1) : r * (q + 1) + (xcd - r) * q) + off; }
        const int nig = WGM * nN, gid = wgid / nig, fm = gid * WGM, gsz = (nM - fm) < WGM ? (nM - fm) : WGM;
        u.pm = fm + ((wgid % nig) % gsz); u.pn = (wgid % nig) / gsz;
    }
    __device__ __forceinline__ bool next(int i, Unit& u) const {
        if (P == 1) { const long L = (long)i * G + c; if (L >= nwg) return false; map((int)L, u); u.kt0 = 0; u.nt = ntot; u.split = -1; u.np = 1; u.part = 0; return true; }
        const bool has_part = c < Rm * P;
        if (i > 0 || !has_part) { const int ii = has_part ? i - 1 : i; if (ii >= F) return false; map(ii * G + c, u); u.kt0 = 0; u.nt = ntot; u.split = -1; u.np = 1; u.part = 0; return true; }
        const int s = c / P, part = c - s * P; map(F * G + s, u);
        u.kt0 = part * nbase + 2 * (part < nextra ? part : nextra); u.nt = nbase + (part < nextra ? 2 : 0); u.split = s; u.np = P; u.part = part; return true;
    }
    __device__ __forceinline__ void a_ready(const Unit&) const {}
    __device__ __forceinline__ void done(const Unit&) const {}
};

constexpr float RMS_EPS = 1e-6f;
typedef float f32x2v __attribute__((ext_vector_type(2)));
typedef __bf16 bf16x2v __attribute__((ext_vector_type(2)));
__device__ __forceinline__ unsigned pkbf(float lo, float hi) { f32x2v v = {lo, hi}; bf16x2v b = __builtin_convertvector(v, bf16x2v); return __builtin_bit_cast(unsigned, b); }

struct EpiScaleBf16 {
    static constexpr bool PERM = true, AFTER_DRAIN = false, SPLITK = false, USES_LDS = false;
    bf16_t* O; int ldc; const float* ss;
    __device__ __forceinline__ void operator()(const f32x4 (&acc)[2][2][4][2], const Unit& u, int wr, int wc, int fr, int fq) const {
        const int row0 = u.pm * BM + wr * 64 + fr, col0 = u.pn * BM + wc * 32 + 8 * fq;
#pragma unroll
        for (int ai = 0; ai < 2; ++ai)
#pragma unroll
            for (int m = 0; m < 4; ++m) {
                const int r = row0 + ai * HALF + m * 16;
                const float s = ss ? __builtin_amdgcn_rsqf(ss[r] * (1.0f / 4096.0f) + RMS_EPS) : 1.0f;
                bf16_t* rowp = O + (size_t)r * ldc + col0;
#pragma unroll
                for (int bj = 0; bj < 2; ++bj) { const f32x4 v0 = acc[ai][bj][m][0] * s, v1 = acc[ai][bj][m][1] * s;
                    u32x4 w; w.x = pkbf(v0[0], v0[1]); w.y = pkbf(v0[2], v0[3]); w.z = pkbf(v1[0], v1[1]); w.w = pkbf(v1[2], v1[3]);
                    *(u32x4*)(rowp + bj * HALF) = w; } }
    }
};
struct EpiScaleF32 {
    static constexpr bool PERM = true, AFTER_DRAIN = false, SPLITK = false, USES_LDS = false;
    float* O; int ldc; const float* ss;
    __device__ __forceinline__ void operator()(const f32x4 (&acc)[2][2][4][2], const Unit& u, int wr, int wc, int fr, int fq) const {
        const int row0 = u.pm * BM + wr * 64 + fr, col0 = u.pn * BM + wc * 32 + 8 * fq;
#pragma unroll
        for (int ai = 0; ai < 2; ++ai)
#pragma unroll
            for (int m = 0; m < 4; ++m) {
                const int r = row0 + ai * HALF + m * 16;
                const float s = ss ? __builtin_amdgcn_rsqf(ss[r] * (1.0f / 4096.0f) + RMS_EPS) : 1.0f;
                float* rowp = O + (size_t)r * ldc + col0;
#pragma unroll
                for (int bj = 0; bj < 2; ++bj) { *(f32x4*)(rowp + bj * HALF) = acc[ai][bj][m][0] * s; *(f32x4*)(rowp + bj * HALF + 4) = acc[ai][bj][m][1] * s; } }
    }
};
struct EpiResid {
    static constexpr bool PERM = true, AFTER_DRAIN = false, SPLITK = true, USES_LDS = false;
    float* Y; bf16_t* XB; float* ssq; unsigned* cnt; unsigned char* slab;
    __device__ __forceinline__ void operator()(const f32x4 (&acc)[2][2][4][2], const Unit& u, int wr, int wc, int fr, int fq) const {
        const int row0 = u.pm * BM + wr * 64 + fr, col0 = u.pn * BM + wc * 32 + 8 * fq;
#pragma unroll
        for (int ai = 0; ai < 2; ++ai)
#pragma unroll
            for (int m = 0; m < 4; ++m) {
                const int r = row0 + ai * HALF + m * 16;
                bf16_t* xp = XB + (size_t)r * 4096 + col0; float sq = 0.f;
                const u32x4 o0 = *(const u32x4*)xp, o1 = *(const u32x4*)(xp + HALF);
#pragma unroll
                for (int bj = 0; bj < 2; ++bj) {
                    const u32x4 o = bj ? o1 : o0;
                    f32x4 a = {__uint_as_float(o.x << 16), __uint_as_float(o.x & 0xffff0000u), __uint_as_float(o.y << 16), __uint_as_float(o.y & 0xffff0000u)};
                    f32x4 b = {__uint_as_float(o.z << 16), __uint_as_float(o.z & 0xffff0000u), __uint_as_float(o.w << 16), __uint_as_float(o.w & 0xffff0000u)};
                    a += acc[ai][bj][m][0]; b += acc[ai][bj][m][1];
                    if (Y) { float* yp = Y + (size_t)r * 4096 + col0 + bj * HALF; *(f32x4*)yp = a; *(f32x4*)(yp + 4) = b; }
                    else {
                        sq += (a[0] * a[0] + a[1] * a[1]) + (a[2] * a[2] + a[3] * a[3]) + (b[0] * b[0] + b[1] * b[1]) + (b[2] * b[2] + b[3] * b[3]);
                        u32x4 w; w.x = pkbf(a[0], a[1]); w.y = pkbf(a[2], a[3]); w.z = pkbf(b[0], b[1]); w.w = pkbf(b[2], b[3]);
                        *(u32x4*)(xp + bj * HALF) = w; } }
                if (!Y) { sq += __shfl_xor(sq, 16); sq += __shfl_xor(sq, 32); if (fq == 0) unsafeAtomicAdd(ssq + r, sq); }
            }
    }
    __device__ __forceinline__ void partial(const f32x4 (&acc)[2][2][4][2], const Unit& u, int wr, int wc, int fr, int fq, PG8_LAS unsigned char* lds, int tid) const {
        const int wid = __builtin_amdgcn_readfirstlane(tid >> 6), lane = tid & 63;
        unsigned char* tile_slabs = slab + (size_t)u.split * 8 * 262144;
        const int myp = u.part;
        { __amdgpu_buffer_rsrc_t rs = __builtin_amdgcn_make_buffer_rsrc((void*)(tile_slabs + (size_t)myp * 262144), (short)0, 262144, 0x00020000);
#pragma unroll
          for (int ai = 0; ai < 2; ++ai)
#pragma unroll
            for (int bj = 0; bj < 2; ++bj)
#pragma unroll
                for (int m = 0; m < 4; ++m)
#pragma unroll
                    for (int n = 0; n < 2; ++n) { const int k = ((ai * 2 + bj) * 4 + m) * 2 + n;
                        __builtin_amdgcn_raw_buffer_store_b128(__builtin_bit_cast(u32x4, acc[ai][bj][m][n]), rs, ((wid * 32 + k) * 64 + lane) * 16, 0, 16); } }
        asm volatile("s_waitcnt vmcnt(0)" ::: "memory");
        __builtin_amdgcn_s_barrier();
        PG8_LAS unsigned* bw = (PG8_LAS unsigned*)(lds + 131072 + 320 + 64);
        if (tid == 0) { const unsigned old = __hip_atomic_fetch_add(cnt + u.split, 1u, __ATOMIC_RELAXED, __HIP_MEMORY_SCOPE_AGENT); *bw = old; }
        asm volatile("s_waitcnt vmcnt(0) lgkmcnt(0)" ::: "memory");
        __builtin_amdgcn_s_barrier();
        const unsigned old = *bw;
        asm volatile("s_waitcnt lgkmcnt(0)" ::: "memory");
        if (old == (unsigned)(u.np - 1)) {
            f32x4 z[2][2][4][2];
#pragma unroll
            for (int a = 0; a < 2; ++a)
#pragma unroll
                for (int b = 0; b < 2; ++b)
#pragma unroll
                    for (int m = 0; m < 4; ++m)
#pragma unroll
                        for (int n = 0; n < 2; ++n) z[a][b][m][n] = (f32x4){0.f, 0.f, 0.f, 0.f};
            for (int p = 0; p < u.np; ++p) {
                __amdgpu_buffer_rsrc_t rs = __builtin_amdgcn_make_buffer_rsrc((void*)(tile_slabs + (size_t)p * 262144), (short)0, 262144, 0x00020000);
#pragma unroll
                for (int ai = 0; ai < 2; ++ai)
#pragma unroll
                    for (int bj = 0; bj < 2; ++bj)
#pragma unroll
                        for (int m = 0; m < 4; ++m)
#pragma unroll
                            for (int n = 0; n < 2; ++n) { const int k = ((ai * 2 + bj) * 4 + m) * 2 + n;
                                z[ai][bj][m][n] += __builtin_bit_cast(f32x4, __builtin_amdgcn_raw_buffer_load_b128(rs, ((wid * 32 + k) * 64 + lane) * 16, 0, 16)); }
            }
            (*this)(z, u, wr, wc, fr, fq);
        }
    }
};
struct EpiGU {
    static constexpr bool PERM = true, AFTER_DRAIN = false, SPLITK = false, USES_LDS = false;
    bf16_t* H; const float* ss; unsigned* cnt; unsigned char* slab;
    __device__ __forceinline__ void operator()(const f32x4 (&acc)[2][2][4][2], const Unit& u, int wr, int wc, int fr, int fq) const {
        const int row0 = u.pm * BM + wr * 64 + fr, col0 = u.pn * HALF + wc * 32 + 8 * fq;
#pragma unroll
        for (int ai = 0; ai < 2; ++ai)
#pragma unroll
            for (int m = 0; m < 4; ++m) {
                const int r = row0 + ai * HALF + m * 16;
                const float s = __builtin_amdgcn_rsqf(ss[r] * (1.0f / 4096.0f) + RMS_EPS);
                float hv[8];
#pragma unroll
                for (int n = 0; n < 2; ++n)
#pragma unroll
                    for (int j = 0; j < 4; ++j) { const float g = acc[ai][0][m][n][j] * s, up = acc[ai][1][m][n][j] * s;
                        hv[n * 4 + j] = g * __builtin_amdgcn_rcpf(1.0f + __builtin_amdgcn_exp2f(-1.4426950408889634f * g)) * up; }
                u32x4 w; w.x = pkbf(hv[0], hv[1]); w.y = pkbf(hv[2], hv[3]); w.z = pkbf(hv[4], hv[5]); w.w = pkbf(hv[6], hv[7]);
                *(u32x4*)(H + (size_t)r * 11008 + col0) = w; }
    }
    __device__ __forceinline__ void partial(const f32x4 (&acc)[2][2][4][2], const Unit& u, int wr, int wc, int fr, int fq, PG8_LAS unsigned char* lds, int tid) const {
        const int wid = __builtin_amdgcn_readfirstlane(tid >> 6), lane = tid & 63;
        unsigned char* tile_slabs = slab + (size_t)u.split * 8 * 262144;
        const int myp = u.part;
        { __amdgpu_buffer_rsrc_t rs = __builtin_amdgcn_make_buffer_rsrc((void*)(tile_slabs + (size_t)myp * 262144), (short)0, 262144, 0x00020000);
#pragma unroll
          for (int ai = 0; ai < 2; ++ai)
#pragma unroll
            for (int bj = 0; bj < 2; ++bj)
#pragma unroll
                for (int m = 0; m < 4; ++m)
#pragma unroll
                    for (int n = 0; n < 2; ++n) { const int k = ((ai * 2 + bj) * 4 + m) * 2 + n;
                        __builtin_amdgcn_raw_buffer_store_b128(__builtin_bit_cast(u32x4, acc[ai][bj][m][n]), rs, ((wid * 32 + k) * 64 + lane) * 16, 0, 16); } }
        asm volatile("s_waitcnt vmcnt(0)" ::: "memory");
        __builtin_amdgcn_s_barrier();
        PG8_LAS unsigned* bw = (PG8_LAS unsigned*)(lds + 131072 + 320 + 64);
        if (tid == 0) { const unsigned old = __hip_atomic_fetch_add(cnt + u.split, 1u, __ATOMIC_RELAXED, __HIP_MEMORY_SCOPE_AGENT); *bw = old; }
        asm volatile("s_waitcnt vmcnt(0) lgkmcnt(0)" ::: "memory");
        __builtin_amdgcn_s_barrier();
        const unsigned old = *bw;
        asm volatile("s_waitcnt lgkmcnt(0)" ::: "memory");
        if (old == (unsigned)(u.np - 1)) {
            f32x4 z[2][2][4][2];
#pragma unroll
            for (int a = 0; a < 2; ++a)
#pragma unroll
                for (int b = 0; b < 2; ++b)
#pragma unroll
                    for (int m = 0; m < 4; ++m)
#pragma unroll
                        for (int n = 0; n < 2; ++n) z[a][b][m][n] = (f32x4){0.f, 0.f, 0.f, 0.f};
            for (int p = 0; p < u.np; ++p) {
                __amdgpu_buffer_rsrc_t rs = __builtin_amdgcn_make_buffer_rsrc((void*)(tile_slabs + (size_t)p * 262144), (short)0, 262144, 0x00020000);
#pragma unroll
                for (int ai = 0; ai < 2; ++ai)
#pragma unroll
                    for (int bj = 0; bj < 2; ++bj)
#pragma unroll
                        for (int m = 0; m < 4; ++m)
#pragma unroll
                            for (int n = 0; n < 2; ++n) { const int k = ((ai * 2 + bj) * 4 + m) * 2 + n;
                                z[ai][bj][m][n] += __builtin_bit_cast(f32x4, __builtin_amdgcn_raw_buffer_load_b128(rs, ((wid * 32 + k) * 64 + lane) * 16, 0, 16)); }
            }
            (*this)(z, u, wr, wc, fr, fq);
        }
    }
};

struct EpiKVNorm {
    static constexpr bool PERM = true, AFTER_DRAIN = false, SPLITK = false, USES_LDS = true;
    bf16_t* O; const float* gain; int Mrows;
    __device__ __forceinline__ void operator()(const f32x4 (&acc)[2][2][4][2], const Unit& u, int wr, int wc, int fr, int fq) const {}
    __device__ __forceinline__ void with_lds(const f32x4 (&acc)[2][2][4][2], const Unit& u, int wr, int wc, int fr, int fq, PG8_LAS unsigned char* lds) const {
        PG8_LAS float* part = (PG8_LAS float*)(lds + 131072 + 1024);
        const int rb = wr * 64 + fr;
#pragma unroll
        for (int ai = 0; ai < 2; ++ai)
#pragma unroll
            for (int m = 0; m < 4; ++m) { const f32x4 a = acc[ai][0][m][0], b = acc[ai][0][m][1];
                float s = (a[0] * a[0] + a[1] * a[1]) + (a[2] * a[2] + a[3] * a[3]) + (b[0] * b[0] + b[1] * b[1]) + (b[2] * b[2] + b[3] * b[3]);
                s += __shfl_xor(s, 16); s += __shfl_xor(s, 32);
                if (fq == 0) part[(ai * HALF + rb + m * 16) * 4 + wc] = s; }
        asm volatile("s_waitcnt lgkmcnt(0)" ::: "memory"); __builtin_amdgcn_s_barrier(); asm volatile("" ::: "memory");
        const int cl = wc * 32 + 8 * fq; const f32x4 g0 = *(const f32x4*)(gain + cl), g1 = *(const f32x4*)(gain + cl + 4);
        const int row0 = u.pm * BM + rb;
#pragma unroll
        for (int ai = 0; ai < 2; ++ai)
#pragma unroll
            for (int m = 0; m < 4; ++m) {
                const f32x4 p = *(const PG8_LAS f32x4*)(part + (ai * HALF + rb + m * 16) * 4);
                const float rs = __builtin_amdgcn_rsqf(((p[0] + p[1]) + (p[2] + p[3])) * (1.0f / 128.0f) + RMS_EPS);
                bf16_t* rowp = O + ((size_t)u.pn * Mrows + (size_t)(row0 + ai * HALF + m * 16)) * 256 + cl;
                const f32x4 k0 = acc[ai][0][m][0] * rs * g0, k1 = acc[ai][0][m][1] * rs * g1, v0 = acc[ai][1][m][0], v1 = acc[ai][1][m][1];
                u32x4 w; w.x = pkbf(k0[0], k0[1]); w.y = pkbf(k0[2], k0[3]); w.z = pkbf(k1[0], k1[1]); w.w = pkbf(k1[2], k1[3]);
                *(u32x4*)rowp = w;
                w.x = pkbf(v0[0], v0[1]); w.y = pkbf(v0[2], v0[3]); w.z = pkbf(v1[0], v1[1]); w.w = pkbf(v1[2], v1[3]);
                *(u32x4*)(rowp + HALF) = w; }
    }
};

struct EpiMemKV {
    static constexpr bool PERM = true, AFTER_DRAIN = false, SPLITK = false, USES_LDS = true;
    const float* ssm; const float* gain; float* outK; float* outV; bf16_t* MK; bf16_t* MV;
    __device__ __forceinline__ void operator()(const f32x4 (&acc)[2][2][4][2], const Unit& u, int wr, int wc, int fr, int fq) const {}
    __device__ __forceinline__ void with_lds(const f32x4 (&acc)[2][2][4][2], const Unit& u, int wr, int wc, int fr, int fq, PG8_LAS unsigned char* lds) const {
        PG8_LAS float* part = (PG8_LAS float*)(lds + 131072 + 1024);
        const int rb = wr * 64 + fr, cl = wc * 32 + 8 * fq; const bool isk = u.pn < 2;
        float sr[2][4];
#pragma unroll
        for (int ai = 0; ai < 2; ++ai)
#pragma unroll
            for (int m = 0; m < 4; ++m) sr[ai][m] = __builtin_amdgcn_rsqf(ssm[u.pm * BM + ai * HALF + rb + m * 16] * (1.0f / 4096.0f) + RMS_EPS);
        if (isk) {
#pragma unroll
            for (int ai = 0; ai < 2; ++ai)
#pragma unroll
                for (int m = 0; m < 4; ++m)
#pragma unroll
                    for (int bj = 0; bj < 2; ++bj) { const f32x4 a = acc[ai][bj][m][0], b = acc[ai][bj][m][1];
                        float s = (a[0] * a[0] + a[1] * a[1]) + (a[2] * a[2] + a[3] * a[3]) + (b[0] * b[0] + b[1] * b[1]) + (b[2] * b[2] + b[3] * b[3]);
                        s *= sr[ai][m] * sr[ai][m]; s += __shfl_xor(s, 16); s += __shfl_xor(s, 32);
                        if (fq == 0) part[((ai * HALF + rb + m * 16) * 2 + bj) * 4 + wc] = s; }
            asm volatile("s_waitcnt lgkmcnt(0)" ::: "memory"); __builtin_amdgcn_s_barrier(); asm volatile("" ::: "memory");
        }
        const f32x4 g0 = *(const f32x4*)(gain + cl), g1 = *(const f32x4*)(gain + cl + 4);
        float* outp = isk ? outK : outV; bf16_t* outb = isk ? MK : MV; const int ct = (isk ? u.pn : u.pn - 2) * BM + cl;
#pragma unroll
        for (int ai = 0; ai < 2; ++ai)
#pragma unroll
            for (int m = 0; m < 4; ++m) { const int r = u.pm * BM + ai * HALF + rb + m * 16;
#pragma unroll
                for (int bj = 0; bj < 2; ++bj) {
                    f32x4 v0 = acc[ai][bj][m][0] * sr[ai][m], v1 = acc[ai][bj][m][1] * sr[ai][m];
                    if (isk) { const f32x4 p = *(const PG8_LAS f32x4*)(part + ((ai * HALF + rb + m * 16) * 2 + bj) * 4);
                        const float rs = __builtin_amdgcn_rsqf(((p[0] + p[1]) + (p[2] + p[3])) * (1.0f / 128.0f) + RMS_EPS); v0 = v0 * rs * g0; v1 = v1 * rs * g1; }
                    float* op = outp + (size_t)r * 512 + ct + bj * HALF; *(f32x4*)op = v0; *(f32x4*)(op + 4) = v1;
                    u32x4 w; w.x = pkbf(v0[0], v0[1]); w.y = pkbf(v0[2], v0[3]); w.z = pkbf(v1[0], v1[1]); w.w = pkbf(v1[2], v1[3]);
                    *(u32x4*)(outb + (size_t)r * 512 + ct + bj * HALF) = w; } }
    }
};

#ifndef PROBE_NULLSPLIT
#define PROBE_NULLSPLIT false
#endif
struct EpiNull {
    static constexpr bool PERM = true, AFTER_DRAIN = false, SPLITK = PROBE_NULLSPLIT, USES_LDS = false;
    __device__ __forceinline__ void partial(const f32x4 (&acc)[2][2][4][2], const Unit& u, int wr, int wc, int fr, int fq, PG8_LAS unsigned char* lds, int tid) const { (*this)(acc, u, wr, wc, fr, fq); }
    __device__ __forceinline__ void operator()(const f32x4 (&acc)[2][2][4][2], const Unit& u, int wr, int wc, int fr, int fq) const {
#pragma unroll
        for (int ai = 0; ai < 2; ++ai)
#pragma unroll
            for (int bj = 0; bj < 2; ++bj)
#pragma unroll
                for (int m = 0; m < 4; ++m) asm volatile("" :: "v"(acc[ai][bj][m][0]), "v"(acc[ai][bj][m][1]));
    }
};

template <class Epi, class Sched, bool ALIGN_EPI = false, bool SP2 = false>
__device__ __forceinline__ void gemm_phase(PG8_LAS unsigned char* lds, const Gemm g, const Sched& S, const Epi& E) {
    int tid_o = threadIdx.x; asm volatile("" : "+v"(tid_o));
    const int tid = tid_o, wid = __builtin_amdgcn_readfirstlane(tid >> 6), lane = tid & 63, wr = wid >> 2, wc = wid & 3, fr = lane & 15, fq = lane >> 4;
    const int K = g.K;
    unsigned voffA[2], voffB[2];
#pragma unroll
    for (int i = 0; i < 2; ++i) { int R, C; stage_rc(tid * 16 + i * 8192, R, C); const int Rb = Epi::PERM ? ((R & ~31) + perm32(R & 31)) : R;
        voffA[i] = (unsigned)(R * K + C) * 2u; voffB[i] = (unsigned)(Rb * K + C) * 2u; }
    const size_t kstep = (size_t)(BK * 2);
    const size_t hstep = (size_t)HALF * K * 2;
    const size_t tstep = 2 * hstep;
    const unsigned ldsw = (unsigned)wid * 1024u;
    const int aoff = lds_byte(wr * 64 + fr, fq * 8), boff = lds_byte(wc * 32 + fr, fq * 8);
#define PG8_SA(b, h) (((b) * 2 + (h)) * HTB)
#define PG8_SB(b, h) ((4 + (b) * 2 + (h)) * HTB)
#define PG8_STAGE(bufoff, gbase, voff) do { _Pragma("unroll") for (int _i = 0; _i < 2; ++_i) \
        __builtin_amdgcn_global_load_lds((const unsigned*)((const char*)(gbase) + (voff)[_i]), (PG8_LAS unsigned*)(lds + (bufoff) + ldsw + _i * 8192), 16, 0, 0); } while (0)
#define PG8_LDA(dst, b, h) do { _Pragma("unroll") for (int m = 0; m < 4; ++m) _Pragma("unroll") for (int k = 0; k < 2; ++k) dst[m][k] = *(const PG8_LAS bf16x8*)(lds + PG8_SA(b, h) + aoff + m * 2048 + k * 1024); } while (0)
#define PG8_LDB(dst, b, h) do { _Pragma("unroll") for (int n = 0; n < 2; ++n) _Pragma("unroll") for (int k = 0; k < 2; ++k) dst[n][k] = *(const PG8_LAS bf16x8*)(lds + PG8_SB(b, h) + boff + n * 2048 + k * 1024); } while (0)
#define PG8_MMA(ai, bj, At, Bt) do { __builtin_amdgcn_s_setprio(1); _Pragma("unroll") for (int m = 0; m < 4; ++m) _Pragma("unroll") for (int n = 0; n < 2; ++n) _Pragma("unroll") for (int k = 0; k < 2; ++k) \
        acc[ai][bj][m][n] = __builtin_amdgcn_mfma_f32_16x16x32_bf16(Bt[n][k], At[m][k], acc[ai][bj][m][n], 0, 0, 0); __builtin_amdgcn_s_setprio(0); } while (0)
#define PG8_WAIT_V(n) asm volatile("s_waitcnt vmcnt(" #n ")" ::: "memory")
#define PG8_WAIT_L(n) asm volatile("s_waitcnt lgkmcnt(" #n ")" ::: "memory")
#define PG8_BAR __builtin_amdgcn_s_barrier()
#define PG8_SCHED __builtin_amdgcn_sched_barrier(0)
    Unit cur, nxt; int ui = 0;
    if (!S.next(0, cur)) return;
    f32x4 acc[2][2][4][2];
#pragma unroll
    for (int a = 0; a < 2; ++a)
#pragma unroll
        for (int b = 0; b < 2; ++b)
#pragma unroll
            for (int m = 0; m < 4; ++m)
#pragma unroll
                for (int n = 0; n < 2; ++n) acc[a][b][m][n] = (f32x4){0.f, 0.f, 0.f, 0.f};
    bf16x8 At[4][2], B0[2][2], B1[2][2];
    const char* cA = (const char*)g.A + (size_t)cur.pm * tstep + (size_t)cur.kt0 * kstep; const char* cB = (const char*)g.Bt + (size_t)cur.pn * tstep + (size_t)cur.kt0 * kstep;
    S.a_ready(cur);
    if constexpr (SP2) {
        PG8_STAGE(PG8_SB(0, 0), cB, voffB); PG8_STAGE(PG8_SB(0, 1), cB + hstep, voffB); PG8_STAGE(PG8_SA(0, 0), cA, voffA); PG8_STAGE(PG8_SA(0, 1), cA + hstep, voffA);
        if (wr == 1) PG8_BAR;
        PG8_WAIT_V(2); PG8_BAR;
        PG8_STAGE(PG8_SB(1, 0), cB + kstep, voffB); PG8_STAGE(PG8_SA(1, 0), cA + kstep, voffA); PG8_STAGE(PG8_SB(1, 1), cB + hstep + kstep, voffB);
        PG8_WAIT_V(6); PG8_BAR;
    } else {
        PG8_STAGE(PG8_SB(0, 0), cB, voffB); PG8_STAGE(PG8_SA(0, 0), cA, voffA); PG8_STAGE(PG8_SB(0, 1), cB + hstep, voffB); PG8_STAGE(PG8_SA(0, 1), cA + hstep, voffA);
        if (wr == 1) PG8_BAR;
        PG8_WAIT_V(4); PG8_BAR;
        PG8_STAGE(PG8_SB(1, 0), cB + kstep, voffB); PG8_STAGE(PG8_SA(1, 0), cA + kstep, voffA); PG8_STAGE(PG8_SB(1, 1), cB + hstep + kstep, voffB);
        PG8_WAIT_V(6); PG8_BAR;
    }
    for (;;) {
        const bool has_next = S.next(ui + 1, nxt);
        const char* nA = has_next ? (const char*)g.A + (size_t)nxt.pm * tstep + (size_t)nxt.kt0 * kstep : cA; const char* nB = has_next ? (const char*)g.Bt + (size_t)nxt.pn * tstep + (size_t)nxt.kt0 * kstep : cB;
        const int nt = cur.nt;
        for (int t = 0; t < nt; t += 2) {
            const bool last = (t == nt - 2);
            const char* a1 = cA + (size_t)(t + 1) * kstep;
            const char* a2 = last ? nA : cA + (size_t)(t + 2) * kstep; const char* b2 = last ? nB : cB + (size_t)(t + 2) * kstep;
            const char* a3 = a2 + kstep; const char* b3 = b2 + kstep;
            if (last && has_next) S.a_ready(nxt);
            if constexpr (SP2) {
            PG8_LDB(B0, 0, 0); PG8_LDB(B1, 0, 1); PG8_SCHED; PG8_LDA(At, 0, 0); PG8_STAGE(PG8_SA(1, 1), a1 + hstep, voffA);
            PG8_WAIT_V(8); PG8_WAIT_L(0); PG8_BAR; PG8_MMA(0, 0, At, B0); PG8_MMA(0, 1, At, B1); PG8_BAR; PG8_SCHED;
            PG8_LDA(At, 0, 1); PG8_STAGE(PG8_SB(0, 0), b2, voffB); PG8_STAGE(PG8_SB(0, 1), b2 + hstep, voffB); PG8_STAGE(PG8_SA(0, 0), a2, voffA);
            PG8_WAIT_V(8); PG8_WAIT_L(0); PG8_BAR; PG8_MMA(1, 0, At, B0); PG8_MMA(1, 1, At, B1); PG8_BAR; PG8_SCHED;
            PG8_LDB(B0, 1, 0); PG8_LDB(B1, 1, 1); PG8_SCHED; PG8_LDA(At, 1, 0); PG8_STAGE(PG8_SA(0, 1), a2 + hstep, voffA);
            PG8_WAIT_V(8); PG8_WAIT_L(0); PG8_BAR; PG8_MMA(0, 0, At, B0); PG8_MMA(0, 1, At, B1); PG8_BAR; PG8_SCHED;
            PG8_LDA(At, 1, 1); PG8_STAGE(PG8_SB(1, 0), b3, voffB); PG8_STAGE(PG8_SB(1, 1), b3 + hstep, voffB); PG8_STAGE(PG8_SA(1, 0), a3, voffA);
            PG8_WAIT_V(8); PG8_WAIT_L(0); PG8_BAR; PG8_MMA(1, 0, At, B0); PG8_MMA(1, 1, At, B1); PG8_BAR; PG8_SCHED;
            } else {
            PG8_LDB(B0, 0, 0); PG8_SCHED; PG8_LDA(At, 0, 0); PG8_STAGE(PG8_SA(1, 1), a1 + hstep, voffA);
            PG8_WAIT_L(8); PG8_BAR; PG8_WAIT_L(0); PG8_MMA(0, 0, At, B0); PG8_BAR; PG8_SCHED;
            PG8_LDB(B1, 0, 1); PG8_STAGE(PG8_SB(0, 0), b2, voffB);
            PG8_BAR; PG8_WAIT_L(0); PG8_MMA(0, 1, At, B1); PG8_BAR;
            PG8_LDA(At, 0, 1); PG8_STAGE(PG8_SA(0, 0), a2, voffA);
            PG8_BAR; PG8_WAIT_L(0); PG8_MMA(1, 0, At, B0); PG8_BAR; PG8_SCHED;
            PG8_STAGE(PG8_SB(0, 1), b2 + hstep, voffB);
            PG8_WAIT_V(6); PG8_BAR; PG8_MMA(1, 1, At, B1); PG8_BAR;
            PG8_LDB(B0, 1, 0); PG8_SCHED; PG8_LDA(At, 1, 0); PG8_STAGE(PG8_SA(0, 1), a2 + hstep, voffA);
            PG8_WAIT_L(8); PG8_BAR; PG8_WAIT_L(0); PG8_MMA(0, 0, At, B0); PG8_BAR; PG8_SCHED;
            PG8_LDB(B1, 1, 1); PG8_STAGE(PG8_SB(1, 0), b3, voffB);
            PG8_BAR; PG8_WAIT_L(0); PG8_MMA(0, 1, At, B1); PG8_BAR;
            PG8_LDA(At, 1, 1); PG8_STAGE(PG8_SA(1, 0), a3, voffA);
            PG8_BAR; PG8_WAIT_L(0); PG8_MMA(1, 0, At, B0); PG8_BAR; PG8_SCHED;
            PG8_STAGE(PG8_SB(1, 1), b3 + hstep, voffB);
            PG8_WAIT_V(6); PG8_BAR; PG8_MMA(1, 1, At, B1); PG8_BAR;
            }
        }
        if constexpr (ALIGN_EPI) { if (wr == 0) PG8_BAR; }
        if constexpr (!Epi::AFTER_DRAIN) { if constexpr (Epi::SPLITK) { if (cur.split >= 0) E.partial(acc, cur, wr, wc, fr, fq, lds, tid); else E(acc, cur, wr, wc, fr, fq); } else if constexpr (Epi::USES_LDS) E.with_lds(acc, cur, wr, wc, fr, fq, lds); else E(acc, cur, wr, wc, fr, fq); S.done(cur); }
        if (!has_next) break;
#pragma unroll
        for (int a = 0; a < 2; ++a)
#pragma unroll
            for (int b = 0; b < 2; ++b)
#pragma unroll
                for (int m = 0; m < 4; ++m)
#pragma unroll
                    for (int n = 0; n < 2; ++n) acc[a][b][m][n] = (f32x4){0.f, 0.f, 0.f, 0.f};
        cur = nxt; cA = nA; cB = nB; ++ui;
        if constexpr (ALIGN_EPI) { if (wr == 1) PG8_BAR; }
    }
    PG8_WAIT_V(0);
    if constexpr (!ALIGN_EPI) { if (wr == 0) PG8_BAR; }
    PG8_BAR;
    if constexpr (Epi::AFTER_DRAIN) { E.fused(acc, cur, wr, wc, fr, fq, lds, wid, lane); S.done(cur); }
#undef PG8_SA
#undef PG8_SB
#undef PG8_STAGE
#undef PG8_LDA
#undef PG8_LDB
#undef PG8_MMA
#undef PG8_WAIT_V
#undef PG8_WAIT_L
#undef PG8_BAR
#undef PG8_SCHED
}
}

typedef unsigned short bf16;
typedef short bf16x8 __attribute__((ext_vector_type(8)));
typedef short s16x4 __attribute__((ext_vector_type(4)));
typedef float f32x4 __attribute__((ext_vector_type(4)));
typedef float f32x16 __attribute__((ext_vector_type(16)));
typedef unsigned u32x4 __attribute__((ext_vector_type(4)));
typedef unsigned u32x2 __attribute__((ext_vector_type(2)));
using pg8::pkbf;
constexpr float EPS = 1e-6f;
DI float bf_lo(unsigned w) { return __uint_as_float(w << 16); }
DI float bf_hi(unsigned w) { return __uint_as_float(w & 0xffff0000u); }
DI float bf2f(bf16 v) { return __uint_as_float((unsigned)v << 16); }
DI bf16 f2bf(float f) { return (bf16)(pkbf(f, f) & 0xffffu); }
DI void unpack8(const u32x4 w, float (&f)[8]) { f[0] = bf_lo(w.x); f[1] = bf_hi(w.x); f[2] = bf_lo(w.y); f[3] = bf_hi(w.y); f[4] = bf_lo(w.z); f[5] = bf_hi(w.z); f[6] = bf_lo(w.w); f[7] = bf_hi(w.w); }
DI u32x4 pack8(const float (&f)[8]) { u32x4 w; w.x = pkbf(f[0], f[1]); w.y = pkbf(f[2], f[3]); w.z = pkbf(f[4], f[5]); w.w = pkbf(f[6], f[7]); return w; }
DI float wave_sum(float v) {
#pragma unroll
    for (int o = 1; o < 64; o <<= 1) v += __shfl_xor(v, o);
    return v;
}
DI float silu_f(float x) { return x * __builtin_amdgcn_rcpf(1.0f + __builtin_amdgcn_exp2f(-1.4426950408889634f * x)); }

#define XB_TMO      128
#define XB_XCNT(j)  (256  + 64 * (j))
#define XB_XSUB(j)  (1280 + 64 * (j))
#define XB_XGEN(j)  (2304 + 64 * (j))
#define XB_TOP      3328
#define XB_TOPGEN   3392
#define XCD_BAR_WORDS 3456
#define XB_SPIN_CAP (1u << 18)

__device__ __forceinline__ unsigned xb_ld(unsigned* p)              { return __hip_atomic_load(p, __ATOMIC_RELAXED, __HIP_MEMORY_SCOPE_AGENT); }
__device__ __forceinline__ unsigned xb_add(unsigned* p, unsigned v) { return __hip_atomic_fetch_add(p, v, __ATOMIC_RELAXED, __HIP_MEMORY_SCOPE_AGENT); }
__device__ __forceinline__ unsigned xb_xcc_id() { return (unsigned)__builtin_amdgcn_s_getreg((3 << 11) | 20) & 0xFu; }
#define XB_SPIN(cond, bar) do { unsigned _sp = 0; while (cond) { __builtin_amdgcn_s_sleep(1); \
    if ((++_sp & 255u) == 0u) { if (xb_ld(&(bar)[XB_TMO])) break; if (_sp > XB_SPIN_CAP) { atomicAdd(&(bar)[XB_TMO], 1u); break; } } } } while (0)

struct XcdBarrier {
    unsigned* bar; unsigned x;
    volatile LAS unsigned* st;
};

__device__ __forceinline__ XcdBarrier xcd_barrier_post(unsigned* bar, volatile LAS unsigned* st) {
    XcdBarrier b; b.bar = bar; b.x = xb_xcc_id(); b.st = st;
    if (threadIdx.x == 0) (void)xb_add(&bar[XB_XCNT(b.x)], 1u);
    return b;
}
__device__ __forceinline__ void xcd_barrier_complete(unsigned* bar, unsigned x, unsigned& nloc, unsigned& nx) {
    const unsigned G = gridDim.x * gridDim.y * gridDim.z;
    unsigned sum, cnt, mine, sp = 0u;
    for (;;) {
        sum = 0u; cnt = 0u; mine = 0u;
#pragma unroll
        for (unsigned j = 0; j < 16; ++j) { const unsigned c = xb_ld(&bar[XB_XCNT(j)]); sum += c; cnt += (c > 0u) ? 1u : 0u; mine = (j == x) ? c : mine; }
        if (sum == G) break;
        __builtin_amdgcn_s_sleep(1);
        if ((++sp & 255u) == 0u) { if (xb_ld(&bar[XB_TMO])) break; if (sp > XB_SPIN_CAP) { atomicAdd(&bar[XB_TMO], 1u); break; } }
    }
    nloc = mine > 0u ? mine : 1u; nx = cnt > 0u ? cnt : 1u;
}

__device__ __forceinline__ void xcd_barrier(const XcdBarrier& b) {
    asm volatile("s_waitcnt vmcnt(0)" ::: "memory");
    __syncthreads();
    if (threadIdx.x == 0) {
        unsigned* bar = b.bar;
        __builtin_amdgcn_s_waitcnt(0);
        unsigned nloc = b.st[0], nx = b.st[1];
        if (nloc == 0u) { xcd_barrier_complete(bar, b.x, nloc, nx); b.st[0] = nloc; b.st[1] = nx; }
        const unsigned old = xb_add(&bar[XB_XSUB(b.x)], 1u);
        const unsigned gen = old / nloc;
        if (old + 1u == (gen + 1u) * nloc) {
            __builtin_amdgcn_fence(__ATOMIC_RELEASE, "agent");
            asm volatile("s_waitcnt vmcnt(0)" ::: "memory");
            const unsigned og = xb_add(&bar[XB_TOP], 1u);
            const unsigned tg = og / nx;
            if (og + 1u == (tg + 1u) * nx) xb_add(&bar[XB_TOPGEN], 1u);
            else XB_SPIN(xb_ld(&bar[XB_TOPGEN]) == tg, bar);
            __builtin_amdgcn_fence(__ATOMIC_ACQUIRE, "agent");
            xb_add(&bar[XB_XGEN(b.x)], 1u);
            asm volatile("s_waitcnt vmcnt(0)" ::: "memory");
        } else {
            XB_SPIN(xb_ld(&bar[XB_XGEN(b.x)]) == gen, bar);
            __builtin_amdgcn_fence(__ATOMIC_ACQUIRE, "agent");
            asm volatile("s_waitcnt vmcnt(0)" ::: "memory");
        }
    }
    __syncthreads();
}

constexpr int DM = 4096, RP = 16384, RSM = 512, R = RP + RSM;
constexpr int SEQ = 2048, DSEQ = 64, PAST = 2048, KVS = PAST + DSEQ;
constexpr int KVROWS = RP + 8 * KVS;
constexpr int NIN = 7936;
constexpr int PC_Z = 1536, PC_XBC = 3584, PC_KPE = 7680, PC_DT = 7744;
constexpr int DFF = 11008, NMEM = 256;
constexpr int NLAYER = 2, NPH = 13;

constexpr size_t O_Y = 0, O_CKV_P = 69206016, O_KPE_P = 85983232, O_CONV_P = 88080384, O_SSM_P = 88276992, O_MK_P = 92471296, O_MV_P = 94568448,
                 O_CKV_S = 96665600, O_KPE_S = 97189888, O_CONV_S = 97255424, O_SSM_S = 97452032, O_END = 101646336;

constexpr size_t al256(size_t x) { return (x + 255) / 256 * 256; }
constexpr size_t WS_CTL = 0, CTL_ZERO_BYTES = 1u << 20;
constexpr int CW_TMO = 0, CW_BAR = 4096, CW_SPLIT = 8192, CW_SS = 16384, CW_SSM = CW_SS + 7 * R;
static_assert((CW_SSM + 2048) * 4 <= (int)CTL_ZERO_BYTES && CW_SPLIT + NLAYER * NPH * 256 <= CW_SS, "ctl");
constexpr size_t WS_ROPE = 1u << 20;
constexpr size_t WS_W = 2u << 20;
constexpr size_t W_IN = WS_W, W_UQ = W_IN + (size_t)NIN * 4096 * 2, W_UKV = W_UQ + (size_t)3072 * 1024 * 2, W_O = W_UKV + (size_t)4096 * 512 * 2,
                 W_XQ = W_O + (size_t)4096 * 4096 * 2, W_XKV = W_XQ + (size_t)512 * 4096 * 2, W_XO = W_XKV + (size_t)1024 * 4096 * 2,
                 W_GU = W_XO + (size_t)4096 * 512 * 2, W_DN = W_GU + (size_t)22016 * 4096 * 2, W_END = W_DN + (size_t)4096 * 11008 * 2;
constexpr size_t A_XB = al256(W_END), A_MB = A_XB + (size_t)R * 4096 * 2, A_MEMF = A_MB + (size_t)2048 * 4096 * 2, A_MEMK = A_MEMF + (size_t)2048 * 1024 * 4,
                 A_MEMV = A_MEMK + (size_t)4096 * 512 * 2, A_XQ = A_MEMV + (size_t)4096 * 512 * 2, A_XO = A_XQ + (size_t)R * 512 * 2, A_DT = A_XO + (size_t)R * 512 * 2,
                 A_CQN = A_DT + (size_t)R * 32 * 4, A_CKV = A_CQN + (size_t)R * 1024 * 2, A_KPE = A_CKV + (size_t)KVROWS * 512 * 2, A_YG = A_KPE + (size_t)KVROWS * 64 * 2,
                 A_MIX = A_YG + (size_t)R * 2048 * 2, A_Q = A_MIX + (size_t)R * 4096 * 2, A_KV = A_Q + (size_t)R * 3072 * 2, A_PROJ = A_KV + (size_t)KVROWS * 4096 * 2,
                 A_XBC = A_PROJ + (size_t)R * NIN * 2, A_WGU2 = A_XBC + (size_t)R * 4096 * 2, A_END = A_WGU2 + (size_t)22016 * 4096 * 2, A_H = A_PROJ;
static_assert((size_t)R * DFF * 2 <= A_WGU2 - A_PROJ, "H overlay");
constexpr size_t WS_NEED = A_END;

constexpr int RING_BYTES = 131072, LDS_BYTES = 163840, MISC_OFF = LDS_BYTES - 256;

struct Args {
    const float* in[38]; float* out; unsigned char* ws; int ph_lo, ph_hi;
};
#define AS4 __attribute__((address_space(4)))
struct Ctx {
    LAS unsigned char* lds; int tid, lane, wave, G, bid;
    const float* const AS4* in; float* out; unsigned char* ws; unsigned* ctl;
};
extern __shared__ __attribute__((aligned(16))) unsigned char lds_raw[];
DI Ctx make_ctx() {
    Ctx F; int tid = threadIdx.x; asm volatile("" : "+v"(tid));
    const AS4 unsigned char* ka = (const AS4 unsigned char*)__builtin_amdgcn_kernarg_segment_ptr(); asm volatile("" : "+s"(ka));
    F.lds = (LAS unsigned char*)lds_raw; F.tid = tid; F.lane = tid & 63; F.wave = __builtin_amdgcn_readfirstlane(tid >> 6); F.G = gridDim.x; F.bid = blockIdx.x;
    F.in = (const float* const AS4*)ka; F.out = *(float* const AS4*)(ka + 38 * 8); F.ws = *(unsigned char* const AS4*)(ka + 39 * 8); F.ctl = (unsigned*)(F.ws + WS_CTL);
    return F;
}
enum { I_XP = 0, I_XS, I_MEM, I_CCKV, I_CKPE, I_SCONV, I_SSSM, I_CMK, I_CMV, I_NMIX, I_WIN, I_QNORM, I_WUQ, I_KVNORM, I_WUKV, I_QNN, I_QNP, I_KNN, I_KNP, I_CONVW, I_CONVB, I_DTB, I_ALOG, I_DSKIP,
       I_SSMN, I_WO, I_NXA, I_MEMN, I_WXQ, I_WXK, I_WXV, I_XNQ, I_XNK, I_WXO, I_NFFN, I_WG, I_WU, I_WD };

DI void p_prologue(const Ctx& F) {
    const int gw = F.bid * 8 + F.wave, NGW = F.G * 8, lane = F.lane;
    float* SS0 = (float*)F.ctl + CW_SS; float* SSM = (float*)F.ctl + CW_SSM;
    bf16* XB = (bf16*)(F.ws + A_XB); bf16* MB = (bf16*)(F.ws + A_MB);
    for (int row = gw; row < R + 2048; row += NGW) {
        const float* src; float* dstf = nullptr; bf16* dstb; float* ssp;
        if (row < RP) { src = F.in[I_XP] + (size_t)row * DM; dstb = XB + (size_t)row * DM; ssp = SS0 + row; }
        else if (row < R) { src = F.in[I_XS] + (size_t)(row - RP) * DM; dstb = XB + (size_t)row * DM; ssp = SS0 + row; }
        else { const int mr = row - R; src = F.in[I_MEM] + (size_t)mr * DM; dstb = MB + (size_t)mr * DM; ssp = SSM + mr; }
        float sq = 0.f;
#pragma unroll
        for (int j = 0; j < 8; ++j) {
            const f32x4 a = *(const f32x4*)(src + j * 512 + lane * 8), b = *(const f32x4*)(src + j * 512 + lane * 8 + 4);
            sq += (a[0] * a[0] + a[1] * a[1]) + (a[2] * a[2] + a[3] * a[3]) + (b[0] * b[0] + b[1] * b[1]) + (b[2] * b[2] + b[3] * b[3]);
            if (dstf) { *(f32x4*)(dstf + j * 512 + lane * 8) = a; *(f32x4*)(dstf + j * 512 + lane * 8 + 4) = b; }
            u32x4 w; w.x = pkbf(a[0], a[1]); w.y = pkbf(a[2], a[3]); w.z = pkbf(b[0], b[1]); w.w = pkbf(b[2], b[3]);
            *(u32x4*)(dstb + j * 512 + lane * 8) = w;
        }
        sq = wave_sum(sq);
        if (lane == 0) *ssp = sq;
    }
    float* ctab = (float*)(F.ws + WS_ROPE); float* stab = ctab + KVS * 32;
    for (int i = F.bid * 512 + F.tid; i < KVS * 32; i += F.G * 512) {
        const int pos = i >> 5, k = i & 31;
        const float inv = powf(10000.0f, -(float)k / 32.0f);
        const float ang = (float)pos * inv;
        ctab[i] = cosf(ang); stab[i] = sinf(ang);
    }
}

struct CvItem { const float* src; const float* gain; bf16* dst; int ldw, K, nvalid; };
DI CvItem cv_decode(const Ctx& F, int l, int it) {
    unsigned char* ws = F.ws; CvItem c; c.gain = nullptr; c.nvalid = 64;
    constexpr int N_IN = 122 * 64, N_UQ = 48 * 16, N_UKV = 64 * 8, N_O = 64 * 64, N_XQ = 8 * 64, N_XK = 8 * 64, N_XV = 8 * 64, N_XO = 64 * 8, N_G = 172 * 64, N_U = 172 * 64;
    int r = it;
    if (r < N_IN) { const int kb = r / 122, nb = r % 122, cc = nb * 64; int dr; if (cc < 1536) dr = cc; else if (cc < 1600) dr = PC_KPE; else if (cc < 3648) dr = PC_Z + (cc - 1600); else if (cc < 7744) dr = PC_XBC + (cc - 3648); else { dr = PC_DT; c.nvalid = 32; }
        c.src = F.in[I_WIN] + (size_t)l * 4096 * 7776 + (size_t)kb * 64 * 7776 + cc; c.ldw = 7776; c.gain = F.in[I_NMIX] + l * 4096 + kb * 64; c.K = 4096; c.dst = (bf16*)(ws + W_IN) + (size_t)dr * 4096 + kb * 64; return c; } r -= N_IN;
    if (r < N_UQ) { const int kb = r / 48, nb = r % 48; c.src = F.in[I_WUQ] + (size_t)l * 1024 * 3072 + (size_t)kb * 64 * 3072 + nb * 64; c.ldw = 3072; c.gain = F.in[I_QNORM] + l * 1024 + kb * 64; c.K = 1024; c.dst = (bf16*)(ws + W_UQ) + (size_t)nb * 64 * 1024 + kb * 64; return c; } r -= N_UQ;
    if (r < N_UKV) { const int kb = r / 64, nb = r % 64; c.src = F.in[I_WUKV] + (size_t)l * 512 * 4096 + (size_t)kb * 64 * 4096 + nb * 64; c.ldw = 4096; c.K = 512; c.dst = (bf16*)(ws + W_UKV) + (size_t)nb * 64 * 512 + kb * 64; return c; } r -= N_UKV;
    if (r < N_O) { const int kb = r / 64, nb = r % 64; c.src = F.in[I_WO] + (size_t)l * 4096 * 4096 + (size_t)kb * 64 * 4096 + nb * 64; c.ldw = 4096; c.K = 4096; c.dst = (bf16*)(ws + W_O) + (size_t)nb * 64 * 4096 + kb * 64; return c; } r -= N_O;
    if (r < N_XQ) { const int kb = r / 8, nb = r % 8; c.src = F.in[I_WXQ] + (size_t)l * 4096 * 512 + (size_t)kb * 64 * 512 + nb * 64; c.ldw = 512; c.gain = F.in[I_NXA] + l * 4096 + kb * 64; c.K = 4096; c.dst = (bf16*)(ws + W_XQ) + (size_t)nb * 64 * 4096 + kb * 64; return c; } r -= N_XQ;
    if (r < N_XK) { const int kb = r / 8, nb = r % 8; c.src = F.in[I_WXK] + (size_t)l * 4096 * 512 + (size_t)kb * 64 * 512 + nb * 64; c.ldw = 512; c.gain = F.in[I_MEMN] + l * 4096 + kb * 64; c.K = 4096; c.dst = (bf16*)(ws + W_XKV) + (size_t)nb * 64 * 4096 + kb * 64; return c; } r -= N_XK;
    if (r < N_XV) { const int kb = r / 8, nb = r % 8; c.src = F.in[I_WXV] + (size_t)l * 4096 * 512 + (size_t)kb * 64 * 512 + nb * 64; c.ldw = 512; c.gain = F.in[I_MEMN] + l * 4096 + kb * 64; c.K = 4096; c.dst = (bf16*)(ws + W_XKV) + (size_t)(512 + nb * 64) * 4096 + kb * 64; return c; } r -= N_XV;
    if (r < N_XO) { const int kb = r / 64, nb = r % 64; c.src = F.in[I_WXO] + (size_t)l * 512 * 4096 + (size_t)kb * 64 * 4096 + nb * 64; c.ldw = 4096; c.K = 512; c.dst = (bf16*)(ws + W_XO) + (size_t)nb * 64 * 512 + kb * 64; return c; } r -= N_XO;
    if (r < N_G) { const int kb = r / 172, nb = r % 172; c.src = F.in[I_WG] + (size_t)l * 4096 * DFF + (size_t)kb * 64 * DFF + nb * 64; c.ldw = DFF; c.gain = F.in[I_NFFN] + l * 4096 + kb * 64; c.K = 4096; c.dst = (bf16*)(ws + ((l & 1) ? A_WGU2 : W_GU)) + (size_t)((nb >> 1) * 256 + (nb & 1) * 64) * 4096 + kb * 64; return c; } r -= N_G;
    if (r < N_U) { const int kb = r / 172, nb = r % 172; c.src = F.in[I_WU] + (size_t)l * 4096 * DFF + (size_t)kb * 64 * DFF + nb * 64; c.ldw = DFF; c.gain = F.in[I_NFFN] + l * 4096 + kb * 64; c.K = 4096; c.dst = (bf16*)(ws + ((l & 1) ? A_WGU2 : W_GU)) + (size_t)((nb >> 1) * 256 + 128 + (nb & 1) * 64) * 4096 + kb * 64; return c; } r -= N_U;
    { const int kb = r / 64, nb = r % 64; c.src = F.in[I_WD] + (size_t)l * DFF * 4096 + (size_t)kb * 64 * 4096 + nb * 64; c.ldw = 4096; c.K = DFF; c.dst = (bf16*)(ws + W_DN) + (size_t)nb * 64 * DFF + kb * 64; return c; }
}
constexpr int CV_NITEMS = 122 * 64 + 48 * 16 + 64 * 8 + 64 * 64 + 3 * 8 * 64 + 64 * 8 + 2 * 172 * 64 + 64 * 172;
DI void cv_load(const CvItem& c, f32x4 (&v)[16], int lane) {
    const int n4 = (lane & 15) * 4, kr = lane >> 4; const float* p = c.src + (size_t)kr * c.ldw + n4;
    if (n4 < c.nvalid) {
#pragma unroll
        for (int i = 0; i < 16; ++i) v[i] = __builtin_nontemporal_load((const f32x4*)(p + (size_t)(4 * i) * c.ldw));
    } else {
#pragma unroll
        for (int i = 0; i < 16; ++i) v[i] = (f32x4){0.f, 0.f, 0.f, 0.f};
    }
}
DI void cv_store(const CvItem& c, const f32x4 (&v)[16], LAS unsigned char* scr, int lane) {
    constexpr int RS = 144;
    const int l15 = lane & 15, kr = lane >> 4;
#pragma unroll
    for (int i = 0; i < 16; ++i) { const int k = kr + 4 * i; const float g = c.gain ? c.gain[k] : 1.0f;
        u32x2 w; w.x = pkbf(v[i][0] * g, v[i][1] * g); w.y = pkbf(v[i][2] * g, v[i][3] * g);
        *(LAS u32x2*)(scr + k * RS + l15 * 8) = w; }
    asm volatile("s_waitcnt lgkmcnt(0)" ::: "memory");
    typedef short v4i16_t __attribute__((ext_vector_type(4)));
    const int g4 = lane >> 4, q = l15 >> 2, pp = lane & 3;
#pragma unroll
    for (int cb = 0; cb < 4; ++cb)
#pragma unroll
        for (int kh = 0; kh < 2; ++kh) {
            const LAS unsigned char* a = scr + (32 * kh + 8 * g4 + q) * RS + (16 * cb + 4 * pp) * 2;
            const s16x4 lo = __builtin_bit_cast(s16x4, __builtin_amdgcn_ds_read_tr16_b64_v4i16((LAS v4i16_t*)a));
            const s16x4 hi = __builtin_bit_cast(s16x4, __builtin_amdgcn_ds_read_tr16_b64_v4i16((LAS v4i16_t*)(a + 4 * RS)));
            const bf16x8 o = (bf16x8){lo[0], lo[1], lo[2], lo[3], hi[0], hi[1], hi[2], hi[3]};
            *(bf16x8*)(c.dst + (size_t)(16 * cb + l15) * c.K + 32 * kh + 8 * g4) = o; }
    asm volatile("s_waitcnt lgkmcnt(0)" ::: "memory");
}
constexpr int CV_E3 = 122 * 64 + 48 * 16 + 64 * 8 + 64 * 64 + 3 * 8 * 64 + 64 * 8;
constexpr int CV_GU0 = CV_E3, CV_GU3 = CV_E3 + 2 * 172 * 64, CV_GU1 = CV_GU3 - 7000;
static_assert(CV_GU3 == 37248, "gate/up item range");
constexpr int CV_A0 = 122 * 64 + 48 * 16 + 64 * 8;
constexpr int CV_AGU = 5000;
constexpr int CV_DX = 1500, CV_DG = 2500 + (CV_E3 - CV_A0);
#define CV_MAP(v_) ((v_) < n1 ? la : lb), ((v_) < n1 ? a0 + (v_) : b0 + ((v_) - n1))
#ifndef CV_TAILW
#define CV_TAILW 8
#endif
DI void p_convw_range(const Ctx& F, int la, int a0, int n1, int lb, int b0, int n2, int wg0, int nwg, int nwv = 8, int rank = -1) {
    if (F.wave >= nwv) return;
    LAS unsigned char* scr = F.lds + F.wave * 16384;
    const int gw = (rank >= 0 ? rank : F.bid - wg0) * nwv + F.wave, NGW = nwg * nwv, lane = F.lane;
    const int CV_END = n1 + n2;
    CvItem ca, cb, cc; f32x4 va[16], vb[16], vc[16];
    int nx = gw;
    bool ha = nx < CV_END; if (ha) { ca = cv_decode(F, CV_MAP(nx)); cv_load(ca, va, lane); } nx += NGW;
    bool hb = nx < CV_END; if (hb) { cb = cv_decode(F, CV_MAP(nx)); cv_load(cb, vb, lane); } nx += NGW;
    if (ha) for (;;) {
        const bool hc = nx < CV_END; if (hc) { cc = cv_decode(F, CV_MAP(nx)); cv_load(cc, vc, lane); } nx += NGW;
        cv_store(ca, va, scr, lane);
        if (!hb) break;
        ha = nx < CV_END; if (ha) { ca = cv_decode(F, CV_MAP(nx)); cv_load(ca, va, lane); } nx += NGW;
        cv_store(cb, vb, scr, lane);
        if (!hc) break;
        hb = nx < CV_END; if (hb) { cb = cv_decode(F, CV_MAP(nx)); cv_load(cb, vb, lane); } nx += NGW;
        cv_store(cc, vc, scr, lane);
        if (!ha) break;
    }
}
DI void p_convw(const Ctx& F, int l) {
    if (F.G == 256) { const int s0 = l > 0 ? CV_E3 : 0, s1 = l > 0 ? CV_E3 : CV_A0, d0 = CV_GU3 + CV_DX + CV_DG, d1 = l + 1 < NLAYER ? CV_NITEMS : d0; p_convw_range(F, l, s0, s1 - s0, l, d0, d1 - d0, 0, F.G); }
    else p_convw_range(F, l, 0, CV_NITEMS, l, 0, 0, 0, F.G);
    { unsigned zz = 0u; asm volatile("" : "+v"(zz));
      u32x4 z = {zz, zz, zz, zz}; u32x4* p = (u32x4*)(F.ws + W_IN + (size_t)7808 * 4096 * 2); const int n16 = 128 * 4096 * 2 / 16;
      for (int i = F.bid * 512 + F.tid; i < n16; i += F.G * 512) p[i] = z; }
}

DI void p_post1(const Ctx& F, int l) {
    const int gw = F.bid * 8 + F.wave, NGW = F.G * 8, lane = F.lane;
    unsigned char* ws = F.ws;
    const bf16* PROJ = (const bf16*)(ws + A_PROJ);
    bf16* CQN = (bf16*)(ws + A_CQN); bf16* CKV = (bf16*)(ws + A_CKV); bf16* KPE = (bf16*)(ws + A_KPE); bf16* XBC = (bf16*)(ws + A_XBC); float* DT = (float*)(ws + A_DT);
    const float* ctab = (const float*)(ws + WS_ROPE); const float* stab = ctab + KVS * 32;
    const float* kv_norm = F.in[I_KVNORM] + l * 512; const float* kn_pe = F.in[I_KNP] + l * 64;
    const float* conv_w = F.in[I_CONVW] + l * 4 * 4096; const float* conv_b = F.in[I_CONVB] + l * 4096; const float* dt_bias = F.in[I_DTB] + l * 32;
    f32x4 dk0, dk1, dv0, dv1;
    if (2048 + gw < 4096) { const float* kp = F.in[I_CMK] + ((size_t)l * 2048 + gw) * 512 + lane * 8; dk0 = *(const f32x4*)kp; dk1 = *(const f32x4*)(kp + 4);
        const float* vp = F.in[I_CMV] + ((size_t)l * 2048 + gw) * 512 + lane * 8; dv0 = *(const f32x4*)vp; dv1 = *(const f32x4*)(vp + 4); }
    u32x4 nq0, nq1, nkv; bf16 nk, nd;
#define P1_LOAD(row_) do { const bf16* pr_ = PROJ + (size_t)(row_) * NIN; nq0 = *(const u32x4*)(pr_ + lane * 8); nq1 = *(const u32x4*)(pr_ + 512 + lane * 8); nkv = *(const u32x4*)(pr_ + 1024 + lane * 8); \
        nk = pr_[PC_KPE + lane]; nd = pr_[PC_DT + (lane & 31)]; } while (0)
    f32x4 nc0, nc1; float nkp;
#define P1_CLOAD(i_) do { const int b_ = (i_) >> 11, s_ = (i_) & 2047; const float* cp_ = F.in[I_CCKV] + ((size_t)(l * 8 + b_) * PAST + s_) * 512 + lane * 8; \
        nc0 = *(const f32x4*)cp_; nc1 = *(const f32x4*)(cp_ + 4); nkp = F.in[I_CKPE][((size_t)(l * 8 + b_) * PAST + s_) * 64 + lane]; } while (0)
    if (gw < R) P1_LOAD(gw);
    if (gw < 8 * PAST) P1_CLOAD(gw);
    for (int row = gw; row < R; row += NGW) {
        const bool samp = row >= RP; const int b = samp ? (row - RP) >> 6 : row >> 11, t = samp ? (row - RP) & 63 : row & 2047;
        const int pos = samp ? PAST + t : t; const int kvrow = samp ? RP + b * KVS + PAST + t : row;
        const u32x4 cq0 = nq0, cq1 = nq1, ckv = nkv; const bf16 ck = nk, cd = nd;
        const f32x4 cc0 = nc0, cc1 = nc1; const float ckp = nkp;
        if (row + NGW < R) P1_LOAD(row + NGW);
        if (row + NGW < 8 * PAST) P1_CLOAD(row + NGW);
        const float cs_c = ctab[pos * 32 + (lane & 31)], cs_s = stab[pos * 32 + (lane & 31)];
        {   float f0[8], f1[8]; unpack8(cq0, f0); unpack8(cq1, f1);
            float sq = 0.f;
#pragma unroll
            for (int j = 0; j < 8; ++j) sq += f0[j] * f0[j] + f1[j] * f1[j];
            const float rs = __builtin_amdgcn_rsqf(wave_sum(sq) * (1.0f / 1024.0f) + EPS);
#pragma unroll
            for (int j = 0; j < 8; ++j) { f0[j] *= rs; f1[j] *= rs; }
            *(u32x4*)(CQN + (size_t)row * 1024 + lane * 8) = pack8(f0); *(u32x4*)(CQN + (size_t)row * 1024 + 512 + lane * 8) = pack8(f1); }
        {   float f0[8]; unpack8(ckv, f0);
            float sq = 0.f;
#pragma unroll
            for (int j = 0; j < 8; ++j) sq += f0[j] * f0[j];
            const float rs = __builtin_amdgcn_rsqf(wave_sum(sq) * (1.0f / 512.0f) + EPS);
#pragma unroll
            for (int j = 0; j < 8; ++j) f0[j] *= rs * kv_norm[lane * 8 + j];
            float* op = samp ? F.out + O_CKV_S + ((size_t)(l * 8 + b) * 64 + t) * 512 : F.out + O_CKV_P + ((size_t)(l * 8 + b) * 2048 + t) * 512;
            *(f32x4*)(op + lane * 8) = (f32x4){f0[0], f0[1], f0[2], f0[3]}; *(f32x4*)(op + lane * 8 + 4) = (f32x4){f0[4], f0[5], f0[6], f0[7]};
            *(u32x4*)(CKV + (size_t)kvrow * 512 + lane * 8) = pack8(f0); }
        {   const float x = bf2f(ck);
            const float rs = __builtin_amdgcn_rsqf(wave_sum(x * x) * (1.0f / 64.0f) + EPS);
            const float xn = x * rs * kn_pe[lane]; const float other = __shfl_xor(xn, 32);
            const float o = lane < 32 ? xn * cs_c - other * cs_s : other * cs_s + xn * cs_c;
            float* op = samp ? F.out + O_KPE_S + ((size_t)(l * 8 + b) * 64 + t) * 64 : F.out + O_KPE_P + ((size_t)(l * 8 + b) * 2048 + t) * 64;
            op[lane] = o; KPE[(size_t)kvrow * 64 + lane] = f2bf(o); }
        if (lane < 32) { const float v = bf2f(cd) + dt_bias[lane]; DT[(size_t)row * 32 + lane] = v > 20.f ? v : 0.6931471805599453f * __builtin_amdgcn_logf(1.0f + __builtin_amdgcn_exp2f(1.4426950408889634f * v)); }
        if (row < 8 * PAST) { const int cb_ = row >> 11, cs_ = row & 2047; const size_t ckr = (size_t)RP + cb_ * KVS + cs_;
            u32x4 w; w.x = pkbf(cc0[0], cc0[1]); w.y = pkbf(cc0[2], cc0[3]); w.z = pkbf(cc1[0], cc1[1]); w.w = pkbf(cc1[2], cc1[3]);
            *(u32x4*)(CKV + ckr * 512 + lane * 8) = w; KPE[ckr * 64 + lane] = f2bf(ckp); }
    }
#undef P1_LOAD
#undef P1_CLOAD
    const int cvc = (gw & 7) * 512 + lane * 8;
    u32x4 xn[11];
#define P1_XLOAD(it_) do { const int rb_ = (it_) >> 3, r0_ = rb_ * 8; const bool samp_ = r0_ >= RP; const int b_ = samp_ ? (r0_ - RP) >> 6 : r0_ >> 11, t0_ = samp_ ? (r0_ - RP) & 63 : r0_ & 2047; \
        _Pragma("unroll") for (int i = 0; i < 11; ++i) { const int tt = t0_ - 3 + i; \
            if (tt >= 0) xn[i] = *(const u32x4*)(PROJ + (size_t)(r0_ - 3 + i) * NIN + PC_XBC + cvc); \
            else if (samp_) { const float* sp = F.in[I_SCONV] + ((size_t)(l * 8 + b_) * 3 + (tt + 3)) * 4096 + cvc; const f32x4 a0 = *(const f32x4*)sp, a1 = *(const f32x4*)(sp + 4); \
                xn[i].x = pkbf(a0[0], a0[1]); xn[i].y = pkbf(a0[2], a0[3]); xn[i].z = pkbf(a1[0], a1[1]); xn[i].w = pkbf(a1[2], a1[3]); } \
            else xn[i] = (u32x4){0u, 0u, 0u, 0u}; } } while (0)
    const int NCI = (R / 8) * 8;
    if (gw < NCI) P1_XLOAD(gw);
    float wt[4][8], bs[8];
    {   const int c = cvc;
#pragma unroll
        for (int i = 0; i < 4; ++i) { const f32x4 w0 = *(const f32x4*)(conv_w + i * 4096 + c), w1 = *(const f32x4*)(conv_w + i * 4096 + c + 4);
            wt[i][0] = w0[0]; wt[i][1] = w0[1]; wt[i][2] = w0[2]; wt[i][3] = w0[3]; wt[i][4] = w1[0]; wt[i][5] = w1[1]; wt[i][6] = w1[2]; wt[i][7] = w1[3]; }
        { const f32x4 b0 = *(const f32x4*)(conv_b + c), b1 = *(const f32x4*)(conv_b + c + 4); bs[0] = b0[0]; bs[1] = b0[1]; bs[2] = b0[2]; bs[3] = b0[3]; bs[4] = b1[0]; bs[5] = b1[1]; bs[6] = b1[2]; bs[7] = b1[3]; } }
    for (int it = gw; it < NCI; it += NGW) {
        const int rb = it >> 3, r0 = rb * 8, c = cvc;
        const bool samp = r0 >= RP; const int b = samp ? (r0 - RP) >> 6 : r0 >> 11, t0 = samp ? (r0 - RP) & 63 : r0 & 2047, L = samp ? DSEQ : SEQ;
        u32x4 xr[11];
#pragma unroll
        for (int i = 0; i < 11; ++i) xr[i] = xn[i];
        if (it + NGW < NCI) P1_XLOAD(it + NGW);
#pragma unroll
        for (int j = 0; j < 8; ++j) {
            float acc[8];
#pragma unroll
            for (int e = 0; e < 8; ++e) acc[e] = bs[e];
#pragma unroll
            for (int i = 0; i < 4; ++i) { float xv[8]; unpack8(xr[j + i], xv);
#pragma unroll
                for (int e = 0; e < 8; ++e) acc[e] += xv[e] * wt[i][e]; }
#pragma unroll
            for (int e = 0; e < 8; ++e) acc[e] = silu_f(acc[e]);
            *(u32x4*)(XBC + (size_t)(r0 + j) * 4096 + c) = pack8(acc);
            if (t0 + j >= L - 3) { float xv[8]; unpack8(xr[j + 3], xv);
                float* op = (samp ? F.out + O_CONV_S : F.out + O_CONV_P) + ((size_t)(l * 8 + b) * 3 + (t0 + j - (L - 3))) * 4096 + c;
                *(f32x4*)op = (f32x4){xv[0], xv[1], xv[2], xv[3]}; *(f32x4*)(op + 4) = (f32x4){xv[4], xv[5], xv[6], xv[7]}; }
        }
    }
    {   bf16* MEMK = (bf16*)(ws + A_MEMK); bf16* MEMV = (bf16*)(ws + A_MEMV);
        for (int row = 2048 + gw; row < 4096; row += NGW) {
            if (row != 2048 + gw) {
                const int mr = row - 2048;
                const float* kp = F.in[I_CMK] + ((size_t)l * 2048 + mr) * 512 + lane * 8; dk0 = *(const f32x4*)kp; dk1 = *(const f32x4*)(kp + 4);
                const float* vp = F.in[I_CMV] + ((size_t)l * 2048 + mr) * 512 + lane * 8; dv0 = *(const f32x4*)vp; dv1 = *(const f32x4*)(vp + 4);
            }
            u32x4 w; w.x = pkbf(dk0[0], dk0[1]); w.y = pkbf(dk0[2], dk0[3]); w.z = pkbf(dk1[0], dk1[1]); w.w = pkbf(dk1[2], dk1[3]);
            *(u32x4*)(MEMK + (size_t)row * 512 + lane * 8) = w;
            w.x = pkbf(dv0[0], dv0[1]); w.y = pkbf(dv0[2], dv0[3]); w.z = pkbf(dv1[0], dv1[1]); w.w = pkbf(dv1[2], dv1[3]);
            *(u32x4*)(MEMV + (size_t)row * 512 + lane * 8) = w;
        }
    }
}

DI void p_gnorm(const Ctx& F, int l) {
    const int gw = F.bid * 8 + F.wave, NGW = F.G * 8, lane = F.lane;
    const bf16* YG = (const bf16*)(F.ws + A_YG); bf16* MIX = (bf16*)(F.ws + A_MIX);
    const float* sn = F.in[I_SSMN] + l * 2048;
    for (int row = gw; row < R; row += NGW) {
        u32x4 w[4];
#pragma unroll
        for (int p = 0; p < 4; ++p) w[p] = *(const u32x4*)(YG + (size_t)row * 2048 + p * 512 + lane * 8);
#pragma unroll
        for (int p = 0; p < 4; ++p) {
            float f[8]; unpack8(w[p], f); float sq = 0.f;
#pragma unroll
            for (int j = 0; j < 8; ++j) sq += f[j] * f[j];
            sq += __shfl_xor(sq, 1); sq += __shfl_xor(sq, 2); sq += __shfl_xor(sq, 4); sq += __shfl_xor(sq, 8); sq += __shfl_xor(sq, 16);
            const float rs = __builtin_amdgcn_rsqf(sq * (1.0f / 256.0f) + EPS);
            const int c = p * 512 + lane * 8; const f32x4 g0 = *(const f32x4*)(sn + c), g1 = *(const f32x4*)(sn + c + 4);
            f[0] *= rs * g0[0]; f[1] *= rs * g0[1]; f[2] *= rs * g0[2]; f[3] *= rs * g0[3]; f[4] *= rs * g1[0]; f[5] *= rs * g1[1]; f[6] *= rs * g1[2]; f[7] *= rs * g1[3];
            *(u32x4*)(MIX + (size_t)row * 4096 + 2048 + c) = pack8(f);
        }
    }
}

namespace att {
#define KSWZ(row, colB) ((row) * 256 + ((colB) ^ (((row) & 7) << 4)))
#define PSWZ(row, colB) ((row) * 128 + ((colB) ^ (((row) & 7) << 4)))
#define SBAR() __builtin_amdgcn_sched_barrier(0)
constexpr int SHM_K = 16384, SHM_V = 16384, SHM_P = 8192, BUF = SHM_K + SHM_V + SHM_P, NBUF = 3, WSOFF = NBUF * BUF, QPOFF = WSOFF + 2048, ATT_END = QPOFF + 32768;
DI int crow(int r, int hi) { return (r & 3) + 8 * (r >> 2) + 4 * hi; }
DI int v_st(int k, int c) { const int kk = (k & ~0xC) | ((k & 4) << 1) | ((k & 8) >> 1); return ((kk >> 3) * 4 + (c >> 5)) * 512 + ((kk & 7) * 32 + (c & 31)) * 2; }
DI int v_rd_base(int lane) { return ((lane & 3) << 3) | (((lane >> 2) & 3) << 6) | (((lane >> 4) & 1) << 5) | (((lane >> 5) & 1) << 8); }
constexpr int v_rd_off(int d0, int ks, int half) { return d0 * 512 + ks * 4096 + half * 2048; }
template <int OFF> DI s16x4 tr_read(int vb) { s16x4 r; asm volatile("ds_read_b64_tr_b16 %0, %1 offset:%2" : "=&v"(r) : "v"(vb), "i"(OFF) : "memory"); return r; }
struct VFrag { s16x4 l0, h0, l1, h1, l2, h2, l3, h3; };
template <int D0> DI void v_read(VFrag& f, int vb) {
    f.l0 = tr_read<v_rd_off(D0, 0, 0)>(vb); f.h0 = tr_read<v_rd_off(D0, 0, 1)>(vb); f.l1 = tr_read<v_rd_off(D0, 1, 0)>(vb); f.h1 = tr_read<v_rd_off(D0, 1, 1)>(vb);
    f.l2 = tr_read<v_rd_off(D0, 2, 0)>(vb); f.h2 = tr_read<v_rd_off(D0, 2, 1)>(vb); f.l3 = tr_read<v_rd_off(D0, 3, 0)>(vb); f.h3 = tr_read<v_rd_off(D0, 3, 1)>(vb);
}
DI void pv_mma(f32x16& od, const VFrag& f, bf16x8 pa0, bf16x8 pa1, bf16x8 pa2, bf16x8 pa3) {
#define PKV(L, H) (bf16x8){L[0], L[1], L[2], L[3], H[0], H[1], H[2], H[3]}
    od = __builtin_amdgcn_mfma_f32_32x32x16_bf16(pa0, PKV(f.l0, f.h0), od, 0, 0, 0);
    od = __builtin_amdgcn_mfma_f32_32x32x16_bf16(pa1, PKV(f.l1, f.h1), od, 0, 0, 0);
    od = __builtin_amdgcn_mfma_f32_32x32x16_bf16(pa2, PKV(f.l2, f.h2), od, 0, 0, 0);
    od = __builtin_amdgcn_mfma_f32_32x32x16_bf16(pa3, PKV(f.l3, f.h3), od, 0, 0, 0);
#undef PKV
}
DI void pv_all(f32x16* o, int vb, bf16x8 pa0, bf16x8 pa1, bf16x8 pa2, bf16x8 pa3) {
    VFrag fa, fb;
    v_read<0>(fa, vb);
    v_read<1>(fb, vb); asm volatile("s_waitcnt lgkmcnt(8)" ::: "memory"); SBAR(); pv_mma(o[0], fa, pa0, pa1, pa2, pa3); SBAR();
    v_read<2>(fa, vb); asm volatile("s_waitcnt lgkmcnt(8)" ::: "memory"); SBAR(); pv_mma(o[1], fb, pa0, pa1, pa2, pa3); SBAR();
    v_read<3>(fb, vb); asm volatile("s_waitcnt lgkmcnt(8)" ::: "memory"); SBAR(); pv_mma(o[2], fa, pa0, pa1, pa2, pa3); SBAR();
    asm volatile("s_waitcnt lgkmcnt(0)" ::: "memory"); SBAR(); pv_mma(o[3], fb, pa0, pa1, pa2, pa3);
}
template <int DPE, int ABL = 0>
DI void attn_unit(LAS unsigned char* lds, const bf16* Qrow, const bf16* Kn, int ldk, const bf16* Kp, const bf16* Vh, int ldv, bf16* Ow, int ldo,
                  int NT, int wnt, bool active, float scale, const float* g_nope, const float* g_pe, const float* ctab, const float* stab, int pos, int tid) {
    const int wid = __builtin_amdgcn_readfirstlane(tid >> 6), lane = tid & 63, r32 = lane & 31, hi = lane >> 5;
    LAS float* li_l = (LAS float*)(lds + WSOFF) + wid * 64; LAS float* al_l = li_l + 32;
    const float C = scale * 1.4426950408889634f;
    constexpr int NQ = 8 + DPE / 16;
    bf16x8 qr[8];
    LAS unsigned char* qpl = lds + QPOFF + wid * 4096 + lane * 16;
    if (active) {
        const bf16* Qw = Qrow + hi * 8;
        if constexpr (DPE == 64) {
            float pe[4][8]; float sp = 0.f;
#pragma unroll
            for (int db = 0; db < 4; ++db) { const u32x4 rw = *(const u32x4*)(Qw + 128 + db * 16); unpack8(rw, pe[db]);
#pragma unroll
                for (int j = 0; j < 8; ++j) sp += pe[db][j] * pe[db][j]; }
            sp += __shfl_xor(sp, 32);
            const float rp = __builtin_amdgcn_rsqf(sp * (1.0f / 64.0f) + EPS);
#pragma unroll
            for (int db = 0; db < 2; ++db) { const int i0 = db * 16 + hi * 8; float o1[8], o2[8];
#pragma unroll
                for (int j = 0; j < 8; ++j) { const float x1 = pe[db][j] * rp * g_pe[i0 + j], x2 = pe[db + 2][j] * rp * g_pe[32 + i0 + j];
                    const float cj = ctab[pos * 32 + i0 + j], sj = stab[pos * 32 + i0 + j]; o1[j] = x1 * cj - x2 * sj; o2[j] = x1 * sj + x2 * cj; }
                const u32x4 w1 = pack8(o1), w2 = pack8(o2); *(LAS u32x4*)(qpl + 1024 * db) = w1; *(LAS u32x4*)(qpl + 1024 * (2 + db)) = w2; }
            asm volatile("" ::: "memory");
        }
        float sq = 0.f; u32x4 raw[8];
#pragma unroll
        for (int d0 = 0; d0 < 8; ++d0) raw[d0] = *(const u32x4*)(Qw + d0 * 16);
#pragma unroll
        for (int d0 = 0; d0 < 8; ++d0) { float f[8]; unpack8(raw[d0], f);
#pragma unroll
            for (int j = 0; j < 8; ++j) sq += f[j] * f[j]; }
        sq += __shfl_xor(sq, 32);
        const float rs = __builtin_amdgcn_rsqf(sq * (1.0f / 128.0f) + EPS);
#pragma unroll
        for (int d0 = 0; d0 < 8; ++d0) { float f[8]; unpack8(raw[d0], f); const int c = d0 * 16 + hi * 8;
            const f32x4 g0 = *(const f32x4*)(g_nope + c), g1 = *(const f32x4*)(g_nope + c + 4);
            f[0] *= rs * g0[0]; f[1] *= rs * g0[1]; f[2] *= rs * g0[2]; f[3] *= rs * g0[3]; f[4] *= rs * g1[0]; f[5] *= rs * g1[1]; f[6] *= rs * g1[2]; f[7] *= rs * g1[3];
            const u32x4 w = pack8(f); qr[d0] = __builtin_bit_cast(bf16x8, w); }
    } else {
#pragma unroll
        for (int d0 = 0; d0 < 8; ++d0) qr[d0] = (bf16x8){0, 0, 0, 0, 0, 0, 0, 0};
    }
    int offK[2], offV[2], offP;
#pragma unroll
    for (int i = 0; i < 2; ++i) { const int ob = i * 8192 + wid * 1024 + lane * 16;
        { const int row = ob >> 8, cb = (ob & 255) ^ ((row & 7) << 4); offK[i] = row * ldk * 2 + cb; }
        { const int sub = ob >> 9, kk = (sub >> 2) * 8 + ((ob & 511) >> 6), k = (kk & ~0xC) | ((kk & 4) << 1) | ((kk & 8) >> 1), cc = (sub & 3) * 32 + ((ob & 63) >> 1); offV[i] = k * ldv * 2 + cc * 2; } }
    { const int ob = wid * 1024 + lane * 16, row = ob >> 7, cb = (ob & 127) ^ ((row & 7) << 4); offP = row * 128 + cb; }
    const int vb0 = (int)(uintptr_t)(lds + SHM_K) + v_rd_base(lane);
    const int sw_ = (r32 & 7) << 4;
    const int ka0 = r32 * 256 + ((0 * 32 + hi * 16) ^ sw_), ka1 = r32 * 256 + ((1 * 32 + hi * 16) ^ sw_), ka2 = r32 * 256 + ((2 * 32 + hi * 16) ^ sw_), ka3 = r32 * 256 + ((3 * 32 + hi * 16) ^ sw_);
    const int pa_0 = r32 * 128 + ((0 * 32 + hi * 16) ^ sw_), pa_1 = r32 * 128 + ((1 * 32 + hi * 16) ^ sw_), pa_2 = r32 * 128 + ((2 * 32 + hi * 16) ^ sw_), pa_3 = r32 * 128 + ((3 * 32 + hi * 16) ^ sw_);
#define STAGE(j_, b_) do { const size_t k0_ = (size_t)(j_) * 64; const char* kb_ = (const char*)Kn + k0_ * ldk * 2; const char* vbp_ = (const char*)Vh + k0_ * ldv * 2; LAS unsigned char* bb_ = lds + (b_) * BUF + wid * 1024; \
        __builtin_amdgcn_global_load_lds((const unsigned*)(kb_ + offK[0]), (LAS unsigned*)(bb_), 16, 0, 0); __builtin_amdgcn_global_load_lds((const unsigned*)(kb_ + offK[1]), (LAS unsigned*)(bb_ + 8192), 16, 0, 0); \
        __builtin_amdgcn_global_load_lds((const unsigned*)(vbp_ + offV[0]), (LAS unsigned*)(bb_ + SHM_K), 16, 0, 0); __builtin_amdgcn_global_load_lds((const unsigned*)(vbp_ + offV[1]), (LAS unsigned*)(bb_ + SHM_K + 8192), 16, 0, 0); \
        if constexpr (DPE == 64) __builtin_amdgcn_global_load_lds((const unsigned*)((const char*)Kp + k0_ * 128 + offP), (LAS unsigned*)(bb_ + SHM_K + SHM_V), 16, 0, 0); } while (0)
    constexpr int NLD = DPE == 64 ? 5 : 4;
#define STAGE_WAIT1() do { if constexpr (NLD == 5) asm volatile("s_waitcnt vmcnt(5)" ::: "memory"); else asm volatile("s_waitcnt vmcnt(4)" ::: "memory"); __builtin_amdgcn_s_barrier(); asm volatile("" ::: "memory"); } while (0)
#define STAGE_WAIT0() do { asm volatile("s_waitcnt vmcnt(0)" ::: "memory"); __builtin_amdgcn_s_barrier(); asm volatile("" ::: "memory"); } while (0)
    if constexpr (ABL != 4) { STAGE(0, 0); if (NT > 1) STAGE(1, 1); } if (NT > 1) STAGE_WAIT1(); else STAGE_WAIT0();
    float m_reg = -1e30f, l_reg = 0.f; f32x16 o[4];
#pragma unroll
    for (int d = 0; d < 4; ++d)
#pragma unroll
        for (int r = 0; r < 16; ++r) o[d][r] = 0.f;
    const float thr_raw = 8.0f / scale;
    int buf = 0;
    for (int j = 0; j < NT; ++j) {
        const int bn2 = buf == 0 ? 2 : buf - 1;
        if constexpr (ABL != 4) { if (j + 2 < NT) STAGE(j + 2, bn2); }
        if (active && j < wnt) {
            const LAS unsigned char* Ks = lds + buf * BUF; const LAS unsigned char* Ps = Ks + SHM_K + SHM_V;
            f32x16 p0, p1;
#pragma unroll
            for (int r = 0; r < 16; ++r) { p0[r] = 0.f; p1[r] = 0.f; }
            if constexpr (ABL != 3) {
            const int kbo = (int)(uintptr_t)Ks;
            bf16x8 fa0, fa1, fb0, fb1;
#define KRD(dst, addr, off) asm volatile("ds_read_b128 %0, %1 offset:%2" : "=&v"(dst) : "v"(addr), "i"(off) : "memory")
#define KRD2(f0, f1, ka_, m_) do { KRD(f0, kbo + ka_, (m_) * 128); KRD(f1, kbo + ka_, (m_) * 128 + 8192); } while (0)
#define KMMA(f0, f1, q_) do { p0 = __builtin_amdgcn_mfma_f32_32x32x16_bf16(f0, q_, p0, 0, 0, 0); p1 = __builtin_amdgcn_mfma_f32_32x32x16_bf16(f1, q_, p1, 0, 0, 0); } while (0)
#define KWAIT(n_) do { asm volatile("s_waitcnt lgkmcnt(" #n_ ")" ::: "memory"); SBAR(); } while (0)
            KRD2(fa0, fa1, ka0, 0); KRD2(fb0, fb1, ka1, 0);
            KWAIT(2); KMMA(fa0, fa1, qr[0]); SBAR(); KRD2(fa0, fa1, ka2, 0);
            KWAIT(2); KMMA(fb0, fb1, qr[1]); SBAR(); KRD2(fb0, fb1, ka3, 0);
            KWAIT(2); KMMA(fa0, fa1, qr[2]); SBAR(); KRD2(fa0, fa1, ka0, 1);
            KWAIT(2); KMMA(fb0, fb1, qr[3]); SBAR(); KRD2(fb0, fb1, ka1, 1);
            KWAIT(2); KMMA(fa0, fa1, qr[4]); SBAR(); KRD2(fa0, fa1, ka2, 1);
            KWAIT(2); KMMA(fb0, fb1, qr[5]); SBAR(); KRD2(fb0, fb1, ka3, 1);
            if constexpr (DPE == 64) {
                const int pbo = (int)(uintptr_t)Ps; const int qpo = (int)(uintptr_t)qpl; bf16x8 qfa, qfb;
#define PRD3(f0, f1, qf, pa_, d_) do { KRD(f0, pbo + pa_, 0); KRD(f1, pbo + pa_, 4096); KRD(qf, qpo, (d_) * 1024); } while (0)
                KWAIT(2); KMMA(fa0, fa1, qr[6]); SBAR(); PRD3(fa0, fa1, qfa, pa_0, 0);
                KWAIT(3); KMMA(fb0, fb1, qr[7]); SBAR(); PRD3(fb0, fb1, qfb, pa_1, 1);
                KWAIT(3); KMMA(fa0, fa1, qfa); SBAR(); PRD3(fa0, fa1, qfa, pa_2, 2);
                KWAIT(3); KMMA(fb0, fb1, qfb); SBAR(); PRD3(fb0, fb1, qfb, pa_3, 3);
                KWAIT(3); KMMA(fa0, fa1, qfa); SBAR();
                KWAIT(0); KMMA(fb0, fb1, qfb);
#undef PRD3
            } else {
                KWAIT(2); KMMA(fa0, fa1, qr[6]); SBAR();
                KWAIT(0); KMMA(fb0, fb1, qr[7]);
            }
#undef KRD
#undef KRD2
#undef KMMA
#undef KWAIT
            } else { asm volatile("" : "+v"(p0), "+v"(p1)); }
            float alpha = 1.f;
            if constexpr (ABL != 1) {
            float pmax = p0[0];
#pragma unroll
            for (int r = 1; r < 16; ++r) pmax = fmaxf(pmax, p0[r]);
#pragma unroll
            for (int r = 0; r < 16; ++r) pmax = fmaxf(pmax, p1[r]);
            { auto rr = __builtin_amdgcn_permlane32_swap(__float_as_uint(pmax), __float_as_uint(pmax), false, false); pmax = fmaxf(__uint_as_float(rr[0]), __uint_as_float(rr[1])); }
            float mn;
            if (__all(pmax - m_reg <= thr_raw)) { mn = m_reg; alpha = 1.f; }
            else { mn = fmaxf(m_reg, pmax); alpha = __builtin_amdgcn_exp2f((m_reg - mn) * C); m_reg = mn; }
            const float mnC = -mn * C;
#pragma unroll
            for (int r = 0; r < 16; ++r) { p0[r] = __builtin_amdgcn_exp2f(fmaf(p0[r], C, mnC)); p1[r] = __builtin_amdgcn_exp2f(fmaf(p1[r], C, mnC)); }
            float ps = 0.f;
#pragma unroll
            for (int r = 0; r < 16; ++r) ps += p0[r] + p1[r];
            { auto rr = __builtin_amdgcn_permlane32_swap(__float_as_uint(ps), __float_as_uint(ps), false, false); ps = __uint_as_float(rr[0]) + __uint_as_float(rr[1]); }
            l_reg = l_reg * alpha + ps;
            }
            bf16x8 pa0, pa1, pa2, pa3;
#define PK4(P, BASE, OUT) do { unsigned a0 = pkbf(P[BASE + 0], P[BASE + 1]), a1 = pkbf(P[BASE + 2], P[BASE + 3]); \
        unsigned b0_ = pkbf(P[BASE + 4], P[BASE + 5]), b1_ = pkbf(P[BASE + 6], P[BASE + 7]); \
        auto r0 = __builtin_amdgcn_permlane32_swap(a0, b0_, false, false); auto r1 = __builtin_amdgcn_permlane32_swap(a1, b1_, false, false); \
        u32x4 w_ = {r0[0], r1[0], r0[1], r1[1]}; OUT = __builtin_bit_cast(bf16x8, w_); } while (0)
            PK4(p0, 0, pa0); PK4(p0, 8, pa1); PK4(p1, 0, pa2); PK4(p1, 8, pa3);
#undef PK4
            if (__any(alpha < 1.f)) { if (hi == 0) al_l[r32] = alpha; asm volatile("s_waitcnt lgkmcnt(0)" ::: "memory");
#pragma unroll
                for (int r = 0; r < 16; ++r) { const float a = al_l[crow(r, hi)];
#pragma unroll
                    for (int d = 0; d < 4; ++d) o[d][r] *= a; } }
            const int vb = vb0 + buf * BUF;
            if constexpr (ABL != 2) pv_all(o, vb, pa0, pa1, pa2, pa3); else asm volatile("" :: "v"(pa0), "v"(pa1), "v"(pa2), "v"(pa3), "v"(vb));
        }
        asm volatile("s_waitcnt lgkmcnt(0)" ::: "memory");
        if (j + 2 < NT) STAGE_WAIT1(); else STAGE_WAIT0();
        buf = buf == 2 ? 0 : buf + 1;
    }
#undef STAGE
#undef STAGE_WAIT0
#undef STAGE_WAIT1
    if (active) {
        if (hi == 0) li_l[r32] = l_reg;
        asm volatile("s_waitcnt lgkmcnt(0)" ::: "memory");
        int le = lane; asm volatile("" : "+v"(le));
        const int r32e = le & 31, hie = le >> 5;
        bf16* Owl = Ow + r32e;
#pragma unroll
        for (int r = 0; r < 16; ++r) { const int orow = crow(r, hie); const float rl = __builtin_amdgcn_rcpf(li_l[orow]); bf16* orp = Owl + (size_t)orow * ldo;
#pragma unroll
            for (int d0 = 0; d0 < 4; ++d0) orp[d0 * 32] = f2bf(o[d0][r] * rl); }
    }
    __syncthreads();
}
}

namespace ssd {
constexpr int RSC = 272, RSX = 144;
constexpr int CS = 0, BS = CS + 64 * RSC, XD = BS + 64 * RSC, XW = XD + 64 * RSX, TSET = XW + 64 * RSX, LS = 2 * TSET, HS = LS + 64 * RSX, HSET = 64 * RSC, END = HS + 2 * HSET;
typedef short v4i16_t __attribute__((ext_vector_type(4)));
DI s16x4 vtr(const LAS unsigned char* p) { return __builtin_bit_cast(s16x4, __builtin_amdgcn_ds_read_tr16_b64_v4i16((LAS v4i16_t*)p)); }
DI bf16x8 tr_frag(const LAS unsigned char* tile, int rsb, int jb, int col0, int lane) {
    const int g = lane >> 4, q = (lane & 15) >> 2, pp = lane & 3;
    const LAS unsigned char* a = tile + (jb + 8 * g + q) * rsb + (col0 + 4 * pp) * 2;
    const s16x4 lo = vtr(a), hi = vtr(a + 4 * rsb);
    return (bf16x8){lo[0], lo[1], lo[2], lo[3], hi[0], hi[1], hi[2], hi[3]};
}
DI bf16x8 row_frag(const LAS unsigned char* tile, int rsb, int row, int k0, int lane) {
    return *(const LAS bf16x8*)(tile + row * rsb + (k0 + 8 * (lane >> 4)) * 2);
}
DI float wave_iscan(float v) {
#define SSD_DPP_ADD(ctrl_, rmask_) v += __builtin_bit_cast(float, __builtin_amdgcn_update_dpp(0, __builtin_bit_cast(int, v), (ctrl_), (rmask_), 0xf, false))
    SSD_DPP_ADD(0x111, 0xf); SSD_DPP_ADD(0x112, 0xf); SSD_DPP_ADD(0x114, 0xf); SSD_DPP_ADD(0x118, 0xf);
    SSD_DPP_ADD(0x142, 0xa);
    SSD_DPP_ADD(0x143, 0xc);
#undef SSD_DPP_ADD
    return v;
}
#define MFMA16(a, b, c) __builtin_amdgcn_mfma_f32_16x16x32_bf16((a), (b), (c), 0, 0, 0)

DI void ssd_unit(LAS unsigned char* lds, const bf16* XBC, const float* DT, const bf16* PROJ, bf16* YG, int rb, int NC, int h, float A, float Dsk, const float* h0, float* hout, int tid) {
    const int wid = tid >> 6, lane = tid & 63, l15 = lane & 15, quad = lane >> 4;
    const int g = h >> 2;
    const int pbk = wid & 3, nb0 = 4 * (wid >> 2);
    f32x4 hacc[4];
#pragma unroll
    for (int t = 0; t < 4; ++t) {
        hacc[t] = h0 ? *(const f32x4*)(h0 + (16 * pbk + l15) * 128 + 16 * (nb0 + t) + 4 * quad) : (f32x4){0.f, 0.f, 0.f, 0.f};
        u32x2 w; w.x = pkbf(hacc[t][0], hacc[t][1]); w.y = pkbf(hacc[t][2], hacc[t][3]);
        *(LAS u32x2*)(lds + HS + (16 * pbk + l15) * RSC + (16 * (nb0 + t) + 4 * quad) * 2) = w;
    }
    const int srow = tid >> 3, sc16 = (tid & 7) * 16, sc8 = (tid & 7) * 8;
    u32x4 rC0, rC1, rB0, rB1, rX; float rdt;
#define SSD_LOAD(c_) do { const size_t row_ = (size_t)rb + (size_t)(c_) * 64 + srow; const bf16* xr_ = XBC + row_ * 4096; \
        rX = *(const u32x4*)(xr_ + h * 64 + sc8); rB0 = *(const u32x4*)(xr_ + 2048 + g * 128 + sc16); rB1 = *(const u32x4*)(xr_ + 2048 + g * 128 + sc16 + 8); \
        rC0 = *(const u32x4*)(xr_ + 3072 + g * 128 + sc16); rC1 = *(const u32x4*)(xr_ + 3072 + g * 128 + sc16 + 8); \
        rdt = DT[((size_t)rb + (size_t)(c_) * 64 + lane) * 32 + h]; } while (0)
#define SSD_STAGE(ts_, acn_, atn_) do { acn_ = rdt * A; \
        acn_ = wave_iscan(acn_); \
        atn_ = __builtin_bit_cast(float, __builtin_amdgcn_readlane(__builtin_bit_cast(int, acn_), 63)); const float dtj_ = __shfl(rdt, srow), acj_ = __shfl(acn_, srow), wj_ = __expf(atn_ - acj_); \
        LAS unsigned char* tb_ = lds + (ts_) * TSET; \
        *(LAS u32x4*)(tb_ + CS + srow * RSC + sc16 * 2) = rC0; *(LAS u32x4*)(tb_ + CS + srow * RSC + sc16 * 2 + 16) = rC1; \
        *(LAS u32x4*)(tb_ + BS + srow * RSC + sc16 * 2) = rB0; *(LAS u32x4*)(tb_ + BS + srow * RSC + sc16 * 2 + 16) = rB1; \
        { float f_[8], fw_[8]; unpack8(rX, f_); _Pragma("unroll") for (int j_ = 0; j_ < 8; ++j_) { f_[j_] *= dtj_; fw_[j_] = f_[j_] * wj_; } \
          *(LAS u32x4*)(tb_ + XD + srow * RSX + sc8 * 2) = pack8(f_); *(LAS u32x4*)(tb_ + XW + srow * RSX + sc8 * 2) = pack8(fw_); } } while (0)
    float ac, atot;
    SSD_LOAD(0);
    SSD_STAGE(0, ac, atot);
    if (NC > 1) SSD_LOAD(1);
    __syncthreads();
    const int ib = wid >> 1;
    u32x2 ngx[2], ngz[2];
#define SSD_GLOAD(c_) do { const size_t gr_ = (size_t)rb + (size_t)(c_) * 64 + 16 * ib + l15; _Pragma("unroll") for (int pt = 0; pt < 2; ++pt) { const int p0 = 16 * (2 * (wid & 1) + pt) + 4 * quad; \
        ngx[pt] = *(const u32x2*)(XBC + gr_ * 4096 + h * 64 + p0); ngz[pt] = *(const u32x2*)(PROJ + gr_ * NIN + PC_Z + h * 64 + p0); } } while (0)
    SSD_GLOAD(0);
    for (int c = 0; c < NC; ++c) {
        const int row0 = rb + c * 64, ts = c & 1;
        const LAS unsigned char* T = lds + ts * TSET;
        const LAS unsigned char* Hc = lds + HS + ts * HSET; LAS unsigned char* Hn = lds + HS + (ts ^ 1) * HSET;
        const int i = 16 * ib + l15; const float ac_i = __shfl(ac, i);
        u32x2 gx[2], gz[2];
#pragma unroll
        for (int pt = 0; pt < 2; ++pt) { gx[pt] = ngx[pt]; gz[pt] = ngz[pt]; }
        if (c + 1 < NC) SSD_GLOAD(c + 1);
        bf16x8 cf[4];
#pragma unroll
        for (int s = 0; s < 4; ++s) cf[s] = row_frag(T + CS, RSC, 16 * ib + l15, 32 * s, lane);
#pragma unroll
        for (int jt = 0; jt < 2; ++jt) {
            const int jb = 2 * (wid & 1) + jt; u32x2 w = {0u, 0u};
            if (jb <= ib) {
                f32x4 acc = {0.f, 0.f, 0.f, 0.f};
#pragma unroll
                for (int s = 0; s < 4; ++s) acc = MFMA16(row_frag(T + BS, RSC, 16 * jb + l15, 32 * s, lane), cf[s], acc);
                float v[4];
#pragma unroll
                for (int r = 0; r < 4; ++r) { const int j = 16 * jb + 4 * quad + r; const float ac_j = __shfl(ac, j); v[r] = (j <= i) ? acc[r] * __expf(ac_i - ac_j) : 0.f; }
                w.x = pkbf(v[0], v[1]); w.y = pkbf(v[2], v[3]);
            }
            *(LAS u32x2*)(lds + LS + i * RSX + (16 * jb + 4 * quad) * 2) = w;
        }
        float acn = 0.f, atn = 0.f;
        if (c + 1 < NC) { SSD_STAGE(ts ^ 1, acn, atn); if (c + 2 < NC) SSD_LOAD(c + 2); }
        __syncthreads();
        const float ei = __expf(ac_i);
        bf16x8 lf[2];
#pragma unroll
        for (int s = 0; s < 2; ++s) if (32 * s <= 16 * ib + 15) lf[s] = row_frag(lds + LS, RSX, 16 * ib + l15, 32 * s, lane);
#pragma unroll
        for (int pt = 0; pt < 2; ++pt) {
            const int pb = 2 * (wid & 1) + pt; f32x4 y = {0.f, 0.f, 0.f, 0.f};
#pragma unroll
            for (int s = 0; s < 4; ++s) y = MFMA16(row_frag(Hc, RSC, 16 * pb + l15, 32 * s, lane), cf[s], y);
            y *= ei;
#pragma unroll
            for (int s = 0; s < 2; ++s) if (32 * s <= 16 * ib + 15) y = MFMA16(tr_frag(T + XD, RSX, 32 * s, 16 * pb, lane), lf[s], y);
            const float x0 = bf_lo(gx[pt].x), x1 = bf_hi(gx[pt].x), x2 = bf_lo(gx[pt].y), x3 = bf_hi(gx[pt].y);
            const float z0 = bf_lo(gz[pt].x), z1 = bf_hi(gz[pt].x), z2 = bf_lo(gz[pt].y), z3 = bf_hi(gz[pt].y);
            u32x2 w; w.x = pkbf((y[0] + Dsk * x0) * silu_f(z0), (y[1] + Dsk * x1) * silu_f(z1)); w.y = pkbf((y[2] + Dsk * x2) * silu_f(z2), (y[3] + Dsk * x3) * silu_f(z3));
            *(u32x2*)(YG + (size_t)(row0 + i) * 2048 + h * 64 + 16 * pb + 4 * quad) = w;
        }
        const float et = __expf(atot);
#pragma unroll
        for (int t = 0; t < 4; ++t) hacc[t] *= et;
#pragma unroll
        for (int s = 0; s < 2; ++s) {
            const bf16x8 xf = tr_frag(T + XW, RSX, 32 * s, 16 * pbk, lane);
#pragma unroll
            for (int t = 0; t < 4; ++t) hacc[t] = MFMA16(tr_frag(T + BS, RSC, 32 * s, 16 * (nb0 + t), lane), xf, hacc[t]);
        }
#pragma unroll
        for (int t = 0; t < 4; ++t) { u32x2 w; w.x = pkbf(hacc[t][0], hacc[t][1]); w.y = pkbf(hacc[t][2], hacc[t][3]);
            *(LAS u32x2*)(Hn + (16 * pbk + l15) * RSC + (16 * (nb0 + t) + 4 * quad) * 2) = w; }
        ac = acn; atot = atn;
        __syncthreads();
    }
#undef SSD_LOAD
#undef SSD_STAGE
#undef SSD_GLOAD
#pragma unroll
    for (int t = 0; t < 4; ++t) *(f32x4*)(hout + (16 * pbk + l15) * 128 + 16 * (nb0 + t) + 4 * quad) = hacc[t];
}
}

#ifndef PHMASK
#define PHMASK 0xFFFFFFF
#endif
#define PHON(k) (((PHMASK) >> (k)) & 1)
#ifndef PHREP
#define PHREP 0
#endif
#ifndef PG8_SP2V
#define PG8_SP2V true
#endif
#define NREP(k) (1 + (((PHREP) >> (k)) & 1))
__global__ void __launch_bounds__(512, 2) mk_fwd(Args args) {
    {
        LAS unsigned char* lds0 = (LAS unsigned char*)lds_raw;
        for (int u = threadIdx.x; u < (LDS_BYTES - RING_BYTES) / 4; u += 512) ((LAS unsigned*)(lds0 + RING_BYTES))[u] = 0u;
        __syncthreads();
    }
    const int lo = args.ph_lo, hi = args.ph_hi;
    const bool multi = (hi - lo) > 1;
    unsigned* const barw = (unsigned*)(args.ws + WS_CTL) + CW_BAR;
    XcdBarrier bar; bar.bar = barw; bar.x = 0; bar.st = nullptr;
    if (multi) bar = xcd_barrier_post(barw, (volatile LAS unsigned*)((LAS unsigned char*)lds_raw + MISC_OFF) + 8);
#define IN(k) (lo <= (k) && (k) < hi)
#define SEAM(k) do { if (IN(k) && IN((k) + 1)) xcd_barrier(bar); } while (0)
#define RUN_GEMM(EpiT, Ap, Bp, M_, N_, K_, cid, ...) do { pg8::Gemm g_{(const pg8::bf16_t*)(Ap), (const pg8::bf16_t*)(Bp), M_, N_, K_}; pg8::SplitOrder S_; S_.init(M_, N_, K_, F.G, (cid), EpiT::SPLITK && (K_) >= 8192);     \
        const EpiT E_{__VA_ARGS__}; pg8::gemm_phase<EpiT, pg8::SplitOrder, true, PG8_SP2V>(F.lds, g_, S_, E_); } while (0)
#define SPCNT(k_) ((unsigned*)F.ctl + CW_SPLIT + (l * NPH + (k_)) * 256)
#define SSP(i_) ((float*)F.ctl + CW_SS + (size_t)(i_) * R)

    if (PHON(13) && IN(0)) { const Ctx F = make_ctx(); p_prologue(F); }
    for (int l = 0; l < NLAYER; ++l) {
        const int pb = 1 + NPH * l;
        const bool cv_skip = l > 0 && l + 1 == NLAYER && gridDim.x == 256;
        if (PHON(0) && IN(pb + 0) && !cv_skip) for (int rep_ = 0; rep_ < NREP(0); ++rep_) { if (rep_) xcd_barrier(bar); const Ctx F = make_ctx(); p_convw(F, l); }
        if (!cv_skip) SEAM(pb + 0);
        if (PHON(1) && IN(pb + 1)) for (int rep_ = 0; rep_ < NREP(1); ++rep_) { if (rep_) xcd_barrier(bar);
            { const Ctx F = make_ctx(); unsigned char* ws = F.ws; RUN_GEMM(pg8::EpiScaleBf16, ws + A_XB, ws + W_IN, R, NIN, 4096, F.bid, (pg8::bf16_t*)(ws + A_PROJ), NIN, SSP(3 * l)); }
        }
        SEAM(pb + 1);
        if (PHON(2) && IN(pb + 2)) for (int rep_ = 0; rep_ < NREP(2); ++rep_) { if (rep_) xcd_barrier(bar); const Ctx F = make_ctx(); p_post1(F, l); }
        SEAM(pb + 2);
        if (PHON(3) && IN(pb + 3)) for (int rep_ = 0; rep_ < NREP(3); ++rep_) { if (rep_) xcd_barrier(bar);
            { const Ctx F = make_ctx(); unsigned char* ws = F.ws; RUN_GEMM(pg8::EpiScaleBf16, ws + A_CQN, ws + W_UQ, R, 3072, 1024, F.G - 1 - F.bid, (pg8::bf16_t*)(ws + A_Q), 3072, nullptr); }
            { const Ctx F = make_ctx(); unsigned char* ws = F.ws; RUN_GEMM(pg8::EpiKVNorm, ws + A_CKV, ws + W_UKV, KVROWS, 4096, 512, F.bid, (pg8::bf16_t*)(ws + A_KV), F.in[I_KNN] + l * 128, KVROWS); }
        }
        SEAM(pb + 3);
        if (PHON(5) && IN(pb + 5)) for (int rep_ = 0; rep_ < NREP(5); ++rep_) { if (rep_) xcd_barrier(bar); const int F0g = gridDim.x;
#ifndef NO_SSD
            for (int r2_ = 0; r2_ < NREP(14); ++r2_) {   const Ctx F = make_ctx(); unsigned char* ws = F.ws;
                const bf16* XBC = (const bf16*)(ws + A_XBC); const float* DT = (const float*)(ws + A_DT); const bf16* PROJ = (const bf16*)(ws + A_PROJ); bf16* YG = (bf16*)(ws + A_YG);
                for (int it = F.bid; it < 512; it += F.G) {
                    const int k = it >> 8, u = it & 255, b = u >> 5, h = u & 31;
                    const float A = -__expf(F.in[I_ALOG][l * 32 + h]), Dsk = F.in[I_DSKIP][l * 32 + h];
                    const size_t so = ((size_t)(l * 8 + b) * 32 + h) * 8192;
                    ssd::ssd_unit(F.lds, XBC, DT, PROJ, YG, k ? RP + b * DSEQ : b * SEQ, k ? 1 : SEQ / 64, h, A, Dsk, k ? F.in[I_SSSM] + so : nullptr, F.out + (k ? O_SSM_S : O_SSM_P) + so, F.tid);
                }
            }
#endif
#ifndef NO_ATT
            for (int r2_ = 0; r2_ < NREP(15); ++r2_) {   const Ctx F = make_ctx(); unsigned char* ws = F.ws;
                const bf16* Q = (const bf16*)(ws + A_Q); const bf16* KV = (const bf16*)(ws + A_KV); const bf16* KPE = (const bf16*)(ws + A_KPE); bf16* MIX = (bf16*)(ws + A_MIX);
                const float* ctab = (const float*)(ws + WS_ROPE); const float* stab = ctab + KVS * 32;
                const float* qnn = F.in[I_QNN] + l * 128; const float* qnp = F.in[I_QNP] + l * 64;
                const float scale = 0.07216878364870322f;
                const int wid = F.wave, r32 = F.lane & 31;
                for (int it = F.bid; it < 1280; it += F.G) {
                    const int slot = it >> 8, w = it & 255, xcd = w & 7, r = w >> 3, g = r >> 2, k = r & 3;
                    const bool smp = slot == 4;
                    if (smp && k >= 2) continue;
                    const int bh = (xcd * 8 + g) * 2 + (smp ? k : (slot >> 1));
                    const int qb = (slot & 1) ? k : 7 - k;
                    const int b = bh >> 4, h = bh & 15;
                    const bool act = smp ? wid < 2 : true; const int wo = act ? wid * 32 : 0;
                    const int row0 = smp ? RP + b * DSEQ : b * SEQ + qb * 256; const size_t kr0 = smp ? (size_t)RP + (size_t)b * KVS : (size_t)b * SEQ;
                    const int NT = smp ? KVS / 64 : 4 * qb + 4, wnt = smp ? KVS / 64 : 4 * qb + (wid >> 1) + 1, pos = (smp ? PAST : qb * 256) + wid * 32 + r32;
#if defined(PROBE_ATT_ABL)
                    if (r2_) att::attn_unit<64, PROBE_ATT_ABL>(F.lds, Q + (size_t)(row0 + wo + (act ? r32 : 0)) * 3072 + h * 192, KV + ((size_t)h * KVROWS + kr0) * 256, 256, KPE + kr0 * 64,
                                       KV + ((size_t)h * KVROWS + kr0) * 256 + 128, 256, (bf16*)(ws + A_CQN) + (size_t)wo * 128, 128, NT, wnt, act, scale, qnn, qnp, ctab, stab, pos, F.tid); else
#endif
                    att::attn_unit<64>(F.lds, Q + (size_t)(row0 + wo + (act ? r32 : 0)) * 3072 + h * 192, KV + ((size_t)h * KVROWS + kr0) * 256, 256, KPE + kr0 * 64,
                                       KV + ((size_t)h * KVROWS + kr0) * 256 + 128, 256, MIX + (size_t)(row0 + wo) * 4096 + h * 128, 4096, NT, wnt, act, scale, qnn, qnp, ctab, stab, pos, F.tid);
                }
            }
#endif
            if (rep_ == 0 && F0g == 256 && ((blockIdx.x >> 3) & 3) >= 2) { __syncthreads();     const Ctx F3 = make_ctx(); const int rk = ((F3.bid >> 5) << 4) | ((((F3.bid >> 3) & 3) - 2) << 3) | (F3.bid & 7);
                p_convw_range(F3, l, CV_A0, CV_E3 - CV_A0, l, 0, 0, 0, 128, 8, rk); }
        }
        SEAM(pb + 5);
        if (PHON(6) && IN(pb + 6)) for (int rep_ = 0; rep_ < NREP(6); ++rep_) { if (rep_) xcd_barrier(bar); const Ctx F = make_ctx(); p_gnorm(F, l); }
        SEAM(pb + 6);
        if (PHON(7) && IN(pb + 7)) for (int rep_ = 0; rep_ < NREP(7); ++rep_) { if (rep_) xcd_barrier(bar); const Ctx F = make_ctx(); unsigned char* ws = F.ws;
#if defined(PROBE_NULLEPI)
            if (rep_) RUN_GEMM(pg8::EpiNull, ws + A_MIX, ws + W_O, R, 4096, 4096, F.bid); else
#endif
            RUN_GEMM(pg8::EpiResid, ws + A_MIX, ws + W_O, R, 4096, 4096, F.bid, (float*)nullptr, (pg8::bf16_t*)(ws + A_XB), SSP(3 * l + 1), SPCNT(7), ws + A_KV);
            if (F.G == 256 && F.bid >= 32) { const Ctx F3 = make_ctx(); p_convw_range(F3, l, CV_GU0, CV_GU1 - CV_GU0, l, 0, 0, 32, 224, CV_TAILW); } }
        SEAM(pb + 7);
        if (PHON(8) && IN(pb + 8)) for (int rep_ = 0; rep_ < NREP(8); ++rep_) { if (rep_) xcd_barrier(bar); const Ctx F = make_ctx(); unsigned char* ws = F.ws; RUN_GEMM(pg8::EpiScaleBf16, ws + A_XB, ws + W_XQ, R, 512, 4096, F.bid, (pg8::bf16_t*)(ws + A_XQ), 512, SSP(3 * l + 1));
            { const Ctx F2 = make_ctx(); unsigned char* ws2 = F2.ws; pg8::Gemm g2{(const pg8::bf16_t*)(ws2 + A_MB), (const pg8::bf16_t*)(ws2 + W_XKV), 2048, 1024, 4096}; pg8::SplitOrder S2; S2.init(2048, 1024, 4096, F2.G, (F2.bid + F2.G - 132) % F2.G, false);
              const pg8::EpiMemKV E2{(const float*)F2.ctl + CW_SSM, F2.in[I_XNK] + l * 128, F2.out + O_MK_P + (size_t)l * 2048 * 512, F2.out + O_MV_P + (size_t)l * 2048 * 512, (pg8::bf16_t*)(ws2 + A_MEMK), (pg8::bf16_t*)(ws2 + A_MEMV)};
              pg8::gemm_phase<pg8::EpiMemKV, pg8::SplitOrder, true, true>(F2.lds, g2, S2, E2); }
            if (F.G == 256 && F.bid >= 164) { const Ctx F3 = make_ctx(); p_convw_range(F3, l, CV_GU1, CV_GU3 - CV_GU1, l, 0, 0, 164, 92, CV_TAILW); } }
        SEAM(pb + 8);
        if (PHON(9) && IN(pb + 9)) for (int rep_ = 0; rep_ < NREP(9); ++rep_) { if (rep_) xcd_barrier(bar);
            const Ctx F = make_ctx(); unsigned char* ws = F.ws;
            const bf16* XQ = (const bf16*)(ws + A_XQ); const bf16* MEMK = (const bf16*)(ws + A_MEMK); const bf16* MEMV = (const bf16*)(ws + A_MEMV); bf16* XO = (bf16*)(ws + A_XO);
            const float* xnq = F.in[I_XNQ] + l * 128; const float scale = 0.08838834764831845f;
            const int wid = F.wave, r32 = F.lane & 31;
            for (int it = F.bid; it < 512; it += F.G) {
                if (it >= 288) continue;
                const bool smp = it >= 256; const int u = it & 255;
                const int b = smp ? u >> 2 : u >> 5, h = smp ? u & 3 : (u >> 3) & 3, qb = u & 7;
                const bool act = smp ? wid < 2 : true; const int wo = act ? wid * 32 : 0;
                const int row0 = smp ? RP + b * DSEQ : b * SEQ + qb * 256; const size_t mr0 = (size_t)(smp ? 2048 : 0) + (size_t)b * NMEM;
                att::attn_unit<0>(F.lds, XQ + (size_t)(row0 + wo + (act ? r32 : 0)) * 512 + h * 128, MEMK + mr0 * 512 + h * 128, 512, nullptr,
                                  MEMV + mr0 * 512 + h * 128, 512, XO + (size_t)(row0 + wo) * 512 + h * 128, 512, 4, 4, act, scale, xnq, nullptr, nullptr, nullptr, 0, F.tid);
            }
        }
        SEAM(pb + 9);
        if (PHON(10) && IN(pb + 10)) for (int rep_ = 0; rep_ < NREP(10); ++rep_) { if (rep_) xcd_barrier(bar); const Ctx F = make_ctx(); unsigned char* ws = F.ws; RUN_GEMM(pg8::EpiResid, ws + A_XO, ws + W_XO, R, 4096, 512, F.bid, (float*)nullptr, (pg8::bf16_t*)(ws + A_XB), SSP(3 * l + 2), SPCNT(10), ws + A_KV);
            if (F.G == 256 && F.bid >= 32) { const Ctx F3 = make_ctx(); p_convw_range(F3, l, CV_GU3, CV_DX, l, 0, 0, 32, 224, CV_TAILW); } }
        SEAM(pb + 10);
        if (PHON(11) && IN(pb + 11)) for (int rep_ = 0; rep_ < NREP(11); ++rep_) { if (rep_) xcd_barrier(bar); const Ctx F = make_ctx(); unsigned char* ws = F.ws;
#if defined(PROBE_NULLEPI)
            if (rep_) RUN_GEMM(pg8::EpiNull, ws + A_XB, ws + ((l & 1) ? A_WGU2 : W_GU), R, 22016, 4096, F.bid); else
#endif
            RUN_GEMM(pg8::EpiGU, ws + A_XB, ws + ((l & 1) ? A_WGU2 : W_GU), R, 22016, 4096, F.bid, (pg8::bf16_t*)(ws + A_H), SSP(3 * l + 2), SPCNT(11), ws + A_KV);
            if (F.G == 256 && F.bid >= 44) { const Ctx F3 = make_ctx(); const bool more = l + 1 < NLAYER; p_convw_range(F3, l + 1, 0, more ? CV_A0 : 0, l, CV_GU3 + CV_DX, more ? CV_DG : CV_NITEMS - CV_GU3 - CV_DX, 44, 212, CV_TAILW); } }
        SEAM(pb + 11);
        if (PHON(12) && IN(pb + 12)) for (int rep_ = 0; rep_ < NREP(12); ++rep_) { if (rep_) xcd_barrier(bar); const Ctx F = make_ctx(); unsigned char* ws = F.ws; const bool more = l + 1 < NLAYER;
#if defined(PROBE_NULLEPI)
            if (rep_) RUN_GEMM(pg8::EpiNull, ws + A_H, ws + W_DN, R, 4096, DFF, F.bid); else
#endif
            RUN_GEMM(pg8::EpiResid, ws + A_H, ws + W_DN, R, 4096, DFF, F.bid, more ? (float*)nullptr : F.out + O_Y, (pg8::bf16_t*)(ws + A_XB), SSP(3 * l + 3), SPCNT(12), ws + A_KV); }
        SEAM(pb + 12);
    }
#undef IN
#undef SEAM
#undef RUN_GEMM
#undef SSP
#undef SPCNT
}

#ifndef MK_SPLIT
#define MK_SPLIT 0
#endif
extern "C" void kernel_launch(void* const* d_in, const int* in_sizes, int n_in, void* d_out, int out_size, void* d_ws, size_t ws_size, hipStream_t stream) {
    static int grid = 0;
    if (grid == 0) {
        if (n_in != 38 || out_size < (int)O_END || ws_size < WS_NEED) { fprintf(stderr, "kernel_launch: n_in %d out %d ws %zu (need 38, %zu, >= %zu): nothing launched\n", n_in, out_size, ws_size, (size_t)O_END, (size_t)WS_NEED); grid = -1; return; }
        int dev = 0, cus = 0, per_cu = 0;
        if (hipGetDevice(&dev) != hipSuccess || hipDeviceGetAttribute(&cus, hipDeviceAttributeMultiprocessorCount, dev) != hipSuccess) { grid = -1; return; }
        if (hipFuncSetAttribute((const void*)mk_fwd, hipFuncAttributeMaxDynamicSharedMemorySize, LDS_BYTES) != hipSuccess) { fprintf(stderr, "kernel_launch: hipFuncSetAttribute failed\n"); grid = -1; return; }
        if (hipOccupancyMaxActiveBlocksPerMultiprocessor(&per_cu, (const void*)mk_fwd, 512, LDS_BYTES) != hipSuccess || per_cu < 1) fprintf(stderr, "kernel_launch: occupancy query says %d\n", per_cu);
        (void)hipGetLastError();
        grid = cus;
    }
    if (grid < 0) return;
    if (hipMemsetAsync((char*)d_ws + WS_CTL, 0, CTL_ZERO_BYTES, stream) != hipSuccess) return;
    Args a{};
    for (int i = 0; i < 38; ++i) a.in[i] = (const float*)d_in[i];
    a.out = (float*)d_out; a.ws = (unsigned char*)d_ws;
    constexpr int NPHASE = 1 + NLAYER * NPH;
#if MK_SPLIT
    for (int p = 0; p < NPHASE; ++p) { a.ph_lo = p; a.ph_hi = p + 1; hipLaunchKernelGGL(mk_fwd, dim3(grid), dim3(512), LDS_BYTES, stream, a); }
#else
    a.ph_lo = 0; a.ph_hi = NPHASE; hipLaunchKernelGGL(mk_fwd, dim3(grid), dim3(512), LDS_BYTES, stream, a);
#endif
    const hipError_t le = hipPeekAtLastError();
    if (le != hipSuccess) fprintf(stderr, "kernel_launch: launch failed: %s\n", hipGetErrorName(le));
}
```

```cpp
#include <hip/hip_runtime.h>
#include <cstdio>
#include <cstdint>

#define LAS __attribute__((address_space(3)))
#define GAS __attribute__((address_space(1)))
#define DI __device__ __forceinline__

namespace pg8 {
#define PG8_LAS __attribute__((address_space(3)))
typedef unsigned short bf16_t;
typedef short bf16x8 __attribute__((ext_vector_type(8)));
typedef float f32x4 __attribute__((ext_vector_type(4)));
typedef unsigned u32x4 __attribute__((ext_vector_type(4)));
constexpr int BM = 256, BK = 64, HALF = 128, HTB = HALF * BK * 2  , STAGE_BYTES = 8 * HTB, NXCD = 8, WGM = 8;

__host__ __device__ __forceinline__ int lds_byte(int r, int c) { const int st = (r >> 4) * 2 + (c >> 5), rr = r & 15, cc = c & 31, ob = rr * 64 + cc * 2; return st * 1024 + (ob ^ (((ob >> 9) & 1) << 5)); }
__host__ __device__ __forceinline__ void stage_rc(int b, int& R, int& C) { const int st = b / 1024, sb = b % 1024, swz = sb ^ (((sb >> 9) & 1) << 5); R = (st >> 1) * 16 + swz / 64; C = (st & 1) * 32 + (swz % 64) / 2; }
__host__ __device__ __forceinline__ int perm32(int rho) { const int n = rho >> 4, i = rho & 15; return 8 * (i >> 2) + 4 * n + (i & 3); }

struct Unit { int pm, pn, kt0, nt, split, np, part; };
struct Gemm { const bf16_t* A; const bf16_t* Bt; int M, N, K; };

struct StaticOrder {
    int nM, nN, nwg, G, c;
    __host__ __device__ void init(int M, int N, int G_, int c_) { nM = M / BM; nN = N / BM; nwg = nM * nN; G = G_; c = c_; }
    __host__ __device__ bool next(int i, Unit& u) const {
        const long L = (long)i * G + c; if (L >= nwg) return false;
        int wgid = (int)L; { const int q = nwg / NXCD, r = nwg % NXCD, xcd = wgid % NXCD, off = wgid / NXCD; wgid = (xcd < r ? xcd * (q + 1) : r * (q + 1) + (xcd - r) * q) + off; }
        const int nig = WGM * nN, gid = wgid / nig, fm = gid * WGM, gsz = (nM - fm) < WGM ? (nM - fm) : WGM;
        u.pm = fm + ((wgid % nig) % gsz); u.pn = (wgid % nig) / gsz; u.kt0 = 0; u.nt = 0; u.split = -1; u.np = 1; u.part = 0; return true;
    }
    __device__ __forceinline__ void a_ready(const Unit&) const {}
    __device__ __forceinline__ void done(const Unit&) const {}
};

__device__ __forceinline__ unsigned cvt_pk_bf16(float lo, float hi) { unsigned r; asm volatile("v_cvt_pk_bf16_f32 %0, %1, %2" : "=v"(r) : "v"(lo), "v"(hi)); return r; }

struct SplitOrder {
    int nM, nN, nwg, G, c, F, Rm, P, ntot, nbase, nextra;
    __device__ __forceinline__ void init(int M, int N, int K, int G_, int c_, bool allow_split) {
        nM = M / BM; nN = N / BM; nwg = nM * nN; G = G_; c = c_; ntot = K / BK; F = nwg / G; Rm = nwg - F * G; P = 1;
        if (allow_split && Rm > 0 && F > 0 && Rm <= 128) {     int p = G / Rm; if (p > 8) p = 8; const int pk = ntot / 4; if (p > pk) p = pk; if (p >= 2) P = p; }
        nbase = (ntot / P) & ~1; nextra = (ntot - nbase * P) / 2;
    }
    __device__ __forceinline__ void map(int L, Unit& u) const {
        int wgid = L; { const int q = nwg / NXCD, r = nwg % NXCD, xcd = wgid % NXCD, off = wgid / NXCD; wgid = (xcd < r ? xcd * (q + 1) : r * (q + 1) + (xcd - r) * q) + off; }
        const int nig = WGM * nN, gid = wgid / nig, fm = gid * WGM, gsz = (nM - fm) < WGM ? (nM - fm) : WGM;
        u.pm = fm + ((wgid % nig) % gsz); u.pn = (wgid % nig) / gsz;
    }
    __device__ __forceinline__ bool next(int i, Unit& u) const {
        if (P == 1) { const long L = (long)i * G + c; if (L >= nwg) return false; map((int)L, u); u.kt0 = 0; u.nt = ntot; u.split = -1; u.np = 1; u.part = 0; return true; }
        const bool has_part = c < Rm * P;
        if (i > 0 || !has_part) { const int ii = has_part ? i - 1 : i; if (ii >= F) return false; map(ii * G + c, u); u.kt0 = 0; u.nt = ntot; u.split = -1; u.np = 1; u.part = 0; return true; }
        const int s = c / P, part = c - s * P; map(F * G + s, u);
        u.kt0 = part * nbase + 2 * (part < nextra ? part : nextra); u.nt = nbase + (part < nextra ? 2 : 0); u.split = s; u.np = P; u.part = part; return true;
    }
    __device__ __forceinline__ void a_ready(const Unit&) const {}
    __device__ __forceinline__ void done(const Unit&) const {}
};

constexpr float RMS_EPS = 1e-6f;
typedef float f32x2v __attribute__((ext_vector_type(2)));
typedef __bf16 bf16x2v __attribute__((ext_vector_type(2)));
__device__ __forceinline__ unsigned pkbf(float lo, float hi) { f32x2v v = {lo, hi}; bf16x2v b = __builtin_convertvector(v, bf16x2v); return __builtin_bit_cast(unsigned, b); }

struct EpiScaleBf16 {
    static constexpr bool PERM = true, AFTER_DRAIN = false, SPLITK = false, USES_LDS = false;
    bf16_t* O; int ldc; const float* ss;
    __device__ __forceinline__ void operator()(const f32x4 (&acc)[2][2][4][2], const Unit& u, int wr, int wc, int fr, int fq) const {
        const int row0 = u.pm * BM + wr * 64 + fr, col0 = u.pn * BM + wc * 32 + 8 * fq;
#pragma unroll
        for (int ai = 0; ai < 2; ++ai)
#pragma unroll
            for (int m = 0; m < 4; ++m) {
                const int r = row0 + ai * HALF + m * 16;
                const float s = ss ? __builtin_amdgcn_rsqf(ss[r] * (1.0f / 4096.0f) + RMS_EPS) : 1.0f;
                bf16_t* rowp = O + (size_t)r * ldc + col0;
#pragma unroll
                for (int bj = 0; bj < 2; ++bj) { const f32x4 v0 = acc[ai][bj][m][0] * s, v1 = acc[ai][bj][m][1] * s;
                    u32x4 w; w.x = pkbf(v0[0], v0[1]); w.y = pkbf(v0[2], v0[3]); w.z = pkbf(v1[0], v1[1]); w.w = pkbf(v1[2], v1[3]);
                    *(u32x4*)(rowp + bj * HALF) = w; } }
    }
};
struct EpiScaleF32 {
    static constexpr bool PERM = true, AFTER_DRAIN = false, SPLITK = false, USES_LDS = false;
    float* O; int ldc; const float* ss;
    __device__ __forceinline__ void operator()(const f32x4 (&acc)[2][2][4][2], const Unit& u, int wr, int wc, int fr, int fq) const {
        const int row0 = u.pm * BM + wr * 64 + fr, col0 = u.pn * BM + wc * 32 + 8 * fq;
#pragma unroll
        for (int ai = 0; ai < 2; ++ai)
#pragma unroll
            for (int m = 0; m < 4; ++m) {
                const int r = row0 + ai * HALF + m * 16;
                const float s = ss ? __builtin_amdgcn_rsqf(ss[r] * (1.0f / 4096.0f) + RMS_EPS) : 1.0f;
                float* rowp = O + (size_t)r * ldc + col0;
#pragma unroll
                for (int bj = 0; bj < 2; ++bj) { *(f32x4*)(rowp + bj * HALF) = acc[ai][bj][m][0] * s; *(f32x4*)(rowp + bj * HALF + 4) = acc[ai][bj][m][1] * s; } }
    }
};
struct EpiResid {
    static constexpr bool PERM = true, AFTER_DRAIN = false, SPLITK = true, USES_LDS = false;
    float* Y; bf16_t* XB; float* ssq; unsigned* cnt; unsigned char* slab;
    __device__ __forceinline__ void operator()(const f32x4 (&acc)[2][2][4][2], const Unit& u, int wr, int wc, int fr, int fq) const {
        const int row0 = u.pm * BM + wr * 64 + fr, col0 = u.pn * BM + wc * 32 + 8 * fq;
#pragma unroll
        for (int ai = 0; ai < 2; ++ai)
#pragma unroll
            for (int m = 0; m < 4; ++m) {
                const int r = row0 + ai * HALF + m * 16;
                bf16_t* xp = XB + (size_t)r * 4096 + col0; float sq = 0.f;
                const u32x4 o0 = *(const u32x4*)xp, o1 = *(const u32x4*)(xp + HALF);
#pragma unroll
                for (int bj = 0; bj < 2; ++bj) {
                    const u32x4 o = bj ? o1 : o0;
                    f32x4 a = {__uint_as_float(o.x << 16), __uint_as_float(o.x & 0xffff0000u), __uint_as_float(o.y << 16), __uint_as_float(o.y & 0xffff0000u)};
                    f32x4 b = {__uint_as_float(o.z << 16), __uint_as_float(o.z & 0xffff0000u), __uint_as_float(o.w << 16), __uint_as_float(o.w & 0xffff0000u)};
                    a += acc[ai][bj][m][0]; b += acc[ai][bj][m][1];
                    if (Y) { float* yp = Y + (size_t)r * 4096 + col0 + bj * HALF; *(f32x4*)yp = a; *(f32x4*)(yp + 4) = b; }
                    else {
                        sq += (a[0] * a[0] + a[1] * a[1]) + (a[2] * a[2] + a[3] * a[3]) + (b[0] * b[0] + b[1] * b[1]) + (b[2] * b[2] + b[3] * b[3]);
                        u32x4 w; w.x = pkbf(a[0], a[1]); w.y = pkbf(a[2], a[3]); w.z = pkbf(b[0], b[1]); w.w = pkbf(b[2], b[3]);
                        *(u32x4*)(xp + bj * HALF) = w; } }
                if (!Y) { sq += __shfl_xor(sq, 16); sq += __shfl_xor(sq, 32); if (fq == 0) unsafeAtomicAdd(ssq + r, sq); }
            }
    }
    __device__ __forceinline__ void partial(const f32x4 (&acc)[2][2][4][2], const Unit& u, int wr, int wc, int fr, int fq, PG8_LAS unsigned char* lds, int tid) const {
        const int wid = __builtin_amdgcn_readfirstlane(tid >> 6), lane = tid & 63;
        unsigned char* tile_slabs = slab + (size_t)u.split * 8 * 262144;
        const int myp = u.part;
        { __amdgpu_buffer_rsrc_t rs = __builtin_amdgcn_make_buffer_rsrc((void*)(tile_slabs + (size_t)myp * 262144), (short)0, 262144, 0x00020000);
#pragma unroll
          for (int ai = 0; ai < 2; ++ai)
#pragma unroll
            for (int bj = 0; bj < 2; ++bj)
#pragma unroll
                for (int m = 0; m < 4; ++m)
#pragma unroll
                    for (int n = 0; n < 2; ++n) { const int k = ((ai * 2 + bj) * 4 + m) * 2 + n;
                        __builtin_amdgcn_raw_buffer_store_b128(__builtin_bit_cast(u32x4, acc[ai][bj][m][n]), rs, ((wid * 32 + k) * 64 + lane) * 16, 0, 16); } }
        asm volatile("s_waitcnt vmcnt(0)" ::: "memory");
        __builtin_amdgcn_s_barrier();
        PG8_LAS unsigned* bw = (PG8_LAS unsigned*)(lds + 131072 + 320 + 64);
        if (tid == 0) { const unsigned old = __hip_atomic_fetch_add(cnt + u.split, 1u, __ATOMIC_RELAXED, __HIP_MEMORY_SCOPE_AGENT); *bw = old; }
        asm volatile("s_waitcnt vmcnt(0) lgkmcnt(0)" ::: "memory");
        __builtin_amdgcn_s_barrier();
        const unsigned old = *bw;
        asm volatile("s_waitcnt lgkmcnt(0)" ::: "memory");
        if (old == (unsigned)(u.np - 1)) {
            f32x4 z[2][2][4][2];
#pragma unroll
            for (int a = 0; a < 2; ++a)
#pragma unroll
                for (int b = 0; b < 2; ++b)
#pragma unroll
                    for (int m = 0; m < 4; ++m)
#pragma unroll
                        for (int n = 0; n < 2; ++n) z[a][b][m][n] = (f32x4){0.f, 0.f, 0.f, 0.f};
            for (int p = 0; p < u.np; ++p) {
                __amdgpu_buffer_rsrc_t rs = __builtin_amdgcn_make_buffer_rsrc((void*)(tile_slabs + (size_t)p * 262144), (short)0, 262144, 0x00020000);
#pragma unroll
                for (int ai = 0; ai < 2; ++ai)
#pragma unroll
                    for (int bj = 0; bj < 2; ++bj)
#pragma unroll
                        for (int m = 0; m < 4; ++m)
#pragma unroll
                            for (int n = 0; n < 2; ++n) { const int k = ((ai * 2 + bj) * 4 + m) * 2 + n;
                                z[ai][bj][m][n] += __builtin_bit_cast(f32x4, __builtin_amdgcn_raw_buffer_load_b128(rs, ((wid * 32 + k) * 64 + lane) * 16, 0, 16)); }
            }
            (*this)(z, u, wr, wc, fr, fq);
        }
    }
};
struct EpiGU {
    static constexpr bool PERM = true, AFTER_DRAIN = false, SPLITK = false, USES_LDS = false;
    bf16_t* H; const float* ss; unsigned* cnt; unsigned char* slab;
    __device__ __forceinline__ void operator()(const f32x4 (&acc)[2][2][4][2], const Unit& u, int wr, int wc, int fr, int fq) const {
        const int row0 = u.pm * BM + wr * 64 + fr, col0 = u.pn * HALF + wc * 32 + 8 * fq;
#pragma unroll
        for (int ai = 0; ai < 2; ++ai)
#pragma unroll
            for (int m = 0; m < 4; ++m) {
                const int r = row0 + ai * HALF + m * 16;
                const float s = __builtin_amdgcn_rsqf(ss[r] * (1.0f / 4096.0f) + RMS_EPS);
                float hv[8];
#pragma unroll
                for (int n = 0; n < 2; ++n)
#pragma unroll
                    for (int j = 0; j < 4; ++j) { const float g = acc[ai][0][m][n][j] * s, up = acc[ai][1][m][n][j] * s;
                        hv[n * 4 + j] = g * __builtin_amdgcn_rcpf(1.0f + __builtin_amdgcn_exp2f(-1.4426950408889634f * g)) * up; }
                u32x4 w; w.x = pkbf(hv[0], hv[1]); w.y = pkbf(hv[2], hv[3]); w.z = pkbf(hv[4], hv[5]); w.w = pkbf(hv[6], hv[7]);
                *(u32x4*)(H + (size_t)r * 11008 + col0) = w; }
    }
    __device__ __forceinline__ void partial(const f32x4 (&acc)[2][2][4][2], const Unit& u, int wr, int wc, int fr, int fq, PG8_LAS unsigned char* lds, int tid) const {
        const int wid = __builtin_amdgcn_readfirstlane(tid >> 6), lane = tid & 63;
        unsigned char* tile_slabs = slab + (size_t)u.split * 8 * 262144;
        const int myp = u.part;
        { __amdgpu_buffer_rsrc_t rs = __builtin_amdgcn_make_buffer_rsrc((void*)(tile_slabs + (size_t)myp * 262144), (short)0, 262144, 0x00020000);
#pragma unroll
          for (int ai = 0; ai < 2; ++ai)
#pragma unroll
            for (int bj = 0; bj < 2; ++bj)
#pragma unroll
                for (int m = 0; m < 4; ++m)
#pragma unroll
                    for (int n = 0; n < 2; ++n) { const int k = ((ai * 2 + bj) * 4 + m) * 2 + n;
                        __builtin_amdgcn_raw_buffer_store_b128(__builtin_bit_cast(u32x4, acc[ai][bj][m][n]), rs, ((wid * 32 + k) * 64 + lane) * 16, 0, 16); } }
        asm volatile("s_waitcnt vmcnt(0)" ::: "memory");
        __builtin_amdgcn_s_barrier();
        PG8_LAS unsigned* bw = (PG8_LAS unsigned*)(lds + 131072 + 320 + 64);
        if (tid == 0) { const unsigned old = __hip_atomic_fetch_add(cnt + u.split, 1u, __ATOMIC_RELAXED, __HIP_MEMORY_SCOPE_AGENT); *bw = old; }
        asm volatile("s_waitcnt vmcnt(0) lgkmcnt(0)" ::: "memory");
        __builtin_amdgcn_s_barrier();
        const unsigned old = *bw;
        asm volatile("s_waitcnt lgkmcnt(0)" ::: "memory");
        if (old == (unsigned)(u.np - 1)) {
            f32x4 z[2][2][4][2];
#pragma unroll
            for (int a = 0; a < 2; ++a)
#pragma unroll
                for (int b = 0; b < 2; ++b)
#pragma unroll
                    for (int m = 0; m < 4; ++m)
#pragma unroll
                        for (int n = 0; n < 2; ++n) z[a][b][m][n] = (f32x4){0.f, 0.f, 0.f, 0.f};
            for (int p = 0; p < u.np; ++p) {
                __amdgpu_buffer_rsrc_t rs = __builtin_amdgcn_make_buffer_rsrc((void*)(tile_slabs + (size_t)p * 262144), (short)0, 262144, 0x00020000);
#pragma unroll
                for (int ai = 0; ai < 2; ++ai)
#pragma unroll
                    for (int bj = 0; bj < 2; ++bj)
#pragma unroll
                        for (int m = 0; m < 4; ++m)
#pragma unroll
                            for (int n = 0; n < 2; ++n) { const int k = ((ai * 2 + bj) * 4 + m) * 2 + n;
                                z[ai][bj][m][n] += __builtin_bit_cast(f32x4, __builtin_amdgcn_raw_buffer_load_b128(rs, ((wid * 32 + k) * 64 + lane) * 16, 0, 16)); }
            }
            (*this)(z, u, wr, wc, fr, fq);
        }
    }
};

struct EpiKVNorm {
    static constexpr bool PERM = true, AFTER_DRAIN = false, SPLITK = false, USES_LDS = true;
    bf16_t* O; const float* gain; int Mrows;
    __device__ __forceinline__ void operator()(const f32x4 (&acc)[2][2][4][2], const Unit& u, int wr, int wc, int fr, int fq) const {}
    __device__ __forceinline__ void with_lds(const f32x4 (&acc)[2][2][4][2], const Unit& u, int wr, int wc, int fr, int fq, PG8_LAS unsigned char* lds) const {
        PG8_LAS float* part = (PG8_LAS float*)(lds + 131072 + 1024);
        const int rb = wr * 64 + fr;
#pragma unroll
        for (int ai = 0; ai < 2; ++ai)
#pragma unroll
            for (int m = 0; m < 4; ++m) { const f32x4 a = acc[ai][0][m][0], b = acc[ai][0][m][1];
                float s = (a[0] * a[0] + a[1] * a[1]) + (a[2] * a[2] + a[3] * a[3]) + (b[0] * b[0] + b[1] * b[1]) + (b[2] * b[2] + b[3] * b[3]);
                s += __shfl_xor(s, 16); s += __shfl_xor(s, 32);
                if (fq == 0) part[(ai * HALF + rb + m * 16) * 4 + wc] = s; }
        asm volatile("s_waitcnt lgkmcnt(0)" ::: "memory"); __builtin_amdgcn_s_barrier(); asm volatile("" ::: "memory");
        const int cl = wc * 32 + 8 * fq; const f32x4 g0 = *(const f32x4*)(gain + cl), g1 = *(const f32x4*)(gain + cl + 4);
        const int row0 = u.pm * BM + rb;
#pragma unroll
        for (int ai = 0; ai < 2; ++ai)
#pragma unroll
            for (int m = 0; m < 4; ++m) {
                const f32x4 p = *(const PG8_LAS f32x4*)(part + (ai * HALF + rb + m * 16) * 4);
                const float rs = __builtin_amdgcn_rsqf(((p[0] + p[1]) + (p[2] + p[3])) * (1.0f / 128.0f) + RMS_EPS);
                bf16_t* rowp = O + ((size_t)u.pn * Mrows + (size_t)(row0 + ai * HALF + m * 16)) * 256 + cl;
                const f32x4 k0 = acc[ai][0][m][0] * rs * g0, k1 = acc[ai][0][m][1] * rs * g1, v0 = acc[ai][1][m][0], v1 = acc[ai][1][m][1];
                u32x4 w; w.x = pkbf(k0[0], k0[1]); w.y = pkbf(k0[2], k0[3]); w.z = pkbf(k1[0], k1[1]); w.w = pkbf(k1[2], k1[3]);
                *(u32x4*)rowp = w;
                w.x = pkbf(v0[0], v0[1]); w.y = pkbf(v0[2], v0[3]); w.z = pkbf(v1[0], v1[1]); w.w = pkbf(v1[2], v1[3]);
                *(u32x4*)(rowp + HALF) = w; }
    }
};

struct EpiMemKV {
    static constexpr bool PERM = true, AFTER_DRAIN = false, SPLITK = false, USES_LDS = true;
    const float* ssm; const float* gain; float* outK; float* outV; bf16_t* MK; bf16_t* MV;
    __device__ __forceinline__ void operator()(const f32x4 (&acc)[2][2][4][2], const Unit& u, int wr, int wc, int fr, int fq) const {}
    __device__ __forceinline__ void with_lds(const f32x4 (&acc)[2][2][4][2], const Unit& u, int wr, int wc, int fr, int fq, PG8_LAS unsigned char* lds) const {
        PG8_LAS float* part = (PG8_LAS float*)(lds + 131072 + 1024);
        const int rb = wr * 64 + fr, cl = wc * 32 + 8 * fq; const bool isk = u.pn < 2;
        float sr[2][4];
#pragma unroll
        for (int ai = 0; ai < 2; ++ai)
#pragma unroll
            for (int m = 0; m < 4; ++m) sr[ai][m] = __builtin_amdgcn_rsqf(ssm[u.pm * BM + ai * HALF + rb + m * 16] * (1.0f / 4096.0f) + RMS_EPS);
        if (isk) {
#pragma unroll
            for (int ai = 0; ai < 2; ++ai)
#pragma unroll
                for (int m = 0; m < 4; ++m)
#pragma unroll
                    for (int bj = 0; bj < 2; ++bj) { const f32x4 a = acc[ai][bj][m][0], b = acc[ai][bj][m][1];
                        float s = (a[0] * a[0] + a[1] * a[1]) + (a[2] * a[2] + a[3] * a[3]) + (b[0] * b[0] + b[1] * b[1]) + (b[2] * b[2] + b[3] * b[3]);
                        s *= sr[ai][m] * sr[ai][m]; s += __shfl_xor(s, 16); s += __shfl_xor(s, 32);
                        if (fq == 0) part[((ai * HALF + rb + m * 16) * 2 + bj) * 4 + wc] = s; }
            asm volatile("s_waitcnt lgkmcnt(0)" ::: "memory"); __builtin_amdgcn_s_barrier(); asm volatile("" ::: "memory");
        }
        const f32x4 g0 = *(const f32x4*)(gain + cl), g1 = *(const f32x4*)(gain + cl + 4);
        float* outp = isk ? outK : outV; bf16_t* outb = isk ? MK : MV; const int ct = (isk ? u.pn : u.pn - 2) * BM + cl;
#pragma unroll
        for (int ai = 0; ai < 2; ++ai)
#pragma unroll
            for (int m = 0; m < 4; ++m) { const int r = u.pm * BM + ai * HALF + rb + m * 16;
#pragma unroll
                for (int bj = 0; bj < 2; ++bj) {
                    f32x4 v0 = acc[ai][bj][m][0] * sr[ai][m], v1 = acc[ai][bj][m][1] * sr[ai][m];
                    if (isk) { const f32x4 p = *(const PG8_LAS f32x4*)(part + ((ai * HALF + rb + m * 16) * 2 + bj) * 4);
                        const float rs = __builtin_amdgcn_rsqf(((p[0] + p[1]) + (p[2] + p[3])) * (1.0f / 128.0f) + RMS_EPS); v0 = v0 * rs * g0; v1 = v1 * rs * g1; }
                    float* op = outp + (size_t)r * 512 + ct + bj * HALF; *(f32x4*)op = v0; *(f32x4*)(op + 4) = v1;
                    u32x4 w; w.x = pkbf(v0[0], v0[1]); w.y = pkbf(v0[2], v0[3]); w.z = pkbf(v1[0], v1[1]); w.w = pkbf(v1[2], v1[3]);
                    *(u32x4*)(outb + (size_t)r * 512 + ct + bj * HALF) = w; } }
    }
};

#ifndef PROBE_NULLSPLIT
#define PROBE_NULLSPLIT false
#endif
struct EpiNull {
    static constexpr bool PERM = true, AFTER_DRAIN = false, SPLITK = PROBE_NULLSPLIT, USES_LDS = false;
    __device__ __forceinline__ void partial(const f32x4 (&acc)[2][2][4][2], const Unit& u, int wr, int wc, int fr, int fq, PG8_LAS unsigned char* lds, int tid) const { (*this)(acc, u, wr, wc, fr, fq); }
    __device__ __forceinline__ void operator()(const f32x4 (&acc)[2][2][4][2], const Unit& u, int wr, int wc, int fr, int fq) const {
#pragma unroll
        for (int ai = 0; ai < 2; ++ai)
#pragma unroll
            for (int bj = 0; bj < 2; ++bj)
#pragma unroll
                for (int m = 0; m < 4; ++m) asm volatile("" :: "v"(acc[ai][bj][m][0]), "v"(acc[ai][bj][m][1]));
    }
};

template <class Epi, class Sched, bool ALIGN_EPI = false, bool SP2 = false>
__device__ __forceinline__ void gemm_phase(PG8_LAS unsigned char* lds, const Gemm g, const Sched& S, const Epi& E) {
    int tid_o = threadIdx.x; asm volatile("" : "+v"(tid_o));
    const int tid = tid_o, wid = __builtin_amdgcn_readfirstlane(tid >> 6), lane = tid & 63, wr = wid >> 2, wc = wid & 3, fr = lane & 15, fq = lane >> 4;
    const int K = g.K;
    unsigned voffA[2], voffB[2];
#pragma unroll
    for (int i = 0; i < 2; ++i) { int R, C; stage_rc(tid * 16 + i * 8192, R, C); const int Rb = Epi::PERM ? ((R & ~31) + perm32(R & 31)) : R;
        voffA[i] = (unsigned)(R * K + C) * 2u; voffB[i] = (unsigned)(Rb * K + C) * 2u; }
    const size_t kstep = (size_t)(BK * 2);
    const size_t hstep = (size_t)HALF * K * 2;
    const size_t tstep = 2 * hstep;
    const unsigned ldsw = (unsigned)wid * 1024u;
    const int aoff = lds_byte(wr * 64 + fr, fq * 8), boff = lds_byte(wc * 32 + fr, fq * 8);
#define PG8_SA(b, h) (((b) * 2 + (h)) * HTB)
#define PG8_SB(b, h) ((4 + (b) * 2 + (h)) * HTB)
#define PG8_STAGE(bufoff, gbase, voff) do { _Pragma("unroll") for (int _i = 0; _i < 2; ++_i) \
        __builtin_amdgcn_global_load_lds((const unsigned*)((const char*)(gbase) + (voff)[_i]), (PG8_LAS unsigned*)(lds + (bufoff) + ldsw + _i * 8192), 16, 0, 0); } while (0)
#define PG8_LDA(dst, b, h) do { _Pragma("unroll") for (int m = 0; m < 4; ++m) _Pragma("unroll") for (int k = 0; k < 2; ++k) dst[m][k] = *(const PG8_LAS bf16x8*)(lds + PG8_SA(b, h) + aoff + m * 2048 + k * 1024); } while (0)
#define PG8_LDB(dst, b, h) do { _Pragma("unroll") for (int n = 0; n < 2; ++n) _Pragma("unroll") for (int k = 0; k < 2; ++k) dst[n][k] = *(const PG8_LAS bf16x8*)(lds + PG8_SB(b, h) + boff + n * 2048 + k * 1024); } while (0)
#define PG8_MMA(ai, bj, At, Bt) do { __builtin_amdgcn_s_setprio(1); _Pragma("unroll") for (int m = 0; m < 4; ++m) _Pragma("unroll") for (int n = 0; n < 2; ++n) _Pragma("unroll") for (int k = 0; k < 2; ++k) \
        acc[ai][bj][m][n] = __builtin_amdgcn_mfma_f32_16x16x32_bf16(Bt[n][k], At[m][k], acc[ai][bj][m][n], 0, 0, 0); __builtin_amdgcn_s_setprio(0); } while (0)
#define PG8_WAIT_V(n) asm volatile("s_waitcnt vmcnt(" #n ")" ::: "memory")
#define PG8_WAIT_L(n) asm volatile("s_waitcnt lgkmcnt(" #n ")" ::: "memory")
#define PG8_BAR __builtin_amdgcn_s_barrier()
#define PG8_SCHED __builtin_amdgcn_sched_barrier(0)
    Unit cur, nxt; int ui = 0;
    if (!S.next(0, cur)) return;
    f32x4 acc[2][2][4][2];
#pragma unroll
    for (int a = 0; a < 2; ++a)
#pragma unroll
        for (int b = 0; b < 2; ++b)
#pragma unroll
            for (int m = 0; m < 4; ++m)
#pragma unroll
                for (int n = 0; n < 2; ++n) acc[a][b][m][n] = (f32x4){0.f, 0.f, 0.f, 0.f};
    bf16x8 At[4][2], B0[2][2], B1[2][2];
    const char* cA = (const char*)g.A + (size_t)cur.pm * tstep + (size_t)cur.kt0 * kstep; const char* cB = (const char*)g.Bt + (size_t)cur.pn * tstep + (size_t)cur.kt0 * kstep;
    S.a_ready(cur);
    if constexpr (SP2) {
        PG8_STAGE(PG8_SB(0, 0), cB, voffB); PG8_STAGE(PG8_SB(0, 1), cB + hstep, voffB); PG8_STAGE(PG8_SA(0, 0), cA, voffA); PG8_STAGE(PG8_SA(0, 1), cA + hstep, voffA);
        if (wr == 1) PG8_BAR;
        PG8_WAIT_V(2); PG8_BAR;
        PG8_STAGE(PG8_SB(1, 0), cB + kstep, voffB); PG8_STAGE(PG8_SA(1, 0), cA + kstep, voffA); PG8_STAGE(PG8_SB(1, 1), cB + hstep + kstep, voffB);
        PG8_WAIT_V(6); PG8_BAR;
    } else {
        PG8_STAGE(PG8_SB(0, 0), cB, voffB); PG8_STAGE(PG8_SA(0, 0), cA, voffA); PG8_STAGE(PG8_SB(0, 1), cB + hstep, voffB); PG8_STAGE(PG8_SA(0, 1), cA + hstep, voffA);
        if (wr == 1) PG8_BAR;
        PG8_WAIT_V(4); PG8_BAR;
        PG8_STAGE(PG8_SB(1, 0), cB + kstep, voffB); PG8_STAGE(PG8_SA(1, 0), cA + kstep, voffA); PG8_STAGE(PG8_SB(1, 1), cB + hstep + kstep, voffB);
        PG8_WAIT_V(6); PG8_BAR;
    }
    for (;;) {
        const bool has_next = S.next(ui + 1, nxt);
        const char* nA = has_next ? (const char*)g.A + (size_t)nxt.pm * tstep + (size_t)nxt.kt0 * kstep : cA; const char* nB = has_next ? (const char*)g.Bt + (size_t)nxt.pn * tstep + (size_t)nxt.kt0 * kstep : cB;
        const int nt = cur.nt;
        for (int t = 0; t < nt; t += 2) {
            const bool last = (t == nt - 2);
            const char* a1 = cA + (size_t)(t + 1) * kstep;
            const char* a2 = last ? nA : cA + (size_t)(t + 2) * kstep; const char* b2 = last ? nB : cB + (size_t)(t + 2) * kstep;
            const char* a3 = a2 + kstep; const char* b3 = b2 + kstep;
            if (last && has_next) S.a_ready(nxt);
            if constexpr (SP2) {
            PG8_LDB(B0, 0, 0); PG8_LDB(B1, 0, 1); PG8_SCHED; PG8_LDA(At, 0, 0); PG8_STAGE(PG8_SA(1, 1), a1 + hstep, voffA);
            PG8_WAIT_V(8); PG8_WAIT_L(0); PG8_BAR; PG8_MMA(0, 0, At, B0); PG8_MMA(0, 1, At, B1); PG8_BAR; PG8_SCHED;
            PG8_LDA(At, 0, 1); PG8_STAGE(PG8_SB(0, 0), b2, voffB); PG8_STAGE(PG8_SB(0, 1), b2 + hstep, voffB); PG8_STAGE(PG8_SA(0, 0), a2, voffA);
            PG8_WAIT_V(8); PG8_WAIT_L(0); PG8_BAR; PG8_MMA(1, 0, At, B0); PG8_MMA(1, 1, At, B1); PG8_BAR; PG8_SCHED;
            PG8_LDB(B0, 1, 0); PG8_LDB(B1, 1, 1); PG8_SCHED; PG8_LDA(At, 1, 0); PG8_STAGE(PG8_SA(0, 1), a2 + hstep, voffA);
            PG8_WAIT_V(8); PG8_WAIT_L(0); PG8_BAR; PG8_MMA(0, 0, At, B0); PG8_MMA(0, 1, At, B1); PG8_BAR; PG8_SCHED;
            PG8_LDA(At, 1, 1); PG8_STAGE(PG8_SB(1, 0), b3, voffB); PG8_STAGE(PG8_SB(1, 1), b3 + hstep, voffB); PG8_STAGE(PG8_SA(1, 0), a3, voffA);
            PG8_WAIT_V(8); PG8_WAIT_L(0); PG8_BAR; PG8_MMA(1, 0, At, B0); PG8_MMA(1, 1, At, B1); PG8_BAR; PG8_SCHED;
            } else {
            PG8_LDB(B0, 0, 0); PG8_SCHED; PG8_LDA(At, 0, 0); PG8_STAGE(PG8_SA(1, 1), a1 + hstep, voffA);
            PG8_WAIT_L(8); PG8_BAR; PG8_WAIT_L(0); PG8_MMA(0, 0, At, B0); PG8_BAR; PG8_SCHED;
            PG8_LDB(B1, 0, 1); PG8_STAGE(PG8_SB(0, 0), b2, voffB);
            PG8_BAR; PG8_WAIT_L(0); PG8_MMA(0, 1, At, B1); PG8_BAR;
            PG8_LDA(At, 0, 1); PG8_STAGE(PG8_SA(0, 0), a2, voffA);
            PG8_BAR; PG8_WAIT_L(0); PG8_MMA(1, 0, At, B0); PG8_BAR; PG8_SCHED;
            PG8_STAGE(PG8_SB(0, 1), b2 + hstep, voffB);
            PG8_WAIT_V(6); PG8_BAR; PG8_MMA(1, 1, At, B1); PG8_BAR;
            PG8_LDB(B0, 1, 0); PG8_SCHED; PG8_LDA(At, 1, 0); PG8_STAGE(PG8_SA(0, 1), a2 + hstep, voffA);
            PG8_WAIT_L(8); PG8_BAR; PG8_WAIT_L(0); PG8_MMA(0, 0, At, B0); PG8_BAR; PG8_SCHED;
            PG8_LDB(B1, 1, 1); PG8_STAGE(PG8_SB(1, 0), b3, voffB);
            PG8_BAR; PG8_WAIT_L(0); PG8_MMA(0, 1, At, B1); PG8_BAR;
            PG8_LDA(At, 1, 1); PG8_STAGE(PG8_SA(1, 0), a3, voffA);
            PG8_BAR; PG8_WAIT_L(0); PG8_MMA(1, 0, At, B0); PG8_BAR; PG8_SCHED;
            PG8_STAGE(PG8_SB(1, 1), b3 + hstep, voffB);
            PG8_WAIT_V(6); PG8_BAR; PG8_MMA(1, 1, At, B1); PG8_BAR;
            }
        }
        if constexpr (ALIGN_EPI) { if (wr == 0) PG8_BAR; }
        if constexpr (!Epi::AFTER_DRAIN) { if constexpr (Epi::SPLITK) { if (cur.split >= 0) E.partial(acc, cur, wr, wc, fr, fq, lds, tid); else E(acc, cur, wr, wc, fr, fq); } else if constexpr (Epi::USES_LDS) E.with_lds(acc, cur, wr, wc, fr, fq, lds); else E(acc, cur, wr, wc, fr, fq); S.done(cur); }
        if (!has_next) break;
#pragma unroll
        for (int a = 0; a < 2; ++a)
#pragma unroll
            for (int b = 0; b < 2; ++b)
#pragma unroll
                for (int m = 0; m < 4; ++m)
#pragma unroll
                    for (int n = 0; n < 2; ++n) acc[a][b][m][n] = (f32x4){0.f, 0.f, 0.f, 0.f};
        cur = nxt; cA = nA; cB = nB; ++ui;
        if constexpr (ALIGN_EPI) { if (wr == 1) PG8_BAR; }
    }
    PG8_WAIT_V(0);
    if constexpr (!ALIGN_EPI) { if (wr == 0) PG8_BAR; }
    PG8_BAR;
    if constexpr (Epi::AFTER_DRAIN) { E.fused(acc, cur, wr, wc, fr, fq, lds, wid, lane); S.done(cur); }
#undef PG8_SA
#undef PG8_SB
#undef PG8_STAGE
#undef PG8_LDA
#undef PG8_LDB
#undef PG8_MMA
#undef PG8_WAIT_V
#undef PG8_WAIT_L
#undef PG8_BAR
#undef PG8_SCHED
}
}

typedef unsigned short bf16;
typedef short bf16x8 __attribute__((ext_vector_type(8)));
typedef short s16x4 __attribute__((ext_vector_type(4)));
typedef float f32x4 __attribute__((ext_vector_type(4)));
typedef float f32x16 __attribute__((ext_vector_type(16)));
typedef unsigned u32x4 __attribute__((ext_vector_type(4)));
typedef unsigned u32x2 __attribute__((ext_vector_type(2)));
using pg8::pkbf;
constexpr float EPS = 1e-6f;
DI float bf_lo(unsigned w) { return __uint_as_float(w << 16); }
DI float bf_hi(unsigned w) { return __uint_as_float(w & 0xffff0000u); }
DI float bf2f(bf16 v) { return __uint_as_float((unsigned)v << 16); }
DI bf16 f2bf(float f) { return (bf16)(pkbf(f, f) & 0xffffu); }
DI void unpack8(const u32x4 w, float (&f)[8]) { f[0] = bf_lo(w.x); f[1] = bf_hi(w.x); f[2] = bf_lo(w.y); f[3] = bf_hi(w.y); f[4] = bf_lo(w.z); f[5] = bf_hi(w.z); f[6] = bf_lo(w.w); f[7] = bf_hi(w.w); }
DI u32x4 pack8(const float (&f)[8]) { u32x4 w; w.x = pkbf(f[0], f[1]); w.y = pkbf(f[2], f[3]); w.z = pkbf(f[4], f[5]); w.w = pkbf(f[6], f[7]); return w; }
DI float wave_sum(float v) {
#pragma unroll
    for (int o = 1; o < 64; o <<= 1) v += __shfl_xor(v, o);
    return v;
}
DI float silu_f(float x) { return x * __builtin_amdgcn_rcpf(1.0f + __builtin_amdgcn_exp2f(-1.4426950408889634f * x)); }

#define XB_TMO      128
#define XB_XCNT(j)  (256  + 64 * (j))
#define XB_XSUB(j)  (1280 + 64 * (j))
#define XB_XGEN(j)  (2304 + 64 * (j))
#define XB_TOP      3328
#define XB_TOPGEN   3392
#define XCD_BAR_WORDS 3456
#define XB_SPIN_CAP (1u << 18)

__device__ __forceinline__ unsigned xb_ld(unsigned* p)              { return __hip_atomic_load(p, __ATOMIC_RELAXED, __HIP_MEMORY_SCOPE_AGENT); }
__device__ __forceinline__ unsigned xb_add(unsigned* p, unsigned v) { return __hip_atomic_fetch_add(p, v, __ATOMIC_RELAXED, __HIP_MEMORY_SCOPE_AGENT); }
__device__ __forceinline__ unsigned xb_xcc_id() { return (unsigned)__builtin_amdgcn_s_getreg((3 << 11) | 20) & 0xFu; }
#define XB_SPIN(cond, bar) do { unsigned _sp = 0; while (cond) { __builtin_amdgcn_s_sleep(1); \
    if ((++_sp & 255u) == 0u) { if (xb_ld(&(bar)[XB_TMO])) break; if (_sp > XB_SPIN_CAP) { atomicAdd(&(bar)[XB_TMO], 1u); break; } } } } while (0)

struct XcdBarrier {
    unsigned* bar; unsigned x;
    volatile LAS unsigned* st;
};

__device__ __forceinline__ XcdBarrier xcd_barrier_post(unsigned* bar, volatile LAS unsigned* st) {
    XcdBarrier b; b.bar = bar; b.x = xb_xcc_id(); b.st = st;
    if (threadIdx.x == 0) (void)xb_add(&bar[XB_XCNT(b.x)], 1u);
    return b;
}
__device__ __forceinline__ void xcd_barrier_complete(unsigned* bar, unsigned x, unsigned& nloc, unsigned& nx) {
    const unsigned G = gridDim.x * gridDim.y * gridDim.z;
    unsigned sum, cnt, mine, sp = 0u;
    for (;;) {
        sum = 0u; cnt = 0u; mine = 0u;
#pragma unroll
        for (unsigned j = 0; j < 16; ++j) { const unsigned c = xb_ld(&bar[XB_XCNT(j)]); sum += c; cnt += (c > 0u) ? 1u : 0u; mine = (j == x) ? c : mine; }
        if (sum == G) break;
        __builtin_amdgcn_s_sleep(1);
        if ((++sp & 255u) == 0u) { if (xb_ld(&bar[XB_TMO])) break; if (sp > XB_SPIN_CAP) { atomicAdd(&bar[XB_TMO], 1u); break; } }
    }
    nloc = mine > 0u ? mine : 1u; nx = cnt > 0u ? cnt : 1u;
}

__device__ __forceinline__ void xcd_barrier(const XcdBarrier& b) {
    asm volatile("s_waitcnt vmcnt(0)" ::: "memory");
    __syncthreads();
    if (threadIdx.x == 0) {
        unsigned* bar = b.bar;
        __builtin_amdgcn_s_waitcnt(0);
        unsigned nloc = b.st[0], nx = b.st[1];
        if (nloc == 0u) { xcd_barrier_complete(bar, b.x, nloc, nx); b.st[0] = nloc; b.st[1] = nx; }
        const unsigned old = xb_add(&bar[XB_XSUB(b.x)], 1u);
        const unsigned gen = old / nloc;
        if (old + 1u == (gen + 1u) * nloc) {
            __builtin_amdgcn_fence(__ATOMIC_RELEASE, "agent");
            asm volatile("s_waitcnt vmcnt(0)" ::: "memory");
            const unsigned og = xb_add(&bar[XB_TOP], 1u);
            const unsigned tg = og / nx;
            if (og + 1u == (tg + 1u) * nx) xb_add(&bar[XB_TOPGEN], 1u);
            else XB_SPIN(xb_ld(&bar[XB_TOPGEN]) == tg, bar);
            __builtin_amdgcn_fence(__ATOMIC_ACQUIRE, "agent");
            xb_add(&bar[XB_XGEN(b.x)], 1u);
            asm volatile("s_waitcnt vmcnt(0)" ::: "memory");
        } else {
            XB_SPIN(xb_ld(&bar[XB_XGEN(b.x)]) == gen, bar);
            __builtin_amdgcn_fence(__ATOMIC_ACQUIRE, "agent");
            asm volatile("s_waitcnt vmcnt(0)" ::: "memory");
        }
    }
    __syncthreads();
}

constexpr int DM = 4096, RP = 16384, RSM = 512, R = RP + RSM;
constexpr int SEQ = 2048, DSEQ = 64, PAST = 2048, KVS = PAST + DSEQ;
constexpr int KVROWS = RP + 8 * KVS;
constexpr int NIN = 7936;
constexpr int PC_Z = 1536, PC_XBC = 3584, PC_KPE = 7680, PC_DT = 7744;
constexpr int DFF = 11008, NMEM = 256;
constexpr int NLAYER = 2, NPH = 13;

constexpr size_t O_Y = 0, O_CKV_P = 69206016, O_KPE_P = 85983232, O_CONV_P = 88080384, O_SSM_P = 88276992, O_MK_P = 92471296, O_MV_P = 94568448,
                 O_CKV_S = 96665600, O_KPE_S = 97189888, O_CONV_S = 97255424, O_SSM_S = 97452032, O_END = 101646336;

constexpr size_t al256(size_t x) { return (x + 255) / 256 * 256; }
constexpr size_t WS_CTL = 0, CTL_ZERO_BYTES = 1u << 20;
constexpr int CW_TMO = 0, CW_BAR = 4096, CW_SPLIT = 8192, CW_SS = 16384, CW_SSM = CW_SS + 7 * R;
static_assert((CW_SSM + 2048) * 4 <= (int)CTL_ZERO_BYTES && CW_SPLIT + NLAYER * NPH * 256 <= CW_SS, "ctl");
constexpr size_t WS_ROPE = 1u << 20;
constexpr size_t WS_W = 2u << 20;
constexpr size_t W_IN = WS_W, W_UQ = W_IN + (size_t)NIN * 4096 * 2, W_UKV = W_UQ + (size_t)3072 * 1024 * 2, W_O = W_UKV + (size_t)4096 * 512 * 2,
                 W_XQ = W_O + (size_t)4096 * 4096 * 2, W_XKV = W_XQ + (size_t)512 * 4096 * 2, W_XO = W_XKV + (size_t)1024 * 4096 * 2,
                 W_GU = W_XO + (size_t)4096 * 512 * 2, W_DN = W_GU + (size_t)22016 * 4096 * 2, W_END = W_DN + (size_t)4096 * 11008 * 2;
constexpr size_t A_XB = al256(W_END), A_MB = A_XB + (size_t)R * 4096 * 2, A_MEMF = A_MB + (size_t)2048 * 4096 * 2, A_MEMK = A_MEMF + (size_t)2048 * 1024 * 4,
                 A_MEMV = A_MEMK + (size_t)4096 * 512 * 2, A_XQ = A_MEMV + (size_t)4096 * 512 * 2, A_XO = A_XQ + (size_t)R * 512 * 2, A_DT = A_XO + (size_t)R * 512 * 2,
                 A_CQN = A_DT + (size_t)R * 32 * 4, A_CKV = A_CQN + (size_t)R * 1024 * 2, A_KPE = A_CKV + (size_t)KVROWS * 512 * 2, A_YG = A_KPE + (size_t)KVROWS * 64 * 2,
                 A_MIX = A_YG + (size_t)R * 2048 * 2, A_Q = A_MIX + (size_t)R * 4096 * 2, A_KV = A_Q + (size_t)R * 3072 * 2, A_PROJ = A_KV + (size_t)KVROWS * 4096 * 2,
                 A_XBC = A_PROJ + (size_t)R * NIN * 2, A_WGU2 = A_XBC + (size_t)R * 4096 * 2, A_END = A_WGU2 + (size_t)22016 * 4096 * 2, A_H = A_PROJ;
static_assert((size_t)R * DFF * 2 <= A_WGU2 - A_PROJ, "H overlay");
constexpr size_t WS_NEED = A_END;

constexpr int RING_BYTES = 131072, LDS_BYTES = 163840, MISC_OFF = LDS_BYTES - 256;

struct Args {
    const float* in[38]; float* out; unsigned char* ws; int ph_lo, ph_hi;
};
#define AS4 __attribute__((address_space(4)))
struct Ctx {
    LAS unsigned char* lds; int tid, lane, wave, G, bid;
    const float* const AS4* in; float* out; unsigned char* ws; unsigned* ctl;
};
extern __shared__ __attribute__((aligned(16))) unsigned char lds_raw[];
DI Ctx make_ctx() {
    Ctx F; int tid = threadIdx.x; asm volatile("" : "+v"(tid));
    const AS4 unsigned char* ka = (const AS4 unsigned char*)__builtin_amdgcn_kernarg_segment_ptr(); asm volatile("" : "+s"(ka));
    F.lds = (LAS unsigned char*)lds_raw; F.tid = tid; F.lane = tid & 63; F.wave = __builtin_amdgcn_readfirstlane(tid >> 6); F.G = gridDim.x; F.bid = blockIdx.x;
    F.in = (const float* const AS4*)ka; F.out = *(float* const AS4*)(ka + 38 * 8); F.ws = *(unsigned char* const AS4*)(ka + 39 * 8); F.ctl = (unsigned*)(F.ws + WS_CTL);
    return F;
}
enum { I_XP = 0, I_XS, I_MEM, I_CCKV, I_CKPE, I_SCONV, I_SSSM, I_CMK, I_CMV, I_NMIX, I_WIN, I_QNORM, I_WUQ, I_KVNORM, I_WUKV, I_QNN, I_QNP, I_KNN, I_KNP, I_CONVW, I_CONVB, I_DTB, I_ALOG, I_DSKIP,
       I_SSMN, I_WO, I_NXA, I_MEMN, I_WXQ, I_WXK, I_WXV, I_XNQ, I_XNK, I_WXO, I_NFFN, I_WG, I_WU, I_WD };

DI void p_prologue(const Ctx& F) {
    const int gw = F.bid * 8 + F.wave, NGW = F.G * 8, lane = F.lane;
    float* SS0 = (float*)F.ctl + CW_SS; float* SSM = (float*)F.ctl + CW_SSM;
    bf16* XB = (bf16*)(F.ws + A_XB); bf16* MB = (bf16*)(F.ws + A_MB);
    for (int row = gw; row < R + 2048; row += NGW) {
        const float* src; float* dstf = nullptr; bf16* dstb; float* ssp;
        if (row < RP) { src = F.in[I_XP] + (size_t)row * DM; dstb = XB + (size_t)row * DM; ssp = SS0 + row; }
        else if (row < R) { src = F.in[I_XS] + (size_t)(row - RP) * DM; dstb = XB + (size_t)row * DM; ssp = SS0 + row; }
        else { const int mr = row - R; src = F.in[I_MEM] + (size_t)mr * DM; dstb = MB + (size_t)mr * DM; ssp = SSM + mr; }
        float sq = 0.f;
#pragma unroll
        for (int j = 0; j < 8; ++j) {
            const f32x4 a = *(const f32x4*)(src + j * 512 + lane * 8), b = *(const f32x4*)(src + j * 512 + lane * 8 + 4);
            sq += (a[0] * a[0] + a[1] * a[1]) + (a[2] * a[2] + a[3] * a[3]) + (b[0] * b[0] + b[1] * b[1]) + (b[2] * b[2] + b[3] * b[3]);
            if (dstf) { *(f32x4*)(dstf + j * 512 + lane * 8) = a; *(f32x4*)(dstf + j * 512 + lane * 8 + 4) = b; }
            u32x4 w; w.x = pkbf(a[0], a[1]); w.y = pkbf(a[2], a[3]); w.z = pkbf(b[0], b[1]); w.w = pkbf(b[2], b[3]);
            *(u32x4*)(dstb + j * 512 + lane * 8) = w;
        }
        sq = wave_sum(sq);
        if (lane == 0) *ssp = sq;
    }
    float* ctab = (float*)(F.ws + WS_ROPE); float* stab = ctab + KVS * 32;
    for (int i = F.bid * 512 + F.tid; i < KVS * 32; i += F.G * 512) {
        const int pos = i >> 5, k = i & 31;
        const float inv = powf(10000.0f, -(float)k / 32.0f);
        const float ang = (float)pos * inv;
        ctab[i] = cosf(ang); stab[i] = sinf(ang);
    }
}

struct CvItem { const float* src; const float* gain; bf16* dst; int ldw, K, nvalid; };
DI CvItem cv_decode(const Ctx& F, int l, int it) {
    unsigned char* ws = F.ws; CvItem c; c.gain = nullptr; c.nvalid = 64;
    constexpr int N_IN = 122 * 64, N_UQ = 48 * 16, N_UKV = 64 * 8, N_O = 64 * 64, N_XQ = 8 * 64, N_XK = 8 * 64, N_XV = 8 * 64, N_XO = 64 * 8, N_G = 172 * 64, N_U = 172 * 64;
    int r = it;
    if (r < N_IN) { const int kb = r / 122, nb = r % 122, cc = nb * 64; int dr; if (cc < 1536) dr = cc; else if (cc < 1600) dr = PC_KPE; else if (cc < 3648) dr = PC_Z + (cc - 1600); else if (cc < 7744) dr = PC_XBC + (cc - 3648); else { dr = PC_DT; c.nvalid = 32; }
        c.src = F.in[I_WIN] + (size_t)l * 4096 * 7776 + (size_t)kb * 64 * 7776 + cc; c.ldw = 7776; c.gain = F.in[I_NMIX] + l * 4096 + kb * 64; c.K = 4096; c.dst = (bf16*)(ws + W_IN) + (size_t)dr * 4096 + kb * 64; return c; } r -= N_IN;
    if (r < N_UQ) { const int kb = r / 48, nb = r % 48; c.src = F.in[I_WUQ] + (size_t)l * 1024 * 3072 + (size_t)kb * 64 * 3072 + nb * 64; c.ldw = 3072; c.gain = F.in[I_QNORM] + l * 1024 + kb * 64; c.K = 1024; c.dst = (bf16*)(ws + W_UQ) + (size_t)nb * 64 * 1024 + kb * 64; return c; } r -= N_UQ;
    if (r < N_UKV) { const int kb = r / 64, nb = r % 64; c.src = F.in[I_WUKV] + (size_t)l * 512 * 4096 + (size_t)kb * 64 * 4096 + nb * 64; c.ldw = 4096; c.K = 512; c.dst = (bf16*)(ws + W_UKV) + (size_t)nb * 64 * 512 + kb * 64; return c; } r -= N_UKV;
    if (r < N_O) { const int kb = r / 64, nb = r % 64; c.src = F.in[I_WO] + (size_t)l * 4096 * 4096 + (size_t)kb * 64 * 4096 + nb * 64; c.ldw = 4096; c.K = 4096; c.dst = (bf16*)(ws + W_O) + (size_t)nb * 64 * 4096 + kb * 64; return c; } r -= N_O;
    if (r < N_XQ) { const int kb = r / 8, nb = r % 8; c.src = F.in[I_WXQ] + (size_t)l * 4096 * 512 + (size_t)kb * 64 * 512 + nb * 64; c.ldw = 512; c.gain = F.in[I_NXA] + l * 4096 + kb * 64; c.K = 4096; c.dst = (bf16*)(ws + W_XQ) + (size_t)nb * 64 * 4096 + kb * 64; return c; } r -= N_XQ;
    if (r < N_XK) { const int kb = r / 8, nb = r % 8; c.src = F.in[I_WXK] + (size_t)l * 4096 * 512 + (size_t)kb * 64 * 512 + nb * 64; c.ldw = 512; c.gain = F.in[I_MEMN] + l * 4096 + kb * 64; c.K = 4096; c.dst = (bf16*)(ws + W_XKV) + (size_t)nb * 64 * 4096 + kb * 64; return c; } r -= N_XK;
    if (r < N_XV) { const int kb = r / 8, nb = r % 8; c.src = F.in[I_WXV] + (size_t)l * 4096 * 512 + (size_t)kb * 64 * 512 + nb * 64; c.ldw = 512; c.gain = F.in[I_MEMN] + l * 4096 + kb * 64; c.K = 4096; c.dst = (bf16*)(ws + W_XKV) + (size_t)(512 + nb * 64) * 4096 + kb * 64; return c; } r -= N_XV;
    if (r < N_XO) { const int kb = r / 64, nb = r % 64; c.src = F.in[I_WXO] + (size_t)l * 512 * 4096 + (size_t)kb * 64 * 4096 + nb * 64; c.ldw = 4096; c.K = 512; c.dst = (bf16*)(ws + W_XO) + (size_t)nb * 64 * 512 + kb * 64; return c; } r -= N_XO;
    if (r < N_G) { const int kb = r / 172, nb = r % 172; c.src = F.in[I_WG] + (size_t)l * 4096 * DFF + (size_t)kb * 64 * DFF + nb * 64; c.ldw = DFF; c.gain = F.in[I_NFFN] + l * 4096 + kb * 64; c.K = 4096; c.dst = (bf16*)(ws + ((l & 1) ? A_WGU2 : W_GU)) + (size_t)((nb >> 1) * 256 + (nb & 1) * 64) * 4096 + kb * 64; return c; } r -= N_G;
    if (r < N_U) { const int kb = r / 172, nb = r % 172; c.src = F.in[I_WU] + (size_t)l * 4096 * DFF + (size_t)kb * 64 * DFF + nb * 64; c.ldw = DFF; c.gain = F.in[I_NFFN] + l * 4096 + kb * 64; c.K = 4096; c.dst = (bf16*)(ws + ((l & 1) ? A_WGU2 : W_GU)) + (size_t)((nb >> 1) * 256 + 128 + (nb & 1) * 64) * 4096 + kb * 64; return c; } r -= N_U;
    { const int kb = r / 64, nb = r % 64; c.src = F.in[I_WD] + (size_t)l * DFF * 4096 + (size_t)kb * 64 * 4096 + nb * 64; c.ldw = 4096; c.K = DFF; c.dst = (bf16*)(ws + W_DN) + (size_t)nb * 64 * DFF + kb * 64; return c; }
}
constexpr int CV_NITEMS = 122 * 64 + 48 * 16 + 64 * 8 + 64 * 64 + 3 * 8 * 64 + 64 * 8 + 2 * 172 * 64 + 64 * 172;
DI void cv_load(const CvItem& c, f32x4 (&v)[16], int lane) {
    const int n4 = (lane & 15) * 4, kr = lane >> 4; const float* p = c.src + (size_t)kr * c.ldw + n4;
    if (n4 < c.nvalid) {
#pragma unroll
        for (int i = 0; i < 16; ++i) v[i] = __builtin_nontemporal_load((const f32x4*)(p + (size_t)(4 * i) * c.ldw));
    } else {
#pragma unroll
        for (int i = 0; i < 16; ++i) v[i] = (f32x4){0.f, 0.f, 0.f, 0.f};
    }
}
DI void cv_store(const CvItem& c, const f32x4 (&v)[16], LAS unsigned char* scr, int lane) {
    constexpr int RS = 144;
    const int l15 = lane & 15, kr = lane >> 4;
#pragma unroll
    for (int i = 0; i < 16; ++i) { const int k = kr + 4 * i; const float g = c.gain ? c.gain[k] : 1.0f;
        u32x2 w; w.x = pkbf(v[i][0] * g, v[i][1] * g); w.y = pkbf(v[i][2] * g, v[i][3] * g);
        *(LAS u32x2*)(scr + k * RS + l15 * 8) = w; }
    asm volatile("s_waitcnt lgkmcnt(0)" ::: "memory");
    typedef short v4i16_t __attribute__((ext_vector_type(4)));
    const int g4 = lane >> 4, q = l15 >> 2, pp = lane & 3;
#pragma unroll
    for (int cb = 0; cb < 4; ++cb)
#pragma unroll
        for (int kh = 0; kh < 2; ++kh) {
            const LAS unsigned char* a = scr + (32 * kh + 8 * g4 + q) * RS + (16 * cb + 4 * pp) * 2;
            const s16x4 lo = __builtin_bit_cast(s16x4, __builtin_amdgcn_ds_read_tr16_b64_v4i16((LAS v4i16_t*)a));
            const s16x4 hi = __builtin_bit_cast(s16x4, __builtin_amdgcn_ds_read_tr16_b64_v4i16((LAS v4i16_t*)(a + 4 * RS)));
            const bf16x8 o = (bf16x8){lo[0], lo[1], lo[2], lo[3], hi[0], hi[1], hi[2], hi[3]};
            *(bf16x8*)(c.dst + (size_t)(16 * cb + l15) * c.K + 32 * kh + 8 * g4) = o; }
    asm volatile("s_waitcnt lgkmcnt(0)" ::: "memory");
}
constexpr int CV_E3 = 122 * 64 + 48 * 16 + 64 * 8 + 64 * 64 + 3 * 8 * 64 + 64 * 8;
constexpr int CV_GU0 = CV_E3, CV_GU3 = CV_E3 + 2 * 172 * 64, CV_GU1 = CV_GU3 - 7000;
static_assert(CV_GU3 == 37248, "gate/up item range");
constexpr int CV_A0 = 122 * 64 + 48 * 16 + 64 * 8;
constexpr int CV_AGU = 5000;
constexpr int CV_DX = 1500, CV_DG = 2500 + (CV_E3 - CV_A0);
#define CV_MAP(v_) ((v_) < n1 ? la : lb), ((v_) < n1 ? a0 + (v_) : b0 + ((v_) - n1))
#ifndef CV_TAILW
#define CV_TAILW 8
#endif
DI void p_convw_range(const Ctx& F, int la, int a0, int n1, int lb, int b0, int n2, int wg0, int nwg, int nwv = 8, int rank = -1) {
    if (F.wave >= nwv) return;
    LAS unsigned char* scr = F.lds + F.wave * 16384;
    const int gw = (rank >= 0 ? rank : F.bid - wg0) * nwv + F.wave, NGW = nwg * nwv, lane = F.lane;
    const int CV_END = n1 + n2;
    CvItem ca, cb, cc; f32x4 va[16], vb[16], vc[16];
    int nx = gw;
    bool ha = nx < CV_END; if (ha) { ca = cv_decode(F, CV_MAP(nx)); cv_load(ca, va, lane); } nx += NGW;
    bool hb = nx < CV_END; if (hb) { cb = cv_decode(F, CV_MAP(nx)); cv_load(cb, vb, lane); } nx += NGW;
    if (ha) for (;;) {
        const bool hc = nx < CV_END; if (hc) { cc = cv_decode(F, CV_MAP(nx)); cv_load(cc, vc, lane); } nx += NGW;
        cv_store(ca, va, scr, lane);
        if (!hb) break;
        ha = nx < CV_END; if (ha) { ca = cv_decode(F, CV_MAP(nx)); cv_load(ca, va, lane); } nx += NGW;
        cv_store(cb, vb, scr, lane);
        if (!hc) break;
        hb = nx < CV_END; if (hb) { cb = cv_decode(F, CV_MAP(nx)); cv_load(cb, vb, lane); } nx += NGW;
        cv_store(cc, vc, scr, lane);
        if (!ha) break;
    }
}
DI void p_convw(const Ctx& F, int l) {
    if (F.G == 256) { const int s0 = l > 0 ? CV_E3 : 0, s1 = l > 0 ? CV_E3 : CV_A0, d0 = CV_GU3 + CV_DX + CV_DG, d1 = l + 1 < NLAYER ? CV_NITEMS : d0; p_convw_range(F, l, s0, s1 - s0, l, d0, d1 - d0, 0, F.G); }
    else p_convw_range(F, l, 0, CV_NITEMS, l, 0, 0, 0, F.G);
    { unsigned zz = 0u; asm volatile("" : "+v"(zz));
      u32x4 z = {zz, zz, zz, zz}; u32x4* p = (u32x4*)(F.ws + W_IN + (size_t)7808 * 4096 * 2); const int n16 = 128 * 4096 * 2 / 16;
      for (int i = F.bid * 512 + F.tid; i < n16; i += F.G * 512) p[i] = z; }
}

DI void p_post1(const Ctx& F, int l) {
    const int gw = F.bid * 8 + F.wave, NGW = F.G * 8, lane = F.lane;
    unsigned char* ws = F.ws;
    const bf16* PROJ = (const bf16*)(ws + A_PROJ);
    bf16* CQN = (bf16*)(ws + A_CQN); bf16* CKV = (bf16*)(ws + A_CKV); bf16* KPE = (bf16*)(ws + A_KPE); bf16* XBC = (bf16*)(ws + A_XBC); float* DT = (float*)(ws + A_DT);
    const float* ctab = (const float*)(ws + WS_ROPE); const float* stab = ctab + KVS * 32;
    const float* kv_norm = F.in[I_KVNORM] + l * 512; const float* kn_pe = F.in[I_KNP] + l * 64;
    const float* conv_w = F.in[I_CONVW] + l * 4 * 4096; const float* conv_b = F.in[I_CONVB] + l * 4096; const float* dt_bias = F.in[I_DTB] + l * 32;
    f32x4 dk0, dk1, dv0, dv1;
    if (2048 + gw < 4096) { const float* kp = F.in[I_CMK] + ((size_t)l * 2048 + gw) * 512 + lane * 8; dk0 = *(const f32x4*)kp; dk1 = *(const f32x4*)(kp + 4);
        const float* vp = F.in[I_CMV] + ((size_t)l * 2048 + gw) * 512 + lane * 8; dv0 = *(const f32x4*)vp; dv1 = *(const f32x4*)(vp + 4); }
    u32x4 nq0, nq1, nkv; bf16 nk, nd;
#define P1_LOAD(row_) do { const bf16* pr_ = PROJ + (size_t)(row_) * NIN; nq0 = *(const u32x4*)(pr_ + lane * 8); nq1 = *(const u32x4*)(pr_ + 512 + lane * 8); nkv = *(const u32x4*)(pr_ + 1024 + lane * 8); \
        nk = pr_[PC_KPE + lane]; nd = pr_[PC_DT + (lane & 31)]; } while (0)
    f32x4 nc0, nc1; float nkp;
#define P1_CLOAD(i_) do { const int b_ = (i_) >> 11, s_ = (i_) & 2047; const float* cp_ = F.in[I_CCKV] + ((size_t)(l * 8 + b_) * PAST + s_) * 512 + lane * 8; \
        nc0 = *(const f32x4*)cp_; nc1 = *(const f32x4*)(cp_ + 4); nkp = F.in[I_CKPE][((size_t)(l * 8 + b_) * PAST + s_) * 64 + lane]; } while (0)
    if (gw < R) P1_LOAD(gw);
    if (gw < 8 * PAST) P1_CLOAD(gw);
    for (int row = gw; row < R; row += NGW) {
        const bool samp = row >= RP; const int b = samp ? (row - RP) >> 6 : row >> 11, t = samp ? (row - RP) & 63 : row & 2047;
        const int pos = samp ? PAST + t : t; const int kvrow = samp ? RP + b * KVS + PAST + t : row;
        const u32x4 cq0 = nq0, cq1 = nq1, ckv = nkv; const bf16 ck = nk, cd = nd;
        const f32x4 cc0 = nc0, cc1 = nc1; const float ckp = nkp;
        if (row + NGW < R) P1_LOAD(row + NGW);
        if (row + NGW < 8 * PAST) P1_CLOAD(row + NGW);
        const float cs_c = ctab[pos * 32 + (lane & 31)], cs_s = stab[pos * 32 + (lane & 31)];
        {   float f0[8], f1[8]; unpack8(cq0, f0); unpack8(cq1, f1);
            float sq = 0.f;
#pragma unroll
            for (int j = 0; j < 8; ++j) sq += f0[j] * f0[j] + f1[j] * f1[j];
            const float rs = __builtin_amdgcn_rsqf(wave_sum(sq) * (1.0f / 1024.0f) + EPS);
#pragma unroll
            for (int j = 0; j < 8; ++j) { f0[j] *= rs; f1[j] *= rs; }
            *(u32x4*)(CQN + (size_t)row * 1024 + lane * 8) = pack8(f0); *(u32x4*)(CQN + (size_t)row * 1024 + 512 + lane * 8) = pack8(f1); }
        {   float f0[8]; unpack8(ckv, f0);
            float sq = 0.f;
#pragma unroll
            for (int j = 0; j < 8; ++j) sq += f0[j] * f0[j];
            const float rs = __builtin_amdgcn_rsqf(wave_sum(sq) * (1.0f / 512.0f) + EPS);
#pragma unroll
            for (int j = 0; j < 8; ++j) f0[j] *= rs * kv_norm[lane * 8 + j];
            float* op = samp ? F.out + O_CKV_S + ((size_t)(l * 8 + b) * 64 + t) * 512 : F.out + O_CKV_P + ((size_t)(l * 8 + b) * 2048 + t) * 512;
            *(f32x4*)(op + lane * 8) = (f32x4){f0[0], f0[1], f0[2], f0[3]}; *(f32x4*)(op + lane * 8 + 4) = (f32x4){f0[4], f0[5], f0[6], f0[7]};
            *(u32x4*)(CKV + (size_t)kvrow * 512 + lane * 8) = pack8(f0); }
        {   const float x = bf2f(ck);
            const float rs = __builtin_amdgcn_rsqf(wave_sum(x * x) * (1.0f / 64.0f) + EPS);
            const float xn = x * rs * kn_pe[lane]; const float other = __shfl_xor(xn, 32);
            const float o = lane < 32 ? xn * cs_c - other * cs_s : other * cs_s + xn * cs_c;
            float* op = samp ? F.out + O_KPE_S + ((size_t)(l * 8 + b) * 64 + t) * 64 : F.out + O_KPE_P + ((size_t)(l * 8 + b) * 2048 + t) * 64;
            op[lane] = o; KPE[(size_t)kvrow * 64 + lane] = f2bf(o); }
        if (lane < 32) { const float v = bf2f(cd) + dt_bias[lane]; DT[(size_t)row * 32 + lane] = v > 20.f ? v : 0.6931471805599453f * __builtin_amdgcn_logf(1.0f + __builtin_amdgcn_exp2f(1.4426950408889634f * v)); }
        if (row < 8 * PAST) { const int cb_ = row >> 11, cs_ = row & 2047; const size_t ckr = (size_t)RP + cb_ * KVS + cs_;
            u32x4 w; w.x = pkbf(cc0[0], cc0[1]); w.y = pkbf(cc0[2], cc0[3]); w.z = pkbf(cc1[0], cc1[1]); w.w = pkbf(cc1[2], cc1[3]);
            *(u32x4*)(CKV + ckr * 512 + lane * 8) = w; KPE[ckr * 64 + lane] = f2bf(ckp); }
    }
#undef P1_LOAD
#undef P1_CLOAD
    const int cvc = (gw & 7) * 512 + lane * 8;
    u32x4 xn[11];
#define P1_XLOAD(it_) do { const int rb_ = (it_) >> 3, r0_ = rb_ * 8; const bool samp_ = r0_ >= RP; const int b_ = samp_ ? (r0_ - RP) >> 6 : r0_ >> 11, t0_ = samp_ ? (r0_ - RP) & 63 : r0_ & 2047; \
        _Pragma("unroll") for (int i = 0; i < 11; ++i) { const int tt = t0_ - 3 + i; \
            if (tt >= 0) xn[i] = *(const u32x4*)(PROJ + (size_t)(r0_ - 3 + i) * NIN + PC_XBC + cvc); \
            else if (samp_) { const float* sp = F.in[I_SCONV] + ((size_t)(l * 8 + b_) * 3 + (tt + 3)) * 4096 + cvc; const f32x4 a0 = *(const f32x4*)sp, a1 = *(const f32x4*)(sp + 4); \
                xn[i].x = pkbf(a0[0], a0[1]); xn[i].y = pkbf(a0[2], a0[3]); xn[i].z = pkbf(a1[0], a1[1]); xn[i].w = pkbf(a1[2], a1[3]); } \
            else xn[i] = (u32x4){0u, 0u, 0u, 0u}; } } while (0)
    const int NCI = (R / 8) * 8;
    if (gw < NCI) P1_XLOAD(gw);
    float wt[4][8], bs[8];
    {   const int c = cvc;
#pragma unroll
        for (int i = 0; i < 4; ++i) { const f32x4 w0 = *(const f32x4*)(conv_w + i * 4096 + c), w1 = *(const f32x4*)(conv_w + i * 4096 + c + 4);
            wt[i][0] = w0[0]; wt[i][1] = w0[1]; wt[i][2] = w0[2]; wt[i][3] = w0[3]; wt[i][4] = w1[0]; wt[i][5] = w1[1]; wt[i][6] = w1[2]; wt[i][7] = w1[3]; }
        { const f32x4 b0 = *(const f32x4*)(conv_b + c), b1 = *(const f32x4*)(conv_b + c + 4); bs[0] = b0[0]; bs[1] = b0[1]; bs[2] = b0[2]; bs[3] = b0[3]; bs[4] = b1[0]; bs[5] = b1[1]; bs[6] = b1[2]; bs[7] = b1[3]; } }
    for (int it = gw; it < NCI; it += NGW) {
        const int rb = it >> 3, r0 = rb * 8, c = cvc;
        const bool samp = r0 >= RP; const int b = samp ? (r0 - RP) >> 6 : r0 >> 11, t0 = samp ? (r0 - RP) & 63 : r0 & 2047, L = samp ? DSEQ : SEQ;
        u32x4 xr[11];
#pragma unroll
        for (int i = 0; i < 11; ++i) xr[i] = xn[i];
        if (it + NGW < NCI) P1_XLOAD(it + NGW);
#pragma unroll
        for (int j = 0; j < 8; ++j) {
            float acc[8];
#pragma unroll
            for (int e = 0; e < 8; ++e) acc[e] = bs[e];
#pragma unroll
            for (int i = 0; i < 4; ++i) { float xv[8]; unpack8(xr[j + i], xv);
#pragma unroll
                for (int e = 0; e < 8; ++e) acc[e] += xv[e] * wt[i][e]; }
#pragma unroll
            for (int e = 0; e < 8; ++e) acc[e] = silu_f(acc[e]);
            *(u32x4*)(XBC + (size_t)(r0 + j) * 4096 + c) = pack8(acc);
            if (t0 + j >= L - 3) { float xv[8]; unpack8(xr[j + 3], xv);
                float* op = (samp ? F.out + O_CONV_S : F.out + O_CONV_P) + ((size_t)(l * 8 + b) * 3 + (t0 + j - (L - 3))) * 4096 + c;
                *(f32x4*)op = (f32x4){xv[0], xv[1], xv[2], xv[3]}; *(f32x4*)(op + 4) = (f32x4){xv[4], xv[5], xv[6], xv[7]}; }
        }
    }
    {   bf16* MEMK = (bf16*)(ws + A_MEMK); bf16* MEMV = (bf16*)(ws + A_MEMV);
        for (int row = 2048 + gw; row < 4096; row += NGW) {
            if (row != 2048 + gw) {
                const int mr = row - 2048;
                const float* kp = F.in[I_CMK] + ((size_t)l * 2048 + mr) * 512 + lane * 8; dk0 = *(const f32x4*)kp; dk1 = *(const f32x4*)(kp + 4);
                const float* vp = F.in[I_CMV] + ((size_t)l * 2048 + mr) * 512 + lane * 8; dv0 = *(const f32x4*)vp; dv1 = *(const f32x4*)(vp + 4);
            }
            u32x4 w; w.x = pkbf(dk0[0], dk0[1]); w.y = pkbf(dk0[2], dk0[3]); w.z = pkbf(dk1[0], dk1[1]); w.w = pkbf(dk1[2], dk1[3]);
            *(u32x4*)(MEMK + (size_t)row * 512 + lane * 8) = w;
            w.x = pkbf(dv0[0], dv0[1]); w.y = pkbf(dv0[2], dv0[3]); w.z = pkbf(dv1[0], dv1[1]); w.w = pkbf(dv1[2], dv1[3]);
            *(u32x4*)(MEMV + (size_t)row * 512 + lane * 8) = w;
        }
    }
}

DI void p_gnorm(const Ctx& F, int l) {
    const int gw = F.bid * 8 + F.wave, NGW = F.G * 8, lane = F.lane;
    const bf16* YG = (const bf16*)(F.ws + A_YG); bf16* MIX = (bf16*)(F.ws + A_MIX);
    const float* sn = F.in[I_SSMN] + l * 2048;
    u32x4 nw[4];
    f32x4 g0[4], g1[4];
#pragma unroll
    for (int p = 0; p < 4; ++p) { const int c = p * 512 + lane * 8; g0[p] = *(const f32x4*)(sn + c); g1[p] = *(const f32x4*)(sn + c + 4); }
    if (gw < R) {
#pragma unroll
        for (int p = 0; p < 4; ++p) nw[p] = *(const u32x4*)(YG + (size_t)gw * 2048 + p * 512 + lane * 8);
    }
    for (int row = gw; row < R; row += NGW) {
        u32x4 w[4];
#pragma unroll
        for (int p = 0; p < 4; ++p) w[p] = nw[p];
        if (row + NGW < R) {
#pragma unroll
            for (int p = 0; p < 4; ++p) nw[p] = *(const u32x4*)(YG + (size_t)(row + NGW) * 2048 + p * 512 + lane * 8);
        }
#pragma unroll
        for (int p = 0; p < 4; ++p) {
            float f[8]; unpack8(w[p], f); float sq = 0.f;
#pragma unroll
            for (int j = 0; j < 8; ++j) sq += f[j] * f[j];
            sq += __shfl_xor(sq, 1); sq += __shfl_xor(sq, 2); sq += __shfl_xor(sq, 4); sq += __shfl_xor(sq, 8); sq += __shfl_xor(sq, 16);
            const float rs = __builtin_amdgcn_rsqf(sq * (1.0f / 256.0f) + EPS);
            const int c = p * 512 + lane * 8;
            f[0] *= rs * g0[p][0]; f[1] *= rs * g0[p][1]; f[2] *= rs * g0[p][2]; f[3] *= rs * g0[p][3]; f[4] *= rs * g1[p][0]; f[5] *= rs * g1[p][1]; f[6] *= rs * g1[p][2]; f[7] *= rs * g1[p][3];
            *(u32x4*)(MIX + (size_t)row * 4096 + 2048 + c) = pack8(f);
        }
    }
}

namespace att {
#define KSWZ(row, colB) ((row) * 256 + ((colB) ^ (((row) & 7) << 4)))
#define PSWZ(row, colB) ((row) * 128 + ((colB) ^ (((row) & 7) << 4)))
#define SBAR() __builtin_amdgcn_sched_barrier(0)
constexpr int SHM_K = 16384, SHM_V = 16384, SHM_P = 8192, BUF = SHM_K + SHM_V + SHM_P, NBUF = 3, WSOFF = NBUF * BUF, QPOFF = WSOFF + 2048, ATT_END = QPOFF + 32768;
DI int crow(int r, int hi) { return (r & 3) + 8 * (r >> 2) + 4 * hi; }
DI int v_st(int k, int c) { const int kk = (k & ~0xC) | ((k & 4) << 1) | ((k & 8) >> 1); return ((kk >> 3) * 4 + (c >> 5)) * 512 + ((kk & 7) * 32 + (c & 31)) * 2; }
DI int v_rd_base(int lane) { return ((lane & 3) << 3) | (((lane >> 2) & 3) << 6) | (((lane >> 4) & 1) << 5) | (((lane >> 5) & 1) << 8); }
constexpr int v_rd_off(int d0, int ks, int half) { return d0 * 512 + ks * 4096 + half * 2048; }
template <int OFF> DI s16x4 tr_read(int vb) { s16x4 r; asm volatile("ds_read_b64_tr_b16 %0, %1 offset:%2" : "=&v"(r) : "v"(vb), "i"(OFF) : "memory"); return r; }
struct VFrag { s16x4 l0, h0, l1, h1, l2, h2, l3, h3; };
template <int D0> DI void v_read(VFrag& f, int vb) {
    f.l0 = tr_read<v_rd_off(D0, 0, 0)>(vb); f.h0 = tr_read<v_rd_off(D0, 0, 1)>(vb); f.l1 = tr_read<v_rd_off(D0, 1, 0)>(vb); f.h1 = tr_read<v_rd_off(D0, 1, 1)>(vb);
    f.l2 = tr_read<v_rd_off(D0, 2, 0)>(vb); f.h2 = tr_read<v_rd_off(D0, 2, 1)>(vb); f.l3 = tr_read<v_rd_off(D0, 3, 0)>(vb); f.h3 = tr_read<v_rd_off(D0, 3, 1)>(vb);
}
DI void pv_mma(f32x16& od, const VFrag& f, bf16x8 pa0, bf16x8 pa1, bf16x8 pa2, bf16x8 pa3) {
#define PKV(L, H) (bf16x8){L[0], L[1], L[2], L[3], H[0], H[1], H[2], H[3]}
    od = __builtin_amdgcn_mfma_f32_32x32x16_bf16(pa0, PKV(f.l0, f.h0), od, 0, 0, 0);
    od = __builtin_amdgcn_mfma_f32_32x32x16_bf16(pa1, PKV(f.l1, f.h1), od, 0, 0, 0);
    od = __builtin_amdgcn_mfma_f32_32x32x16_bf16(pa2, PKV(f.l2, f.h2), od, 0, 0, 0);
    od = __builtin_amdgcn_mfma_f32_32x32x16_bf16(pa3, PKV(f.l3, f.h3), od, 0, 0, 0);
#undef PKV
}
DI void pv_all(f32x16* o, int vb, bf16x8 pa0, bf16x8 pa1, bf16x8 pa2, bf16x8 pa3) {
    VFrag fa, fb;
    v_read<0>(fa, vb);
    v_read<1>(fb, vb); asm volatile("s_waitcnt lgkmcnt(8)" ::: "memory"); SBAR(); pv_mma(o[0], fa, pa0, pa1, pa2, pa3); SBAR();
    v_read<2>(fa, vb); asm volatile("s_waitcnt lgkmcnt(8)" ::: "memory"); SBAR(); pv_mma(o[1], fb, pa0, pa1, pa2, pa3); SBAR();
    v_read<3>(fb, vb); asm volatile("s_waitcnt lgkmcnt(8)" ::: "memory"); SBAR(); pv_mma(o[2], fa, pa0, pa1, pa2, pa3); SBAR();
    asm volatile("s_waitcnt lgkmcnt(0)" ::: "memory"); SBAR(); pv_mma(o[3], fb, pa0, pa1, pa2, pa3);
}
template <int DPE, int ABL = 0>
DI void attn_unit(LAS unsigned char* lds, const bf16* Qrow, const bf16* Kn, int ldk, const bf16* Kp, const bf16* Vh, int ldv, bf16* Ow, int ldo,
                  int NT, int wnt, bool active, float scale, const float* g_nope, const float* g_pe, const float* ctab, const float* stab, int pos, int tid) {
    const int wid = __builtin_amdgcn_readfirstlane(tid >> 6), lane = tid & 63, r32 = lane & 31, hi = lane >> 5;
    LAS float* li_l = (LAS float*)(lds + WSOFF) + wid * 64; LAS float* al_l = li_l + 32;
    const float C = scale * 1.4426950408889634f;
    constexpr int NQ = 8 + DPE / 16;
    bf16x8 qr[8];
    LAS unsigned char* qpl = lds + QPOFF + wid * 4096 + lane * 16;
    if (active) {
        const bf16* Qw = Qrow + hi * 8;
        if constexpr (DPE == 64) {
            float pe[4][8]; float sp = 0.f;
#pragma unroll
            for (int db = 0; db < 4; ++db) { const u32x4 rw = *(const u32x4*)(Qw + 128 + db * 16); unpack8(rw, pe[db]);
#pragma unroll
                for (int j = 0; j < 8; ++j) sp += pe[db][j] * pe[db][j]; }
            sp += __shfl_xor(sp, 32);
            const float rp = __builtin_amdgcn_rsqf(sp * (1.0f / 64.0f) + EPS);
#pragma unroll
            for (int db = 0; db < 2; ++db) { const int i0 = db * 16 + hi * 8; float o1[8], o2[8];
#pragma unroll
                for (int j = 0; j < 8; ++j) { const float x1 = pe[db][j] * rp * g_pe[i0 + j], x2 = pe[db + 2][j] * rp * g_pe[32 + i0 + j];
                    const float cj = ctab[pos * 32 + i0 + j], sj = stab[pos * 32 + i0 + j]; o1[j] = x1 * cj - x2 * sj; o2[j] = x1 * sj + x2 * cj; }
                const u32x4 w1 = pack8(o1), w2 = pack8(o2); *(LAS u32x4*)(qpl + 1024 * db) = w1; *(LAS u32x4*)(qpl + 1024 * (2 + db)) = w2; }
            asm volatile("" ::: "memory");
        }
        float sq = 0.f; u32x4 raw[8];
#pragma unroll
        for (int d0 = 0; d0 < 8; ++d0) raw[d0] = *(const u32x4*)(Qw + d0 * 16);
#pragma unroll
        for (int d0 = 0; d0 < 8; ++d0) { float f[8]; unpack8(raw[d0], f);
#pragma unroll
            for (int j = 0; j < 8; ++j) sq += f[j] * f[j]; }
        sq += __shfl_xor(sq, 32);
        const float rs = __builtin_amdgcn_rsqf(sq * (1.0f / 128.0f) + EPS);
#pragma unroll
        for (int d0 = 0; d0 < 8; ++d0) { float f[8]; unpack8(raw[d0], f); const int c = d0 * 16 + hi * 8;
            const f32x4 g0 = *(const f32x4*)(g_nope + c), g1 = *(const f32x4*)(g_nope + c + 4);
            f[0] *= rs * g0[0]; f[1] *= rs * g0[1]; f[2] *= rs * g0[2]; f[3] *= rs * g0[3]; f[4] *= rs * g1[0]; f[5] *= rs * g1[1]; f[6] *= rs * g1[2]; f[7] *= rs * g1[3];
            const u32x4 w = pack8(f); qr[d0] = __builtin_bit_cast(bf16x8, w); }
    } else {
#pragma unroll
        for (int d0 = 0; d0 < 8; ++d0) qr[d0] = (bf16x8){0, 0, 0, 0, 0, 0, 0, 0};
    }
    int offK[2], offV[2], offP;
#pragma unroll
    for (int i = 0; i < 2; ++i) { const int ob = i * 8192 + wid * 1024 + lane * 16;
        { const int row = ob >> 8, cb = (ob & 255) ^ ((row & 7) << 4); offK[i] = row * ldk * 2 + cb; }
        { const int sub = ob >> 9, kk = (sub >> 2) * 8 + ((ob & 511) >> 6), k = (kk & ~0xC) | ((kk & 4) << 1) | ((kk & 8) >> 1), cc = (sub & 3) * 32 + ((ob & 63) >> 1); offV[i] = k * ldv * 2 + cc * 2; } }
    { const int ob = wid * 1024 + lane * 16, row = ob >> 7, cb = (ob & 127) ^ ((row & 7) << 4); offP = row * 128 + cb; }
    const int vb0 = (int)(uintptr_t)(lds + SHM_K) + v_rd_base(lane);
    const int sw_ = (r32 & 7) << 4;
    const int ka0 = r32 * 256 + ((0 * 32 + hi * 16) ^ sw_), ka1 = r32 * 256 + ((1 * 32 + hi * 16) ^ sw_), ka2 = r32 * 256 + ((2 * 32 + hi * 16) ^ sw_), ka3 = r32 * 256 + ((3 * 32 + hi * 16) ^ sw_);
    const int pa_0 = r32 * 128 + ((0 * 32 + hi * 16) ^ sw_), pa_1 = r32 * 128 + ((1 * 32 + hi * 16) ^ sw_), pa_2 = r32 * 128 + ((2 * 32 + hi * 16) ^ sw_), pa_3 = r32 * 128 + ((3 * 32 + hi * 16) ^ sw_);
#define STAGE(j_, b_) do { const size_t k0_ = (size_t)(j_) * 64; const char* kb_ = (const char*)Kn + k0_ * ldk * 2; const char* vbp_ = (const char*)Vh + k0_ * ldv * 2; LAS unsigned char* bb_ = lds + (b_) * BUF + wid * 1024; \
        __builtin_amdgcn_global_load_lds((const unsigned*)(kb_ + offK[0]), (LAS unsigned*)(bb_), 16, 0, 0); __builtin_amdgcn_global_load_lds((const unsigned*)(kb_ + offK[1]), (LAS unsigned*)(bb_ + 8192), 16, 0, 0); \
        __builtin_amdgcn_global_load_lds((const unsigned*)(vbp_ + offV[0]), (LAS unsigned*)(bb_ + SHM_K), 16, 0, 0); __builtin_amdgcn_global_load_lds((const unsigned*)(vbp_ + offV[1]), (LAS unsigned*)(bb_ + SHM_K + 8192), 16, 0, 0); \
        if constexpr (DPE == 64) __builtin_amdgcn_global_load_lds((const unsigned*)((const char*)Kp + k0_ * 128 + offP), (LAS unsigned*)(bb_ + SHM_K + SHM_V), 16, 0, 0); } while (0)
    constexpr int NLD = DPE == 64 ? 5 : 4;
#define STAGE_WAIT1() do { if constexpr (NLD == 5) asm volatile("s_waitcnt vmcnt(5)" ::: "memory"); else asm volatile("s_waitcnt vmcnt(4)" ::: "memory"); __builtin_amdgcn_s_barrier(); asm volatile("" ::: "memory"); } while (0)
#define STAGE_WAIT0() do { asm volatile("s_waitcnt vmcnt(0)" ::: "memory"); __builtin_amdgcn_s_barrier(); asm volatile("" ::: "memory"); } while (0)
    if constexpr (ABL != 4) { STAGE(0, 0); if (NT > 1) STAGE(1, 1); } if (NT > 1) STAGE_WAIT1(); else STAGE_WAIT0();
    float m_reg = -1e30f, l_reg = 0.f; f32x16 o[4];
#pragma unroll
    for (int d = 0; d < 4; ++d)
#pragma unroll
        for (int r = 0; r < 16; ++r) o[d][r] = 0.f;
    const float thr_raw = 8.0f / scale;
    int buf = 0;
    for (int j = 0; j < NT; ++j) {
        const int bn2 = buf == 0 ? 2 : buf - 1;
        if constexpr (ABL != 4) { if (j + 2 < NT) STAGE(j + 2, bn2); }
        if (active && j < wnt) {
            const LAS unsigned char* Ks = lds + buf * BUF; const LAS unsigned char* Ps = Ks + SHM_K + SHM_V;
            f32x16 p0, p1;
#pragma unroll
            for (int r = 0; r < 16; ++r) { p0[r] = 0.f; p1[r] = 0.f; }
            if constexpr (ABL != 3) {
            const int kbo = (int)(uintptr_t)Ks;
            bf16x8 fa0, fa1, fb0, fb1;
#define KRD(dst, addr, off) asm volatile("ds_read_b128 %0, %1 offset:%2" : "=&v"(dst) : "v"(addr), "i"(off) : "memory")
#define KRD2(f0, f1, ka_, m_) do { KRD(f0, kbo + ka_, (m_) * 128); KRD(f1, kbo + ka_, (m_) * 128 + 8192); } while (0)
#define KMMA(f0, f1, q_) do { p0 = __builtin_amdgcn_mfma_f32_32x32x16_bf16(f0, q_, p0, 0, 0, 0); p1 = __builtin_amdgcn_mfma_f32_32x32x16_bf16(f1, q_, p1, 0, 0, 0); } while (0)
#define KWAIT(n_) do { asm volatile("s_waitcnt lgkmcnt(" #n_ ")" ::: "memory"); SBAR(); } while (0)
            KRD2(fa0, fa1, ka0, 0); KRD2(fb0, fb1, ka1, 0);
            KWAIT(2); KMMA(fa0, fa1, qr[0]); SBAR(); KRD2(fa0, fa1, ka2, 0);
            KWAIT(2); KMMA(fb0, fb1, qr[1]); SBAR(); KRD2(fb0, fb1, ka3, 0);
            KWAIT(2); KMMA(fa0, fa1, qr[2]); SBAR(); KRD2(fa0, fa1, ka0, 1);
            KWAIT(2); KMMA(fb0, fb1, qr[3]); SBAR(); KRD2(fb0, fb1, ka1, 1);
            KWAIT(2); KMMA(fa0, fa1, qr[4]); SBAR(); KRD2(fa0, fa1, ka2, 1);
            KWAIT(2); KMMA(fb0, fb1, qr[5]); SBAR(); KRD2(fb0, fb1, ka3, 1);
            if constexpr (DPE == 64) {
                const int pbo = (int)(uintptr_t)Ps; const int qpo = (int)(uintptr_t)qpl; bf16x8 qfa, qfb;
#define PRD3(f0, f1, qf, pa_, d_) do { KRD(f0, pbo + pa_, 0); KRD(f1, pbo + pa_, 4096); KRD(qf, qpo, (d_) * 1024); } while (0)
                KWAIT(2); KMMA(fa0, fa1, qr[6]); SBAR(); PRD3(fa0, fa1, qfa, pa_0, 0);
                KWAIT(3); KMMA(fb0, fb1, qr[7]); SBAR(); PRD3(fb0, fb1, qfb, pa_1, 1);
                KWAIT(3); KMMA(fa0, fa1, qfa); SBAR(); PRD3(fa0, fa1, qfa, pa_2, 2);
                KWAIT(3); KMMA(fb0, fb1, qfb); SBAR(); PRD3(fb0, fb1, qfb, pa_3, 3);
                KWAIT(3); KMMA(fa0, fa1, qfa); SBAR();
                KWAIT(0); KMMA(fb0, fb1, qfb);
#undef PRD3
            } else {
                KWAIT(2); KMMA(fa0, fa1, qr[6]); SBAR();
                KWAIT(0); KMMA(fb0, fb1, qr[7]);
            }
#undef KRD
#undef KRD2
#undef KMMA
#undef KWAIT
            } else { asm volatile("" : "+v"(p0), "+v"(p1)); }
            float alpha = 1.f;
            if constexpr (ABL != 1) {
            float pmax = p0[0];
#pragma unroll
            for (int r = 1; r < 16; ++r) pmax = fmaxf(pmax, p0[r]);
#pragma unroll
            for (int r = 0; r < 16; ++r) pmax = fmaxf(pmax, p1[r]);
            { auto rr = __builtin_amdgcn_permlane32_swap(__float_as_uint(pmax), __float_as_uint(pmax), false, false); pmax = fmaxf(__uint_as_float(rr[0]), __uint_as_float(rr[1])); }
            float mn;
            if (__all(pmax - m_reg <= thr_raw)) { mn = m_reg; alpha = 1.f; }
            else { mn = fmaxf(m_reg, pmax); alpha = __builtin_amdgcn_exp2f((m_reg - mn) * C); m_reg = mn; }
            const float mnC = -mn * C;
#pragma unroll
            for (int r = 0; r < 16; ++r) { p0[r] = __builtin_amdgcn_exp2f(fmaf(p0[r], C, mnC)); p1[r] = __builtin_amdgcn_exp2f(fmaf(p1[r], C, mnC)); }
            float ps = 0.f;
#pragma unroll
            for (int r = 0; r < 16; ++r) ps += p0[r] + p1[r];
            { auto rr = __builtin_amdgcn_permlane32_swap(__float_as_uint(ps), __float_as_uint(ps), false, false); ps = __uint_as_float(rr[0]) + __uint_as_float(rr[1]); }
            l_reg = l_reg * alpha + ps;
            }
            bf16x8 pa0, pa1, pa2, pa3;
#define PK4(P, BASE, OUT) do { unsigned a0 = pkbf(P[BASE + 0], P[BASE + 1]), a1 = pkbf(P[BASE + 2], P[BASE + 3]); \
        unsigned b0_ = pkbf(P[BASE + 4], P[BASE + 5]), b1_ = pkbf(P[BASE + 6], P[BASE + 7]); \
        auto r0 = __builtin_amdgcn_permlane32_swap(a0, b0_, false, false); auto r1 = __builtin_amdgcn_permlane32_swap(a1, b1_, false, false); \
        u32x4 w_ = {r0[0], r1[0], r0[1], r1[1]}; OUT = __builtin_bit_cast(bf16x8, w_); } while (0)
            PK4(p0, 0, pa0); PK4(p0, 8, pa1); PK4(p1, 0, pa2); PK4(p1, 8, pa3);
#undef PK4
            if (__any(alpha < 1.f)) { if (hi == 0) al_l[r32] = alpha; asm volatile("s_waitcnt lgkmcnt(0)" ::: "memory");
#pragma unroll
                for (int r = 0; r < 16; ++r) { const float a = al_l[crow(r, hi)];
#pragma unroll
                    for (int d = 0; d < 4; ++d) o[d][r] *= a; } }
            const int vb = vb0 + buf * BUF;
            if constexpr (ABL != 2) pv_all(o, vb, pa0, pa1, pa2, pa3); else asm volatile("" :: "v"(pa0), "v"(pa1), "v"(pa2), "v"(pa3), "v"(vb));
        }
        asm volatile("s_waitcnt lgkmcnt(0)" ::: "memory");
        if (j + 2 < NT) STAGE_WAIT1(); else STAGE_WAIT0();
        buf = buf == 2 ? 0 : buf + 1;
    }
#undef STAGE
#undef STAGE_WAIT0
#undef STAGE_WAIT1
    if (active) {
        if (hi == 0) li_l[r32] = l_reg;
        asm volatile("s_waitcnt lgkmcnt(0)" ::: "memory");
        int le = lane; asm volatile("" : "+v"(le));
        const int r32e = le & 31, hie = le >> 5;
        bf16* Owl = Ow + r32e;
#pragma unroll
        for (int r = 0; r < 16; ++r) { const int orow = crow(r, hie); const float rl = __builtin_amdgcn_rcpf(li_l[orow]); bf16* orp = Owl + (size_t)orow * ldo;
#pragma unroll
            for (int d0 = 0; d0 < 4; ++d0) orp[d0 * 32] = f2bf(o[d0][r] * rl); }
    }
    __syncthreads();
}
}

namespace ssd {
constexpr int RSC = 272, RSX = 144;
constexpr int CS = 0, BS = CS + 64 * RSC, XD = BS + 64 * RSC, XW = XD + 64 * RSX, TSET = XW + 64 * RSX, LS = 2 * TSET, HS = LS + 64 * RSX, HSET = 64 * RSC, END = HS + 2 * HSET;
typedef short v4i16_t __attribute__((ext_vector_type(4)));
DI s16x4 vtr(const LAS unsigned char* p) { return __builtin_bit_cast(s16x4, __builtin_amdgcn_ds_read_tr16_b64_v4i16((LAS v4i16_t*)p)); }
DI bf16x8 tr_frag(const LAS unsigned char* tile, int rsb, int jb, int col0, int lane) {
    const int g = lane >> 4, q = (lane & 15) >> 2, pp = lane & 3;
    const LAS unsigned char* a = tile + (jb + 8 * g + q) * rsb + (col0 + 4 * pp) * 2;
    const s16x4 lo = vtr(a), hi = vtr(a + 4 * rsb);
    return (bf16x8){lo[0], lo[1], lo[2], lo[3], hi[0], hi[1], hi[2], hi[3]};
}
DI bf16x8 row_frag(const LAS unsigned char* tile, int rsb, int row, int k0, int lane) {
    return *(const LAS bf16x8*)(tile + row * rsb + (k0 + 8 * (lane >> 4)) * 2);
}
DI float wave_iscan(float v) {
#define SSD_DPP_ADD(ctrl_, rmask_) v += __builtin_bit_cast(float, __builtin_amdgcn_update_dpp(0, __builtin_bit_cast(int, v), (ctrl_), (rmask_), 0xf, false))
    SSD_DPP_ADD(0x111, 0xf); SSD_DPP_ADD(0x112, 0xf); SSD_DPP_ADD(0x114, 0xf); SSD_DPP_ADD(0x118, 0xf);
    SSD_DPP_ADD(0x142, 0xa);
    SSD_DPP_ADD(0x143, 0xc);
#undef SSD_DPP_ADD
    return v;
}
#define MFMA16(a, b, c) __builtin_amdgcn_mfma_f32_16x16x32_bf16((a), (b), (c), 0, 0, 0)

DI void ssd_unit(LAS unsigned char* lds, const bf16* XBC, const float* DT, const bf16* PROJ, bf16* YG, int rb, int NC, int h, float A, float Dsk, const float* h0, float* hout, int tid) {
    const int wid = tid >> 6, lane = tid & 63, l15 = lane & 15, quad = lane >> 4;
    const int g = h >> 2;
    const int pbk = wid & 3, nb0 = 4 * (wid >> 2);
    f32x4 hacc[4];
#pragma unroll
    for (int t = 0; t < 4; ++t) {
        hacc[t] = h0 ? *(const f32x4*)(h0 + (16 * pbk + l15) * 128 + 16 * (nb0 + t) + 4 * quad) : (f32x4){0.f, 0.f, 0.f, 0.f};
        u32x2 w; w.x = pkbf(hacc[t][0], hacc[t][1]); w.y = pkbf(hacc[t][2], hacc[t][3]);
        *(LAS u32x2*)(lds + HS + (16 * pbk + l15) * RSC + (16 * (nb0 + t) + 4 * quad) * 2) = w;
    }
    const int srow = tid >> 3, sc16 = (tid & 7) * 16, sc8 = (tid & 7) * 8;
    u32x4 rC0, rC1, rB0, rB1, rX; float rdt;
#define SSD_LOAD(c_) do { const size_t row_ = (size_t)rb + (size_t)(c_) * 64 + srow; const bf16* xr_ = XBC + row_ * 4096; \
        rX = *(const u32x4*)(xr_ + h * 64 + sc8); rB0 = *(const u32x4*)(xr_ + 2048 + g * 128 + sc16); rB1 = *(const u32x4*)(xr_ + 2048 + g * 128 + sc16 + 8); \
        rC0 = *(const u32x4*)(xr_ + 3072 + g * 128 + sc16); rC1 = *(const u32x4*)(xr_ + 3072 + g * 128 + sc16 + 8); \
        rdt = DT[((size_t)rb + (size_t)(c_) * 64 + lane) * 32 + h]; } while (0)
#define SSD_STAGE(ts_, acn_, atn_) do { acn_ = rdt * A; \
        acn_ = wave_iscan(acn_); \
        atn_ = __builtin_bit_cast(float, __builtin_amdgcn_readlane(__builtin_bit_cast(int, acn_), 63)); const float dtj_ = __shfl(rdt, srow), acj_ = __shfl(acn_, srow), wj_ = __expf(atn_ - acj_); \
        LAS unsigned char* tb_ = lds + (ts_) * TSET; \
        *(LAS u32x4*)(tb_ + CS + srow * RSC + sc16 * 2) = rC0; *(LAS u32x4*)(tb_ + CS + srow * RSC + sc16 * 2 + 16) = rC1; \
        *(LAS u32x4*)(tb_ + BS + srow * RSC + sc16 * 2) = rB0; *(LAS u32x4*)(tb_ + BS + srow * RSC + sc16 * 2 + 16) = rB1; \
        { float f_[8], fw_[8]; unpack8(rX, f_); _Pragma("unroll") for (int j_ = 0; j_ < 8; ++j_) { f_[j_] *= dtj_; fw_[j_] = f_[j_] * wj_; } \
          *(LAS u32x4*)(tb_ + XD + srow * RSX + sc8 * 2) = pack8(f_); *(LAS u32x4*)(tb_ + XW + srow * RSX + sc8 * 2) = pack8(fw_); } } while (0)
    float ac, atot;
    SSD_LOAD(0);
    SSD_STAGE(0, ac, atot);
    if (NC > 1) SSD_LOAD(1);
    __syncthreads();
    const int ib = wid >> 1;
    u32x2 ngx[2], ngz[2];
#define SSD_GLOAD(c_) do { const size_t gr_ = (size_t)rb + (size_t)(c_) * 64 + 16 * ib + l15; _Pragma("unroll") for (int pt = 0; pt < 2; ++pt) { const int p0 = 16 * (2 * (wid & 1) + pt) + 4 * quad; \
        ngx[pt] = *(const u32x2*)(XBC + gr_ * 4096 + h * 64 + p0); ngz[pt] = *(const u32x2*)(PROJ + gr_ * NIN + PC_Z + h * 64 + p0); } } while (0)
    SSD_GLOAD(0);
    for (int c = 0; c < NC; ++c) {
        const int row0 = rb + c * 64, ts = c & 1;
        const LAS unsigned char* T = lds + ts * TSET;
        const LAS unsigned char* Hc = lds + HS + ts * HSET; LAS unsigned char* Hn = lds + HS + (ts ^ 1) * HSET;
        const int i = 16 * ib + l15; const float ac_i = __shfl(ac, i);
        u32x2 gx[2], gz[2];
#pragma unroll
        for (int pt = 0; pt < 2; ++pt) { gx[pt] = ngx[pt]; gz[pt] = ngz[pt]; }
        if (c + 1 < NC) SSD_GLOAD(c + 1);
        bf16x8 cf[4];
#pragma unroll
        for (int s = 0; s < 4; ++s) cf[s] = row_frag(T + CS, RSC, 16 * ib + l15, 32 * s, lane);
#pragma unroll
        for (int jt = 0; jt < 2; ++jt) {
            const int jb = 2 * (wid & 1) + jt; u32x2 w = {0u, 0u};
            if (jb <= ib) {
                f32x4 acc = {0.f, 0.f, 0.f, 0.f};
#pragma unroll
                for (int s = 0; s < 4; ++s) acc = MFMA16(row_frag(T + BS, RSC, 16 * jb + l15, 32 * s, lane), cf[s], acc);
                float v[4];
#pragma unroll
                for (int r = 0; r < 4; ++r) { const int j = 16 * jb + 4 * quad + r; const float ac_j = __shfl(ac, j); v[r] = (j <= i) ? acc[r] * __expf(ac_i - ac_j) : 0.f; }
                w.x = pkbf(v[0], v[1]); w.y = pkbf(v[2], v[3]);
            }
            *(LAS u32x2*)(lds + LS + i * RSX + (16 * jb + 4 * quad) * 2) = w;
        }
        float acn = 0.f, atn = 0.f;
        if (c + 1 < NC) { SSD_STAGE(ts ^ 1, acn, atn); if (c + 2 < NC) SSD_LOAD(c + 2); }
        __syncthreads();
        const float ei = __expf(ac_i);
        bf16x8 lf[2];
#pragma unroll
        for (int s = 0; s < 2; ++s) if (32 * s <= 16 * ib + 15) lf[s] = row_frag(lds + LS, RSX, 16 * ib + l15, 32 * s, lane);
#pragma unroll
        for (int pt = 0; pt < 2; ++pt) {
            const int pb = 2 * (wid & 1) + pt; f32x4 y = {0.f, 0.f, 0.f, 0.f};
#pragma unroll
            for (int s = 0; s < 4; ++s) y = MFMA16(row_frag(Hc, RSC, 16 * pb + l15, 32 * s, lane), cf[s], y);
            y *= ei;
#pragma unroll
            for (int s = 0; s < 2; ++s) if (32 * s <= 16 * ib + 15) y = MFMA16(tr_frag(T + XD, RSX, 32 * s, 16 * pb, lane), lf[s], y);
            const float x0 = bf_lo(gx[pt].x), x1 = bf_hi(gx[pt].x), x2 = bf_lo(gx[pt].y), x3 = bf_hi(gx[pt].y);
            const float z0 = bf_lo(gz[pt].x), z1 = bf_hi(gz[pt].x), z2 = bf_lo(gz[pt].y), z3 = bf_hi(gz[pt].y);
            u32x2 w; w.x = pkbf((y[0] + Dsk * x0) * silu_f(z0), (y[1] + Dsk * x1) * silu_f(z1)); w.y = pkbf((y[2] + Dsk * x2) * silu_f(z2), (y[3] + Dsk * x3) * silu_f(z3));
            *(u32x2*)(YG + (size_t)(row0 + i) * 2048 + h * 64 + 16 * pb + 4 * quad) = w;
        }
        const float et = __expf(atot);
#pragma unroll
        for (int t = 0; t < 4; ++t) hacc[t] *= et;
#pragma unroll
        for (int s = 0; s < 2; ++s) {
            const bf16x8 xf = tr_frag(T + XW, RSX, 32 * s, 16 * pbk, lane);
#pragma unroll
            for (int t = 0; t < 4; ++t) hacc[t] = MFMA16(tr_frag(T + BS, RSC, 32 * s, 16 * (nb0 + t), lane), xf, hacc[t]);
        }
#pragma unroll
        for (int t = 0; t < 4; ++t) { u32x2 w; w.x = pkbf(hacc[t][0], hacc[t][1]); w.y = pkbf(hacc[t][2], hacc[t][3]);
            *(LAS u32x2*)(Hn + (16 * pbk + l15) * RSC + (16 * (nb0 + t) + 4 * quad) * 2) = w; }
        ac = acn; atot = atn;
        __syncthreads();
    }
#undef SSD_LOAD
#undef SSD_STAGE
#undef SSD_GLOAD
#pragma unroll
    for (int t = 0; t < 4; ++t) *(f32x4*)(hout + (16 * pbk + l15) * 128 + 16 * (nb0 + t) + 4 * quad) = hacc[t];
}
}

#ifndef PHMASK
#define PHMASK 0xFFFFFFF
#endif
#define PHON(k) (((PHMASK) >> (k)) & 1)
#ifndef PHREP
#define PHREP 0
#endif
#ifndef PG8_SP2V
#define PG8_SP2V true
#endif
#define NREP(k) (1 + (((PHREP) >> (k)) & 1))
__global__ void __launch_bounds__(512, 2) mk_fwd(Args args) {
    {
        LAS unsigned char* lds0 = (LAS unsigned char*)lds_raw;
        for (int u = threadIdx.x; u < (LDS_BYTES - RING_BYTES) / 4; u += 512) ((LAS unsigned*)(lds0 + RING_BYTES))[u] = 0u;
        __syncthreads();
    }
    const int lo = args.ph_lo, hi = args.ph_hi;
    const bool multi = (hi - lo) > 1;
    unsigned* const barw = (unsigned*)(args.ws + WS_CTL) + CW_BAR;
    XcdBarrier bar; bar.bar = barw; bar.x = 0; bar.st = nullptr;
    if (multi) bar = xcd_barrier_post(barw, (volatile LAS unsigned*)((LAS unsigned char*)lds_raw + MISC_OFF) + 8);
#define IN(k) (lo <= (k) && (k) < hi)
#define SEAM(k) do { if (IN(k) && IN((k) + 1)) xcd_barrier(bar); } while (0)
#define RUN_GEMM(EpiT, Ap, Bp, M_, N_, K_, cid, ...) do { pg8::Gemm g_{(const pg8::bf16_t*)(Ap), (const pg8::bf16_t*)(Bp), M_, N_, K_}; pg8::SplitOrder S_; S_.init(M_, N_, K_, F.G, (cid), EpiT::SPLITK && (K_) >= 8192);     \
        const EpiT E_{__VA_ARGS__}; pg8::gemm_phase<EpiT, pg8::SplitOrder, true, PG8_SP2V>(F.lds, g_, S_, E_); } while (0)
#define SPCNT(k_) ((unsigned*)F.ctl + CW_SPLIT + (l * NPH + (k_)) * 256)
#define SSP(i_) ((float*)F.ctl + CW_SS + (size_t)(i_) * R)

    if (PHON(13) && IN(0)) { const Ctx F = make_ctx(); p_prologue(F); }
    for (int l = 0; l < NLAYER; ++l) {
        const int pb = 1 + NPH * l;
        const bool cv_skip = l > 0 && l + 1 == NLAYER && gridDim.x == 256;
        if (PHON(0) && IN(pb + 0) && !cv_skip) for (int rep_ = 0; rep_ < NREP(0); ++rep_) { if (rep_) xcd_barrier(bar); const Ctx F = make_ctx(); p_convw(F, l); }
        if (!cv_skip) SEAM(pb + 0);
        if (PHON(1) && IN(pb + 1)) for (int rep_ = 0; rep_ < NREP(1); ++rep_) { if (rep_) xcd_barrier(bar);
            { const Ctx F = make_ctx(); unsigned char* ws = F.ws; RUN_GEMM(pg8::EpiScaleBf16, ws + A_XB, ws + W_IN, R, NIN, 4096, F.bid, (pg8::bf16_t*)(ws + A_PROJ), NIN, SSP(3 * l)); }
        }
        SEAM(pb + 1);
        if (PHON(2) && IN(pb + 2)) for (int rep_ = 0; rep_ < NREP(2); ++rep_) { if (rep_) xcd_barrier(bar); const Ctx F = make_ctx(); p_post1(F, l); }
        SEAM(pb + 2);
        if (PHON(3) && IN(pb + 3)) for (int rep_ = 0; rep_ < NREP(3); ++rep_) { if (rep_) xcd_barrier(bar);
            { const Ctx F = make_ctx(); unsigned char* ws = F.ws; RUN_GEMM(pg8::EpiScaleBf16, ws + A_CQN, ws + W_UQ, R, 3072, 1024, F.G - 1 - F.bid, (pg8::bf16_t*)(ws + A_Q), 3072, nullptr); }
            { const Ctx F = make_ctx(); unsigned char* ws = F.ws; RUN_GEMM(pg8::EpiKVNorm, ws + A_CKV, ws + W_UKV, KVROWS, 4096, 512, F.bid, (pg8::bf16_t*)(ws + A_KV), F.in[I_KNN] + l * 128, KVROWS); }
        }
        SEAM(pb + 3);
        if (PHON(5) && IN(pb + 5)) for (int rep_ = 0; rep_ < NREP(5); ++rep_) { if (rep_) xcd_barrier(bar); const int F0g = gridDim.x;
#ifndef NO_SSD
            for (int r2_ = 0; r2_ < NREP(14); ++r2_) {   const Ctx F = make_ctx(); unsigned char* ws = F.ws;
                const bf16* XBC = (const bf16*)(ws + A_XBC); const float* DT = (const float*)(ws + A_DT); const bf16* PROJ = (const bf16*)(ws + A_PROJ); bf16* YG = (bf16*)(ws + A_YG);
                for (int it = F.bid; it < 512; it += F.G) {
                    const int k = it >> 8, u = it & 255, b = u >> 5, h = u & 31;
                    const float A = -__expf(F.in[I_ALOG][l * 32 + h]), Dsk = F.in[I_DSKIP][l * 32 + h];
                    const size_t so = ((size_t)(l * 8 + b) * 32 + h) * 8192;
                    ssd::ssd_unit(F.lds, XBC, DT, PROJ, YG, k ? RP + b * DSEQ : b * SEQ, k ? 1 : SEQ / 64, h, A, Dsk, k ? F.in[I_SSSM] + so : nullptr, F.out + (k ? O_SSM_S : O_SSM_P) + so, F.tid);
                }
            }
#endif
#ifndef NO_ATT
            for (int r2_ = 0; r2_ < NREP(15); ++r2_) {   const Ctx F = make_ctx(); unsigned char* ws = F.ws;
                const bf16* Q = (const bf16*)(ws + A_Q); const bf16* KV = (const bf16*)(ws + A_KV); const bf16* KPE = (const bf16*)(ws + A_KPE); bf16* MIX = (bf16*)(ws + A_MIX);
                const float* ctab = (const float*)(ws + WS_ROPE); const float* stab = ctab + KVS * 32;
                const float* qnn = F.in[I_QNN] + l * 128; const float* qnp = F.in[I_QNP] + l * 64;
                const float scale = 0.07216878364870322f;
                const int wid = F.wave, r32 = F.lane & 31;
                for (int it = F.bid; it < 1280; it += F.G) {
                    const int slot = it >> 8, w = it & 255, xcd = w & 7, r = w >> 3, g = r >> 2, k = r & 3;
                    const bool smp = slot == 4;
                    if (smp && k >= 2) continue;
                    const int bh = (xcd * 8 + g) * 2 + (smp ? k : (slot >> 1));
                    const int qb = (slot & 1) ? k : 7 - k;
                    const int b = bh >> 4, h = bh & 15;
                    const bool act = smp ? wid < 2 : true; const int wo = act ? wid * 32 : 0;
                    const int row0 = smp ? RP + b * DSEQ : b * SEQ + qb * 256; const size_t kr0 = smp ? (size_t)RP + (size_t)b * KVS : (size_t)b * SEQ;
                    const int NT = smp ? KVS / 64 : 4 * qb + 4, wnt = smp ? KVS / 64 : 4 * qb + (wid >> 1) + 1, pos = (smp ? PAST : qb * 256) + wid * 32 + r32;
#if defined(PROBE_ATT_ABL)
                    if (r2_) att::attn_unit<64, PROBE_ATT_ABL>(F.lds, Q + (size_t)(row0 + wo + (act ? r32 : 0)) * 3072 + h * 192, KV + ((size_t)h * KVROWS + kr0) * 256, 256, KPE + kr0 * 64,
                                       KV + ((size_t)h * KVROWS + kr0) * 256 + 128, 256, (bf16*)(ws + A_CQN) + (size_t)wo * 128, 128, NT, wnt, act, scale, qnn, qnp, ctab, stab, pos, F.tid); else
#endif
                    att::attn_unit<64>(F.lds, Q + (size_t)(row0 + wo + (act ? r32 : 0)) * 3072 + h * 192, KV + ((size_t)h * KVROWS + kr0) * 256, 256, KPE + kr0 * 64,
                                       KV + ((size_t)h * KVROWS + kr0) * 256 + 128, 256, MIX + (size_t)(row0 + wo) * 4096 + h * 128, 4096, NT, wnt, act, scale, qnn, qnp, ctab, stab, pos, F.tid);
                }
            }
#endif
            if (rep_ == 0 && F0g == 256 && ((blockIdx.x >> 3) & 3) >= 2) { __syncthreads();     const Ctx F3 = make_ctx(); const int rk = ((F3.bid >> 5) << 4) | ((((F3.bid >> 3) & 3) - 2) << 3) | (F3.bid & 7);
                p_convw_range(F3, l, CV_A0, CV_E3 - CV_A0, l, 0, 0, 0, 128, 8, rk); }
        }
        SEAM(pb + 5);
        if (PHON(6) && IN(pb + 6)) for (int rep_ = 0; rep_ < NREP(6); ++rep_) { if (rep_) xcd_barrier(bar); const Ctx F = make_ctx(); p_gnorm(F, l); }
        SEAM(pb + 6);
        if (PHON(7) && IN(pb + 7)) for (int rep_ = 0; rep_ < NREP(7); ++rep_) { if (rep_) xcd_barrier(bar); const Ctx F = make_ctx(); unsigned char* ws = F.ws;
#if defined(PROBE_NULLEPI)
            if (rep_) RUN_GEMM(pg8::EpiNull, ws + A_MIX, ws + W_O, R, 4096, 4096, F.bid); else
#endif
            RUN_GEMM(pg8::EpiResid, ws + A_MIX, ws + W_O, R, 4096, 4096, F.bid, (float*)nullptr, (pg8::bf16_t*)(ws + A_XB), SSP(3 * l + 1), SPCNT(7), ws + A_KV);
            if (F.G == 256 && F.bid >= 32) { const Ctx F3 = make_ctx(); p_convw_range(F3, l, CV_GU0, CV_GU1 - CV_GU0, l, 0, 0, 32, 224, CV_TAILW); } }
        SEAM(pb + 7);
        if (PHON(8) && IN(pb + 8)) for (int rep_ = 0; rep_ < NREP(8); ++rep_) { if (rep_) xcd_barrier(bar); const Ctx F = make_ctx(); unsigned char* ws = F.ws; RUN_GEMM(pg8::EpiScaleBf16, ws + A_XB, ws + W_XQ, R, 512, 4096, F.bid, (pg8::bf16_t*)(ws + A_XQ), 512, SSP(3 * l + 1));
            { const Ctx F2 = make_ctx(); unsigned char* ws2 = F2.ws; pg8::Gemm g2{(const pg8::bf16_t*)(ws2 + A_MB), (const pg8::bf16_t*)(ws2 + W_XKV), 2048, 1024, 4096}; pg8::SplitOrder S2; S2.init(2048, 1024, 4096, F2.G, (F2.bid + F2.G - 132) % F2.G, false);
              const pg8::EpiMemKV E2{(const float*)F2.ctl + CW_SSM, F2.in[I_XNK] + l * 128, F2.out + O_MK_P + (size_t)l * 2048 * 512, F2.out + O_MV_P + (size_t)l * 2048 * 512, (pg8::bf16_t*)(ws2 + A_MEMK), (pg8::bf16_t*)(ws2 + A_MEMV)};
              pg8::gemm_phase<pg8::EpiMemKV, pg8::SplitOrder, true, true>(F2.lds, g2, S2, E2); }
            if (F.G == 256 && F.bid >= 164) { const Ctx F3 = make_ctx(); p_convw_range(F3, l, CV_GU1, CV_GU3 - CV_GU1, l, 0, 0, 164, 92, CV_TAILW); } }
        SEAM(pb + 8);
        if (PHON(9) && IN(pb + 9)) for (int rep_ = 0; rep_ < NREP(9); ++rep_) { if (rep_) xcd_barrier(bar);
            const Ctx F = make_ctx(); unsigned char* ws = F.ws;
            const bf16* XQ = (const bf16*)(ws + A_XQ); const bf16* MEMK = (const bf16*)(ws + A_MEMK); const bf16* MEMV = (const bf16*)(ws + A_MEMV); bf16* XO = (bf16*)(ws + A_XO);
            const float* xnq = F.in[I_XNQ] + l * 128; const float scale = 0.08838834764831845f;
            const int wid = F.wave, r32 = F.lane & 31;
            for (int it = F.bid; it < 512; it += F.G) {
                if (it >= 288) continue;
                const bool smp = it >= 256; const int u = it & 255;
                const int b = smp ? u >> 2 : u >> 5, h = smp ? u & 3 : (u >> 3) & 3, qb = u & 7;
                const bool act = smp ? wid < 2 : true; const int wo = act ? wid * 32 : 0;
                const int row0 = smp ? RP + b * DSEQ : b * SEQ + qb * 256; const size_t mr0 = (size_t)(smp ? 2048 : 0) + (size_t)b * NMEM;
                att::attn_unit<0>(F.lds, XQ + (size_t)(row0 + wo + (act ? r32 : 0)) * 512 + h * 128, MEMK + mr0 * 512 + h * 128, 512, nullptr,
                                  MEMV + mr0 * 512 + h * 128, 512, XO + (size_t)(row0 + wo) * 512 + h * 128, 512, 4, 4, act, scale, xnq, nullptr, nullptr, nullptr, 0, F.tid);
            }
        }
        SEAM(pb + 9);
        if (PHON(10) && IN(pb + 10)) for (int rep_ = 0; rep_ < NREP(10); ++rep_) { if (rep_) xcd_barrier(bar); const Ctx F = make_ctx(); unsigned char* ws = F.ws; RUN_GEMM(pg8::EpiResid, ws + A_XO, ws + W_XO, R, 4096, 512, F.bid, (float*)nullptr, (pg8::bf16_t*)(ws + A_XB), SSP(3 * l + 2), SPCNT(10), ws + A_KV);
            if (F.G == 256 && F.bid >= 32) { const Ctx F3 = make_ctx(); p_convw_range(F3, l, CV_GU3, CV_DX, l, 0, 0, 32, 224, CV_TAILW); } }
        SEAM(pb + 10);
        if (PHON(11) && IN(pb + 11)) for (int rep_ = 0; rep_ < NREP(11); ++rep_) { if (rep_) xcd_barrier(bar); const Ctx F = make_ctx(); unsigned char* ws = F.ws;
#if defined(PROBE_NULLEPI)
            if (rep_) RUN_GEMM(pg8::EpiNull, ws + A_XB, ws + ((l & 1) ? A_WGU2 : W_GU), R, 22016, 4096, F.bid); else
#endif
            RUN_GEMM(pg8::EpiGU, ws + A_XB, ws + ((l & 1) ? A_WGU2 : W_GU), R, 22016, 4096, F.bid, (pg8::bf16_t*)(ws + A_H), SSP(3 * l + 2), SPCNT(11), ws + A_KV);
            if (F.G == 256 && F.bid >= 44) { const Ctx F3 = make_ctx(); const bool more = l + 1 < NLAYER; p_convw_range(F3, l + 1, 0, more ? CV_A0 : 0, l, CV_GU3 + CV_DX, more ? CV_DG : CV_NITEMS - CV_GU3 - CV_DX, 44, 212, CV_TAILW); } }
        SEAM(pb + 11);
        if (PHON(12) && IN(pb + 12)) for (int rep_ = 0; rep_ < NREP(12); ++rep_) { if (rep_) xcd_barrier(bar); const Ctx F = make_ctx(); unsigned char* ws = F.ws; const bool more = l + 1 < NLAYER;
#if defined(PROBE_NULLEPI)
            if (rep_) RUN_GEMM(pg8::EpiNull, ws + A_H, ws + W_DN, R, 4096, DFF, F.bid); else
#endif
            RUN_GEMM(pg8::EpiResid, ws + A_H, ws + W_DN, R, 4096, DFF, F.bid, more ? (float*)nullptr : F.out + O_Y, (pg8::bf16_t*)(ws + A_XB), SSP(3 * l + 3), SPCNT(12), ws + A_KV); }
        SEAM(pb + 12);
    }
#undef IN
#undef SEAM
#undef RUN_GEMM
#undef SSP
#undef SPCNT
}

#ifndef MK_SPLIT
#define MK_SPLIT 0
#endif
extern "C" void kernel_launch(void* const* d_in, const int* in_sizes, int n_in, void* d_out, int out_size, void* d_ws, size_t ws_size, hipStream_t stream) {
    static int grid = 0;
    if (grid == 0) {
        if (n_in != 38 || out_size < (int)O_END || ws_size < WS_NEED) { fprintf(stderr, "kernel_launch: n_in %d out %d ws %zu (need 38, %zu, >= %zu): nothing launched\n", n_in, out_size, ws_size, (size_t)O_END, (size_t)WS_NEED); grid = -1; return; }
        int dev = 0, cus = 0, per_cu = 0;
        if (hipGetDevice(&dev) != hipSuccess || hipDeviceGetAttribute(&cus, hipDeviceAttributeMultiprocessorCount, dev) != hipSuccess) { grid = -1; return; }
        if (hipFuncSetAttribute((const void*)mk_fwd, hipFuncAttributeMaxDynamicSharedMemorySize, LDS_BYTES) != hipSuccess) { fprintf(stderr, "kernel_launch: hipFuncSetAttribute failed\n"); grid = -1; return; }
        if (hipOccupancyMaxActiveBlocksPerMultiprocessor(&per_cu, (const void*)mk_fwd, 512, LDS_BYTES) != hipSuccess || per_cu < 1) fprintf(stderr, "kernel_launch: occupancy query says %d\n", per_cu);
        (void)hipGetLastError();
        grid = cus;
    }
    if (grid < 0) return;
    if (hipMemsetAsync((char*)d_ws + WS_CTL, 0, CTL_ZERO_BYTES, stream) != hipSuccess) return;
    Args a{};
    for (int i = 0; i < 38; ++i) a.in[i] = (const float*)d_in[i];
    a.out = (float*)d_out; a.ws = (unsigned char*)d_ws;
    constexpr int NPHASE = 1 + NLAYER * NPH;
#if MK_SPLIT
    for (int p = 0; p < NPHASE; ++p) { a.ph_lo = p; a.ph_hi = p + 1; hipLaunchKernelGGL(mk_fwd, dim3(grid), dim3(512), LDS_BYTES, stream, a); }
#else
    a.ph_lo = 0; a.ph_hi = NPHASE; hipLaunchKernelGGL(mk_fwd, dim3(grid), dim3(512), LDS_BYTES, stream, a);
#endif
    const hipError_t le = hipPeekAtLastError();
    if (le != hipSuccess) fprintf(stderr, "kernel_launch: launch failed: %s\n", hipGetErrorName(le));
}
```

```cpp
#include <hip/hip_runtime.h>
#include <cstdio>
#include <cstdint>

#define LAS __attribute__((address_space(3)))
#define GAS __attribute__((address_space(1)))
#define DI __device__ __forceinline__

namespace pg8 {
#define PG8_LAS __attribute__((address_space(3)))
typedef unsigned short bf16_t;
typedef short bf16x8 __attribute__((ext_vector_type(8)));
typedef float f32x4 __attribute__((ext_vector_type(4)));
typedef unsigned u32x4 __attribute__((ext_vector_type(4)));
constexpr int BM = 256, BK = 64, HALF = 128, HTB = HALF * BK * 2  , STAGE_BYTES = 8 * HTB, NXCD = 8, WGM = 8;

__host__ __device__ __forceinline__ int lds_byte(int r, int c) { const int st = (r >> 4) * 2 + (c >> 5), rr = r & 15, cc = c & 31, ob = rr * 64 + cc * 2; return st * 1024 + (ob ^ (((ob >> 9) & 1) << 5)); }
__host__ __device__ __forceinline__ void stage_rc(int b, int& R, int& C) { const int st = b / 1024, sb = b % 1024, swz = sb ^ (((sb >> 9) & 1) << 5); R = (st >> 1) * 16 + swz / 64; C = (st & 1) * 32 + (swz % 64) / 2; }
__host__ __device__ __forceinline__ int perm32(int rho) { const int n = rho >> 4, i = rho & 15; return 8 * (i >> 2) + 4 * n + (i & 3); }

struct Unit { int pm, pn, kt0, nt, split, np, part; };
struct Gemm { const bf16_t* A; const bf16_t* Bt; int M, N, K; };

struct StaticOrder {
    int nM, nN, nwg, G, c;
    __host__ __device__ void init(int M, int N, int G_, int c_) { nM = M / BM; nN = N / BM; nwg = nM * nN; G = G_; c = c_; }
    __host__ __device__ bool next(int i, Unit& u) const {
        const long L = (long)i * G + c; if (L >= nwg) return false;
        int wgid = (int)L; { const int q = nwg / NXCD, r = nwg % NXCD, xcd = wgid % NXCD, off = wgid / NXCD; wgid = (xcd < r ? xcd * (q + 1) : r * (q + 1) + (xcd - r) * q) + off; }
        const int nig = WGM * nN, gid = wgid / nig, fm = gid * WGM, gsz = (nM - fm) < WGM ? (nM - fm) : WGM;
        u.pm = fm + ((wgid % nig) % gsz); u.pn = (wgid % nig) / gsz; u.kt0 = 0; u.nt = 0; u.split = -1; u.np = 1; u.part = 0; return true;
    }
    __device__ __forceinline__ void a_ready(const Unit&) const {}
    __device__ __forceinline__ void done(const Unit&) const {}
};

__device__ __forceinline__ unsigned cvt_pk_bf16(float lo, float hi) { unsigned r; asm volatile("v_cvt_pk_bf16_f32 %0, %1, %2" : "=v"(r) : "v"(lo), "v"(hi)); return r; }

struct SplitOrder {
    int nM, nN, nwg, G, c, F, Rm, P, ntot, nbase, nextra;
    __device__ __forceinline__ void init(int M, int N, int K, int G_, int c_, bool allow_split) {
        nM = M / BM; nN = N / BM; nwg = nM * nN; G = G_; c = c_; ntot = K / BK; F = nwg / G; Rm = nwg - F * G; P = 1;
        if (allow_split && Rm > 0 && F > 0 && Rm <= 128) {     int p = G / Rm; if (p > 8) p = 8; const int pk = ntot / 4; if (p > pk) p = pk; if (p >= 2) P = p; }
        nbase = (ntot / P) & ~1; nextra = (ntot - nbase * P) / 2;
    }
    __device__ __forceinline__ void map(int L, Unit& u) const {
        int wgid = L; { const int q = nwg / NXCD, r = nwg % NXCD, xcd = wgid % NXCD, off = wgid / NXCD; wgid = (xcd < r ? xcd * (q + 1) : r * (q + 1) + (xcd - r) * q) + off; }
        const int nig = WGM * nN, gid = wgid / nig, fm = gid * WGM, gsz = (nM - fm) < WGM ? (nM - fm) : WGM;
        u.pm = fm + ((wgid % nig) % gsz); u.pn = (wgid % nig) / gsz;
    }
    __device__ __forceinline__ bool next(int i, Unit& u) const {
        if (P == 1) { const long L = (long)i * G + c; if (L >= nwg) return false; map((int)L, u); u.kt0 = 0; u.nt = ntot; u.split = -1; u.np = 1; u.part = 0; return true; }
        const bool has_part = c < Rm * P;
        if (i > 0 || !has_part) { const int ii = has_part ? i - 1 : i; if (ii >= F) return false; map(ii * G + c, u); u.kt0 = 0; u.nt = ntot; u.split = -1; u.np = 1; u.part = 0; return true; }
        const int s = c / P, part = c - s * P; map(F * G + s, u);
        u.kt0 = part * nbase + 2 * (part < nextra ? part : nextra); u.nt = nbase + (part < nextra ? 2 : 0); u.split = s; u.np = P; u.part = part; return true;
    }
    __device__ __forceinline__ void a_ready(const Unit&) const {}
    __device__ __forceinline__ void done(const Unit&) const {}
};

constexpr float RMS_EPS = 1e-6f;
typedef float f32x2v __attribute__((ext_vector_type(2)));
typedef __bf16 bf16x2v __attribute__((ext_vector_type(2)));
__device__ __forceinline__ unsigned pkbf(float lo, float hi) { f32x2v v = {lo, hi}; bf16x2v b = __builtin_convertvector(v, bf16x2v); return __builtin_bit_cast(unsigned, b); }

struct EpiScaleBf16 {
    static constexpr bool PERM = true, AFTER_DRAIN = false, SPLITK = false, USES_LDS = false;
    bf16_t* O; int ldc; const float* ss;
    __device__ __forceinline__ void operator()(const f32x4 (&acc)[2][2][4][2], const Unit& u, int wr, int wc, int fr, int fq) const {
        const int row0 = u.pm * BM + wr * 64 + fr, col0 = u.pn * BM + wc * 32 + 8 * fq;
#pragma unroll
        for (int ai = 0; ai < 2; ++ai)
#pragma unroll
            for (int m = 0; m < 4; ++m) {
                const int r = row0 + ai * HALF + m * 16;
                const float s = ss ? __builtin_amdgcn_rsqf(ss[r] * (1.0f / 4096.0f) + RMS_EPS) : 1.0f;
                bf16_t* rowp = O + (size_t)r * ldc + col0;
#pragma unroll
                for (int bj = 0; bj < 2; ++bj) { const f32x4 v0 = acc[ai][bj][m][0] * s, v1 = acc[ai][bj][m][1] * s;
                    u32x4 w; w.x = pkbf(v0[0], v0[1]); w.y = pkbf(v0[2], v0[3]); w.z = pkbf(v1[0], v1[1]); w.w = pkbf(v1[2], v1[3]);
                    *(u32x4*)(rowp + bj * HALF) = w; } }
    }
};
struct EpiScaleF32 {
    static constexpr bool PERM = true, AFTER_DRAIN = false, SPLITK = false, USES_LDS = false;
    float* O; int ldc; const float* ss;
    __device__ __forceinline__ void operator()(const f32x4 (&acc)[2][2][4][2], const Unit& u, int wr, int wc, int fr, int fq) const {
        const int row0 = u.pm * BM + wr * 64 + fr, col0 = u.pn * BM + wc * 32 + 8 * fq;
#pragma unroll
        for (int ai = 0; ai < 2; ++ai)
#pragma unroll
            for (int m = 0; m < 4; ++m) {
                const int r = row0 + ai * HALF + m * 16;
                const float s = ss ? __builtin_amdgcn_rsqf(ss[r] * (1.0f / 4096.0f) + RMS_EPS) : 1.0f;
                float* rowp = O + (size_t)r * ldc + col0;
#pragma unroll
                for (int bj = 0; bj < 2; ++bj) { *(f32x4*)(rowp + bj * HALF) = acc[ai][bj][m][0] * s; *(f32x4*)(rowp + bj * HALF + 4) = acc[ai][bj][m][1] * s; } }
    }
};
struct EpiResid {
    static constexpr bool PERM = true, AFTER_DRAIN = false, SPLITK = true, USES_LDS = false;
    float* Y; bf16_t* XB; float* ssq; unsigned* cnt; unsigned char* slab;
    __device__ __forceinline__ void operator()(const f32x4 (&acc)[2][2][4][2], const Unit& u, int wr, int wc, int fr, int fq) const {
        const int row0 = u.pm * BM + wr * 64 + fr, col0 = u.pn * BM + wc * 32 + 8 * fq;
#pragma unroll
        for (int ai = 0; ai < 2; ++ai)
#pragma unroll
            for (int m = 0; m < 4; ++m) {
                const int r = row0 + ai * HALF + m * 16;
                bf16_t* xp = XB + (size_t)r * 4096 + col0; float sq = 0.f;
                const u32x4 o0 = *(const u32x4*)xp, o1 = *(const u32x4*)(xp + HALF);
#pragma unroll
                for (int bj = 0; bj < 2; ++bj) {
                    const u32x4 o = bj ? o1 : o0;
                    f32x4 a = {__uint_as_float(o.x << 16), __uint_as_float(o.x & 0xffff0000u), __uint_as_float(o.y << 16), __uint_as_float(o.y & 0xffff0000u)};
                    f32x4 b = {__uint_as_float(o.z << 16), __uint_as_float(o.z & 0xffff0000u), __uint_as_float(o.w << 16), __uint_as_float(o.w & 0xffff0000u)};
                    a += acc[ai][bj][m][0]; b += acc[ai][bj][m][1];
                    if (Y) { float* yp = Y + (size_t)r * 4096 + col0 + bj * HALF; *(f32x4*)yp = a; *(f32x4*)(yp + 4) = b; }
                    else {
                        sq += (a[0] * a[0] + a[1] * a[1]) + (a[2] * a[2] + a[3] * a[3]) + (b[0] * b[0] + b[1] * b[1]) + (b[2] * b[2] + b[3] * b[3]);
                        u32x4 w; w.x = pkbf(a[0], a[1]); w.y = pkbf(a[2], a[3]); w.z = pkbf(b[0], b[1]); w.w = pkbf(b[2], b[3]);
                        *(u32x4*)(xp + bj * HALF) = w; } }
                if (!Y) { sq += __shfl_xor(sq, 16); sq += __shfl_xor(sq, 32); if (fq == 0) unsafeAtomicAdd(ssq + r, sq); }
            }
    }
    __device__ __forceinline__ void partial(const f32x4 (&acc)[2][2][4][2], const Unit& u, int wr, int wc, int fr, int fq, PG8_LAS unsigned char* lds, int tid) const {
        const int wid = __builtin_amdgcn_readfirstlane(tid >> 6), lane = tid & 63;
        unsigned char* tile_slabs = slab + (size_t)u.split * 8 * 262144;
        const int myp = u.part;
        { __amdgpu_buffer_rsrc_t rs = __builtin_amdgcn_make_buffer_rsrc((void*)(tile_slabs + (size_t)myp * 262144), (short)0, 262144, 0x00020000);
#pragma unroll
          for (int ai = 0; ai < 2; ++ai)
#pragma unroll
            for (int bj = 0; bj < 2; ++bj)
#pragma unroll
                for (int m = 0; m < 4; ++m)
#pragma unroll
                    for (int n = 0; n < 2; ++n) { const int k = ((ai * 2 + bj) * 4 + m) * 2 + n;
                        __builtin_amdgcn_raw_buffer_store_b128(__builtin_bit_cast(u32x4, acc[ai][bj][m][n]), rs, ((wid * 32 + k) * 64 + lane) * 16, 0, 16); } }
        asm volatile("s_waitcnt vmcnt(0)" ::: "memory");
        __builtin_amdgcn_s_barrier();
        PG8_LAS unsigned* bw = (PG8_LAS unsigned*)(lds + 131072 + 320 + 64);
        if (tid == 0) { const unsigned old = __hip_atomic_fetch_add(cnt + u.split, 1u, __ATOMIC_RELAXED, __HIP_MEMORY_SCOPE_AGENT); *bw = old; }
        asm volatile("s_waitcnt vmcnt(0) lgkmcnt(0)" ::: "memory");
        __builtin_amdgcn_s_barrier();
        const unsigned old = *bw;
        asm volatile("s_waitcnt lgkmcnt(0)" ::: "memory");
        if (old == (unsigned)(u.np - 1)) {
            f32x4 z[2][2][4][2];
#pragma unroll
            for (int a = 0; a < 2; ++a)
#pragma unroll
                for (int b = 0; b < 2; ++b)
#pragma unroll
                    for (int m = 0; m < 4; ++m)
#pragma unroll
                        for (int n = 0; n < 2; ++n) z[a][b][m][n] = (f32x4){0.f, 0.f, 0.f, 0.f};
            for (int p = 0; p < u.np; ++p) {
                __amdgpu_buffer_rsrc_t rs = __builtin_amdgcn_make_buffer_rsrc((void*)(tile_slabs + (size_t)p * 262144), (short)0, 262144, 0x00020000);
#pragma unroll
                for (int ai = 0; ai < 2; ++ai)
#pragma unroll
                    for (int bj = 0; bj < 2; ++bj)
#pragma unroll
                        for (int m = 0; m < 4; ++m)
#pragma unroll
                            for (int n = 0; n < 2; ++n) { const int k = ((ai * 2 + bj) * 4 + m) * 2 + n;
                                z[ai][bj][m][n] += __builtin_bit_cast(f32x4, __builtin_amdgcn_raw_buffer_load_b128(rs, ((wid * 32 + k) * 64 + lane) * 16, 0, 16)); }
            }
            (*this)(z, u, wr, wc, fr, fq);
        }
    }
};
struct EpiGU {
    static constexpr bool PERM = true, AFTER_DRAIN = false, SPLITK = false, USES_LDS = false;
    bf16_t* H; const float* ss; unsigned* cnt; unsigned char* slab;
    __device__ __forceinline__ void operator()(const f32x4 (&acc)[2][2][4][2], const Unit& u, int wr, int wc, int fr, int fq) const {
        const int row0 = u.pm * BM + wr * 64 + fr, col0 = u.pn * HALF + wc * 32 + 8 * fq;
#pragma unroll
        for (int ai = 0; ai < 2; ++ai)
#pragma unroll
            for (int m = 0; m < 4; ++m) {
                const int r = row0 + ai * HALF + m * 16;
                const float s = __builtin_amdgcn_rsqf(ss[r] * (1.0f / 4096.0f) + RMS_EPS);
                float hv[8];
#pragma unroll
                for (int n = 0; n < 2; ++n)
#pragma unroll
                    for (int j = 0; j < 4; ++j) { const float g = acc[ai][0][m][n][j] * s, up = acc[ai][1][m][n][j] * s;
                        hv[n * 4 + j] = g * __builtin_amdgcn_rcpf(1.0f + __builtin_amdgcn_exp2f(-1.4426950408889634f * g)) * up; }
                u32x4 w; w.x = pkbf(hv[0], hv[1]); w.y = pkbf(hv[2], hv[3]); w.z = pkbf(hv[4], hv[5]); w.w = pkbf(hv[6], hv[7]);
                *(u32x4*)(H + (size_t)r * 11008 + col0) = w; }
    }
    __device__ __forceinline__ void partial(const f32x4 (&acc)[2][2][4][2], const Unit& u, int wr, int wc, int fr, int fq, PG8_LAS unsigned char* lds, int tid) const {
        const int wid = __builtin_amdgcn_readfirstlane(tid >> 6), lane = tid & 63;
        unsigned char* tile_slabs = slab + (size_t)u.split * 8 * 262144;
        const int myp = u.part;
        { __amdgpu_buffer_rsrc_t rs = __builtin_amdgcn_make_buffer_rsrc((void*)(tile_slabs + (size_t)myp * 262144), (short)0, 262144, 0x00020000);
#pragma unroll
          for (int ai = 0; ai < 2; ++ai)
#pragma unroll
            for (int bj = 0; bj < 2; ++bj)
#pragma unroll
                for (int m = 0; m < 4; ++m)
#pragma unroll
                    for (int n = 0; n < 2; ++n) { const int k = ((ai * 2 + bj) * 4 + m) * 2 + n;
                        __builtin_amdgcn_raw_buffer_store_b128(__builtin_bit_cast(u32x4, acc[ai][bj][m][n]), rs, ((wid * 32 + k) * 64 + lane) * 16, 0, 16); } }
        asm volatile("s_waitcnt vmcnt(0)" ::: "memory");
        __builtin_amdgcn_s_barrier();
        PG8_LAS unsigned* bw = (PG8_LAS unsigned*)(lds + 131072 + 320 + 64);
        if (tid == 0) { const unsigned old = __hip_atomic_fetch_add(cnt + u.split, 1u, __ATOMIC_RELAXED, __HIP_MEMORY_SCOPE_AGENT); *bw = old; }
        asm volatile("s_waitcnt vmcnt(0) lgkmcnt(0)" ::: "memory");
        __builtin_amdgcn_s_barrier();
        const unsigned old = *bw;
        asm volatile("s_waitcnt lgkmcnt(0)" ::: "memory");
        if (old == (unsigned)(u.np - 1)) {
            f32x4 z[2][2][4][2];
#pragma unroll
            for (int a = 0; a < 2; ++a)
#pragma unroll
                for (int b = 0; b < 2; ++b)
#pragma unroll
                    for (int m = 0; m < 4; ++m)
#pragma unroll
                        for (int n = 0; n < 2; ++n) z[a][b][m][n] = (f32x4){0.f, 0.f, 0.f, 0.f};
            for (int p = 0; p < u.np; ++p) {
                __amdgpu_buffer_rsrc_t rs = __builtin_amdgcn_make_buffer_rsrc((void*)(tile_slabs + (size_t)p * 262144), (short)0, 262144, 0x00020000);
#pragma unroll
                for (int ai = 0; ai < 2; ++ai)
#pragma unroll
                    for (int bj = 0; bj < 2; ++bj)
#pragma unroll
                        for (int m = 0; m < 4; ++m)
#pragma unroll
                            for (int n = 0; n < 2; ++n) { const int k = ((ai * 2 + bj) * 4 + m) * 2 + n;
                                z[ai][bj][m][n] += __builtin_bit_cast(f32x4, __builtin_amdgcn_raw_buffer_load_b128(rs, ((wid * 32 + k) * 64 + lane) * 16, 0, 16)); }
            }
            (*this)(z, u, wr, wc, fr, fq);
        }
    }
};

struct EpiKVNorm {
    static constexpr bool PERM = true, AFTER_DRAIN = false, SPLITK = false, USES_LDS = true;
    bf16_t* O; const float* gain; int Mrows;
    __device__ __forceinline__ void operator()(const f32x4 (&acc)[2][2][4][2], const Unit& u, int wr, int wc, int fr, int fq) const {}
    __device__ __forceinline__ void with_lds(const f32x4 (&acc)[2][2][4][2], const Unit& u, int wr, int wc, int fr, int fq, PG8_LAS unsigned char* lds) const {
        PG8_LAS float* part = (PG8_LAS float*)(lds + 131072 + 1024);
        const int rb = wr * 64 + fr;
#pragma unroll
        for (int ai = 0; ai < 2; ++ai)
#pragma unroll
            for (int m = 0; m < 4; ++m) { const f32x4 a = acc[ai][0][m][0], b = acc[ai][0][m][1];
                float s = (a[0] * a[0] + a[1] * a[1]) + (a[2] * a[2] + a[3] * a[3]) + (b[0] * b[0] + b[1] * b[1]) + (b[2] * b[2] + b[3] * b[3]);
                s += __shfl_xor(s, 16); s += __shfl_xor(s, 32);
                if (fq == 0) part[(ai * HALF + rb + m * 16) * 4 + wc] = s; }
        asm volatile("s_waitcnt lgkmcnt(0)" ::: "memory"); __builtin_amdgcn_s_barrier(); asm volatile("" ::: "memory");
        const int cl = wc * 32 + 8 * fq; const f32x4 g0 = *(const f32x4*)(gain + cl), g1 = *(const f32x4*)(gain + cl + 4);
        const int row0 = u.pm * BM + rb;
#pragma unroll
        for (int ai = 0; ai < 2; ++ai)
#pragma unroll
            for (int m = 0; m < 4; ++m) {
                const f32x4 p = *(const PG8_LAS f32x4*)(part + (ai * HALF + rb + m * 16) * 4);
                const float rs = __builtin_amdgcn_rsqf(((p[0] + p[1]) + (p[2] + p[3])) * (1.0f / 128.0f) + RMS_EPS);
                bf16_t* rowp = O + ((size_t)u.pn * Mrows + (size_t)(row0 + ai * HALF + m * 16)) * 256 + cl;
                const f32x4 k0 = acc[ai][0][m][0] * rs * g0, k1 = acc[ai][0][m][1] * rs * g1, v0 = acc[ai][1][m][0], v1 = acc[ai][1][m][1];
                u32x4 w; w.x = pkbf(k0[0], k0[1]); w.y = pkbf(k0[2], k0[3]); w.z = pkbf(k1[0], k1[1]); w.w = pkbf(k1[2], k1[3]);
                *(u32x4*)rowp = w;
                w.x = pkbf(v0[0], v0[1]); w.y = pkbf(v0[2], v0[3]); w.z = pkbf(v1[0], v1[1]); w.w = pkbf(v1[2], v1[3]);
                *(u32x4*)(rowp + HALF) = w; }
    }
};

struct EpiMemKV {
    static constexpr bool PERM = true, AFTER_DRAIN = false, SPLITK = false, USES_LDS = true;
    const float* ssm; const float* gain; float* outK; float* outV; bf16_t* MK; bf16_t* MV;
    __device__ __forceinline__ void operator()(const f32x4 (&acc)[2][2][4][2], const Unit& u, int wr, int wc, int fr, int fq) const {}
    __device__ __forceinline__ void with_lds(const f32x4 (&acc)[2][2][4][2], const Unit& u, int wr, int wc, int fr, int fq, PG8_LAS unsigned char* lds) const {
        PG8_LAS float* part = (PG8_LAS float*)(lds + 131072 + 1024);
        const int rb = wr * 64 + fr, cl = wc * 32 + 8 * fq; const bool isk = u.pn < 2;
        float sr[2][4];
#pragma unroll
        for (int ai = 0; ai < 2; ++ai)
#pragma unroll
            for (int m = 0; m < 4; ++m) sr[ai][m] = __builtin_amdgcn_rsqf(ssm[u.pm * BM + ai * HALF + rb + m * 16] * (1.0f / 4096.0f) + RMS_EPS);
        if (isk) {
#pragma unroll
            for (int ai = 0; ai < 2; ++ai)
#pragma unroll
                for (int m = 0; m < 4; ++m)
#pragma unroll
                    for (int bj = 0; bj < 2; ++bj) { const f32x4 a = acc[ai][bj][m][0], b = acc[ai][bj][m][1];
                        float s = (a[0] * a[0] + a[1] * a[1]) + (a[2] * a[2] + a[3] * a[3]) + (b[0] * b[0] + b[1] * b[1]) + (b[2] * b[2] + b[3] * b[3]);
                        s *= sr[ai][m] * sr[ai][m]; s += __shfl_xor(s, 16); s += __shfl_xor(s, 32);
                        if (fq == 0) part[((ai * HALF + rb + m * 16) * 2 + bj) * 4 + wc] = s; }
            asm volatile("s_waitcnt lgkmcnt(0)" ::: "memory"); __builtin_amdgcn_s_barrier(); asm volatile("" ::: "memory");
        }
        const f32x4 g0 = *(const f32x4*)(gain + cl), g1 = *(const f32x4*)(gain + cl + 4);
        float* outp = isk ? outK : outV; bf16_t* outb = isk ? MK : MV; const int ct = (isk ? u.pn : u.pn - 2) * BM + cl;
#pragma unroll
        for (int ai = 0; ai < 2; ++ai)
#pragma unroll
            for (int m = 0; m < 4; ++m) { const int r = u.pm * BM + ai * HALF + rb + m * 16;
#pragma unroll
                for (int bj = 0; bj < 2; ++bj) {
                    f32x4 v0 = acc[ai][bj][m][0] * sr[ai][m], v1 = acc[ai][bj][m][1] * sr[ai][m];
                    if (isk) { const f32x4 p = *(const PG8_LAS f32x4*)(part + ((ai * HALF + rb + m * 16) * 2 + bj) * 4);
                        const float rs = __builtin_amdgcn_rsqf(((p[0] + p[1]) + (p[2] + p[3])) * (1.0f / 128.0f) + RMS_EPS); v0 = v0 * rs * g0; v1 = v1 * rs * g1; }
                    float* op = outp + (size_t)r * 512 + ct + bj * HALF; *(f32x4*)op = v0; *(f32x4*)(op + 4) = v1;
                    u32x4 w; w.x = pkbf(v0[0], v0[1]); w.y = pkbf(v0[2], v0[3]); w.z = pkbf(v1[0], v1[1]); w.w = pkbf(v1[2], v1[3]);
                    *(u32x4*)(outb + (size_t)r * 512 + ct + bj * HALF) = w; } }
    }
};

#ifndef PROBE_NULLSPLIT
#define PROBE_NULLSPLIT false
#endif
struct EpiNull {
    static constexpr bool PERM = true, AFTER_DRAIN = false, SPLITK = PROBE_NULLSPLIT, USES_LDS = false;
    __device__ __forceinline__ void partial(const f32x4 (&acc)[2][2][4][2], const Unit& u, int wr, int wc, int fr, int fq, PG8_LAS unsigned char* lds, int tid) const { (*this)(acc, u, wr, wc, fr, fq); }
    __device__ __forceinline__ void operator()(const f32x4 (&acc)[2][2][4][2], const Unit& u, int wr, int wc, int fr, int fq) const {
#pragma unroll
        for (int ai = 0; ai < 2; ++ai)
#pragma unroll
            for (int bj = 0; bj < 2; ++bj)
#pragma unroll
                for (int m = 0; m < 4; ++m) asm volatile("" :: "v"(acc[ai][bj][m][0]), "v"(acc[ai][bj][m][1]));
    }
};

template <class Epi, class Sched, bool ALIGN_EPI = false, bool SP2 = false>
__device__ __forceinline__ void gemm_phase(PG8_LAS unsigned char* lds, const Gemm g, const Sched& S, const Epi& E) {
    int tid_o = threadIdx.x; asm volatile("" : "+v"(tid_o));
    const int tid = tid_o, wid = __builtin_amdgcn_readfirstlane(tid >> 6), lane = tid & 63, wr = wid >> 2, wc = wid & 3, fr = lane & 15, fq = lane >> 4;
    const int K = g.K;
    unsigned voffA[2], voffB[2];
#pragma unroll
    for (int i = 0; i < 2; ++i) { int R, C; stage_rc(tid * 16 + i * 8192, R, C); const int Rb = Epi::PERM ? ((R & ~31) + perm32(R & 31)) : R;
        voffA[i] = (unsigned)(R * K + C) * 2u; voffB[i] = (unsigned)(Rb * K + C) * 2u; }
    const size_t kstep = (size_t)(BK * 2);
    const size_t hstep = (size_t)HALF * K * 2;
    const size_t tstep = 2 * hstep;
    const unsigned ldsw = (unsigned)wid * 1024u;
    const int aoff = lds_byte(wr * 64 + fr, fq * 8), boff = lds_byte(wc * 32 + fr, fq * 8);
#define PG8_SA(b, h) (((b) * 2 + (h)) * HTB)
#define PG8_SB(b, h) ((4 + (b) * 2 + (h)) * HTB)
#define PG8_STAGE(bufoff, gbase, voff) do { _Pragma("unroll") for (int _i = 0; _i < 2; ++_i) \
        __builtin_amdgcn_global_load_lds((const unsigned*)((const char*)(gbase) + (voff)[_i]), (PG8_LAS unsigned*)(lds + (bufoff) + ldsw + _i * 8192), 16, 0, 0); } while (0)
#define PG8_LDA(dst, b, h) do { _Pragma("unroll") for (int m = 0; m < 4; ++m) _Pragma("unroll") for (int k = 0; k < 2; ++k) dst[m][k] = *(const PG8_LAS bf16x8*)(lds + PG8_SA(b, h) + aoff + m * 2048 + k * 1024); } while (0)
#define PG8_LDB(dst, b, h) do { _Pragma("unroll") for (int n = 0; n < 2; ++n) _Pragma("unroll") for (int k = 0; k < 2; ++k) dst[n][k] = *(const PG8_LAS bf16x8*)(lds + PG8_SB(b, h) + boff + n * 2048 + k * 1024); } while (0)
#define PG8_MMA(ai, bj, At, Bt) do { __builtin_amdgcn_s_setprio(1); _Pragma("unroll") for (int m = 0; m < 4; ++m) _Pragma("unroll") for (int n = 0; n < 2; ++n) _Pragma("unroll") for (int k = 0; k < 2; ++k) \
        acc[ai][bj][m][n] = __builtin_amdgcn_mfma_f32_16x16x32_bf16(Bt[n][k], At[m][k], acc[ai][bj][m][n], 0, 0, 0); __builtin_amdgcn_s_setprio(0); } while (0)
#define PG8_WAIT_V(n) asm volatile("s_waitcnt vmcnt(" #n ")" ::: "memory")
#define PG8_WAIT_L(n) asm volatile("s_waitcnt lgkmcnt(" #n ")" ::: "memory")
#define PG8_BAR __builtin_amdgcn_s_barrier()
#define PG8_SCHED __builtin_amdgcn_sched_barrier(0)
    Unit cur, nxt; int ui = 0;
    if (!S.next(0, cur)) return;
    f32x4 acc[2][2][4][2];
#pragma unroll
    for (int a = 0; a < 2; ++a)
#pragma unroll
        for (int b = 0; b < 2; ++b)
#pragma unroll
            for (int m = 0; m < 4; ++m)
#pragma unroll
                for (int n = 0; n < 2; ++n) acc[a][b][m][n] = (f32x4){0.f, 0.f, 0.f, 0.f};
    bf16x8 At[4][2], B0[2][2], B1[2][2];
    const char* cA = (const char*)g.A + (size_t)cur.pm * tstep + (size_t)cur.kt0 * kstep; const char* cB = (const char*)g.Bt + (size_t)cur.pn * tstep + (size_t)cur.kt0 * kstep;
    S.a_ready(cur);
    if constexpr (SP2) {
        PG8_STAGE(PG8_SB(0, 0), cB, voffB); PG8_STAGE(PG8_SB(0, 1), cB + hstep, voffB); PG8_STAGE(PG8_SA(0, 0), cA, voffA); PG8_STAGE(PG8_SA(0, 1), cA + hstep, voffA);
        if (wr == 1) PG8_BAR;
        PG8_WAIT_V(2); PG8_BAR;
        PG8_STAGE(PG8_SB(1, 0), cB + kstep, voffB); PG8_STAGE(PG8_SA(1, 0), cA + kstep, voffA); PG8_STAGE(PG8_SB(1, 1), cB + hstep + kstep, voffB);
        PG8_WAIT_V(6); PG8_BAR;
    } else {
        PG8_STAGE(PG8_SB(0, 0), cB, voffB); PG8_STAGE(PG8_SA(0, 0), cA, voffA); PG8_STAGE(PG8_SB(0, 1), cB + hstep, voffB); PG8_STAGE(PG8_SA(0, 1), cA + hstep, voffA);
        if (wr == 1) PG8_BAR;
        PG8_WAIT_V(4); PG8_BAR;
        PG8_STAGE(PG8_SB(1, 0), cB + kstep, voffB); PG8_STAGE(PG8_SA(1, 0), cA + kstep, voffA); PG8_STAGE(PG8_SB(1, 1), cB + hstep + kstep, voffB);
        PG8_WAIT_V(6); PG8_BAR;
    }
    for (;;) {
        const bool has_next = S.next(ui + 1, nxt);
        const char* nA = has_next ? (const char*)g.A + (size_t)nxt.pm * tstep + (size_t)nxt.kt0 * kstep : cA; const char* nB = has_next ? (const char*)g.Bt + (size_t)nxt.pn * tstep + (size_t)nxt.kt0 * kstep : cB;
        const int nt = cur.nt;
        for (int t = 0; t < nt; t += 2) {
            const bool last = (t == nt - 2);
            const char* a1 = cA + (size_t)(t + 1) * kstep;
            const char* a2 = last ? nA : cA + (size_t)(t + 2) * kstep; const char* b2 = last ? nB : cB + (size_t)(t + 2) * kstep;
            const char* a3 = a2 + kstep; const char* b3 = b2 + kstep;
            if (last && has_next) S.a_ready(nxt);
            if constexpr (SP2) {
            PG8_LDB(B0, 0, 0); PG8_LDB(B1, 0, 1); PG8_SCHED; PG8_LDA(At, 0, 0); PG8_STAGE(PG8_SA(1, 1), a1 + hstep, voffA);
            PG8_WAIT_V(8); PG8_WAIT_L(0); PG8_BAR; PG8_MMA(0, 0, At, B0); PG8_MMA(0, 1, At, B1); PG8_BAR; PG8_SCHED;
            PG8_LDA(At, 0, 1); PG8_STAGE(PG8_SB(0, 0), b2, voffB); PG8_STAGE(PG8_SB(0, 1), b2 + hstep, voffB); PG8_STAGE(PG8_SA(0, 0), a2, voffA);
            PG8_WAIT_V(8); PG8_WAIT_L(0); PG8_BAR; PG8_MMA(1, 0, At, B0); PG8_MMA(1, 1, At, B1); PG8_BAR; PG8_SCHED;
            PG8_LDB(B0, 1, 0); PG8_LDB(B1, 1, 1); PG8_SCHED; PG8_LDA(At, 1, 0); PG8_STAGE(PG8_SA(0, 1), a2 + hstep, voffA);
            PG8_WAIT_V(8); PG8_WAIT_L(0); PG8_BAR; PG8_MMA(0, 0, At, B0); PG8_MMA(0, 1, At, B1); PG8_BAR; PG8_SCHED;
            PG8_LDA(At, 1, 1); PG8_STAGE(PG8_SB(1, 0), b3, voffB); PG8_STAGE(PG8_SB(1, 1), b3 + hstep, voffB); PG8_STAGE(PG8_SA(1, 0), a3, voffA);
            PG8_WAIT_V(8); PG8_WAIT_L(0); PG8_BAR; PG8_MMA(1, 0, At, B0); PG8_MMA(1, 1, At, B1); PG8_BAR; PG8_SCHED;
            } else {
            PG8_LDB(B0, 0, 0); PG8_SCHED; PG8_LDA(At, 0, 0); PG8_STAGE(PG8_SA(1, 1), a1 + hstep, voffA);
            PG8_WAIT_L(8); PG8_BAR; PG8_WAIT_L(0); PG8_MMA(0, 0, At, B0); PG8_BAR; PG8_SCHED;
            PG8_LDB(B1, 0, 1); PG8_STAGE(PG8_SB(0, 0), b2, voffB);
            PG8_BAR; PG8_WAIT_L(0); PG8_MMA(0, 1, At, B1); PG8_BAR;
            PG8_LDA(At, 0, 1); PG8_STAGE(PG8_SA(0, 0), a2, voffA);
            PG8_BAR; PG8_WAIT_L(0); PG8_MMA(1, 0, At, B0); PG8_BAR; PG8_SCHED;
            PG8_STAGE(PG8_SB(0, 1), b2 + hstep, voffB);
            PG8_WAIT_V(6); PG8_BAR; PG8_MMA(1, 1, At, B1); PG8_BAR;
            PG8_LDB(B0, 1, 0); PG8_SCHED; PG8_LDA(At, 1, 0); PG8_STAGE(PG8_SA(0, 1), a2 + hstep, voffA);
            PG8_WAIT_L(8); PG8_BAR; PG8_WAIT_L(0); PG8_MMA(0, 0, At, B0); PG8_BAR; PG8_SCHED;
            PG8_LDB(B1, 1, 1); PG8_STAGE(PG8_SB(1, 0), b3, voffB);
            PG8_BAR; PG8_WAIT_L(0); PG8_MMA(0, 1, At, B1); PG8_BAR;
            PG8_LDA(At, 1, 1); PG8_STAGE(PG8_SA(1, 0), a3, voffA);
            PG8_BAR; PG8_WAIT_L(0); PG8_MMA(1, 0, At, B0); PG8_BAR; PG8_SCHED;
            PG8_STAGE(PG8_SB(1, 1), b3 + hstep, voffB);
            PG8_WAIT_V(6); PG8_BAR; PG8_MMA(1, 1, At, B1); PG8_BAR;
            }
        }
        if constexpr (ALIGN_EPI) { if (wr == 0) PG8_BAR; }
        if constexpr (!Epi::AFTER_DRAIN) { if constexpr (Epi::SPLITK) { if (cur.split >= 0) E.partial(acc, cur, wr, wc, fr, fq, lds, tid); else E(acc, cur, wr, wc, fr, fq); } else if constexpr (Epi::USES_LDS) E.with_lds(acc, cur, wr, wc, fr, fq, lds); else E(acc, cur, wr, wc, fr, fq); S.done(cur); }
        if (!has_next) break;
#pragma unroll
        for (int a = 0; a < 2; ++a)
#pragma unroll
            for (int b = 0; b < 2; ++b)
#pragma unroll
                for (int m = 0; m < 4; ++m)
#pragma unroll
                    for (int n = 0; n < 2; ++n) acc[a][b][m][n] = (f32x4){0.f, 0.f, 0.f, 0.f};
        cur = nxt; cA = nA; cB = nB; ++ui;
        if constexpr (ALIGN_EPI) { if (wr == 1) PG8_BAR; }
    }
    PG8_WAIT_V(0);
    if constexpr (!ALIGN_EPI) { if (wr == 0) PG8_BAR; }
    PG8_BAR;
    if constexpr (Epi::AFTER_DRAIN) { E.fused(acc, cur, wr, wc, fr, fq, lds, wid, lane); S.done(cur); }
#undef PG8_SA
#undef PG8_SB
#undef PG8_STAGE
#undef PG8_LDA
#undef PG8_LDB
#undef PG8_MMA
#undef PG8_WAIT_V
#undef PG8_WAIT_L
#undef PG8_BAR
#undef PG8_SCHED
}
}

typedef unsigned short bf16;
typedef short bf16x8 __attribute__((ext_vector_type(8)));
typedef short s16x4 __attribute__((ext_vector_type(4)));
typedef float f32x4 __attribute__((ext_vector_type(4)));
typedef float f32x16 __attribute__((ext_vector_type(16)));
typedef unsigned u32x4 __attribute__((ext_vector_type(4)));
typedef unsigned u32x2 __attribute__((ext_vector_type(2)));
using pg8::pkbf;
constexpr float EPS = 1e-6f;
DI float bf_lo(unsigned w) { return __uint_as_float(w << 16); }
DI float bf_hi(unsigned w) { return __uint_as_float(w & 0xffff0000u); }
DI float bf2f(bf16 v) { return __uint_as_float((unsigned)v << 16); }
DI bf16 f2bf(float f) { return (bf16)(pkbf(f, f) & 0xffffu); }
DI void unpack8(const u32x4 w, float (&f)[8]) { f[0] = bf_lo(w.x); f[1] = bf_hi(w.x); f[2] = bf_lo(w.y); f[3] = bf_hi(w.y); f[4] = bf_lo(w.z); f[5] = bf_hi(w.z); f[6] = bf_lo(w.w); f[7] = bf_hi(w.w); }
DI u32x4 pack8(const float (&f)[8]) { u32x4 w; w.x = pkbf(f[0], f[1]); w.y = pkbf(f[2], f[3]); w.z = pkbf(f[4], f[5]); w.w = pkbf(f[6], f[7]); return w; }
DI float wave_sum(float v) {
#pragma unroll
    for (int o = 1; o < 64; o <<= 1) v += __shfl_xor(v, o);
    return v;
}
DI float silu_f(float x) { return x * __builtin_amdgcn_rcpf(1.0f + __builtin_amdgcn_exp2f(-1.4426950408889634f * x)); }

#define XB_TMO      128
#define XB_XCNT(j)  (256  + 64 * (j))
#define XB_XSUB(j)  (1280 + 64 * (j))
#define XB_XGEN(j)  (2304 + 64 * (j))
#define XB_TOP      3328
#define XB_TOPGEN   3392
#define XCD_BAR_WORDS 3456
#define XB_SPIN_CAP (1u << 18)

__device__ __forceinline__ unsigned xb_ld(unsigned* p)              { return __hip_atomic_load(p, __ATOMIC_RELAXED, __HIP_MEMORY_SCOPE_AGENT); }
__device__ __forceinline__ unsigned xb_add(unsigned* p, unsigned v) { return __hip_atomic_fetch_add(p, v, __ATOMIC_RELAXED, __HIP_MEMORY_SCOPE_AGENT); }
__device__ __forceinline__ unsigned xb_xcc_id() { return (unsigned)__builtin_amdgcn_s_getreg((3 << 11) | 20) & 0xFu; }
#define XB_SPIN(cond, bar) do { unsigned _sp = 0; while (cond) { __builtin_amdgcn_s_sleep(1); \
    if ((++_sp & 255u) == 0u) { if (xb_ld(&(bar)[XB_TMO])) break; if (_sp > XB_SPIN_CAP) { atomicAdd(&(bar)[XB_TMO], 1u); break; } } } } while (0)

struct XcdBarrier {
    unsigned* bar; unsigned x;
    volatile LAS unsigned* st;
};

__device__ __forceinline__ XcdBarrier xcd_barrier_post(unsigned* bar, volatile LAS unsigned* st) {
    XcdBarrier b; b.bar = bar; b.x = xb_xcc_id(); b.st = st;
    if (threadIdx.x == 0) (void)xb_add(&bar[XB_XCNT(b.x)], 1u);
    return b;
}
__device__ __forceinline__ void xcd_barrier_complete(unsigned* bar, unsigned x, unsigned& nloc, unsigned& nx) {
    const unsigned G = gridDim.x * gridDim.y * gridDim.z;
    unsigned sum, cnt, mine, sp = 0u;
    for (;;) {
        sum = 0u; cnt = 0u; mine = 0u;
#pragma unroll
        for (unsigned j = 0; j < 16; ++j) { const unsigned c = xb_ld(&bar[XB_XCNT(j)]); sum += c; cnt += (c > 0u) ? 1u : 0u; mine = (j == x) ? c : mine; }
        if (sum == G) break;
        __builtin_amdgcn_s_sleep(1);
        if ((++sp & 255u) == 0u) { if (xb_ld(&bar[XB_TMO])) break; if (sp > XB_SPIN_CAP) { atomicAdd(&bar[XB_TMO], 1u); break; } }
    }
    nloc = mine > 0u ? mine : 1u; nx = cnt > 0u ? cnt : 1u;
}

__device__ __forceinline__ void xcd_barrier(const XcdBarrier& b) {
    asm volatile("s_waitcnt vmcnt(0)" ::: "memory");
    __syncthreads();
    if (threadIdx.x == 0) {
        unsigned* bar = b.bar;
        __builtin_amdgcn_s_waitcnt(0);
        unsigned nloc = b.st[0], nx = b.st[1];
        if (nloc == 0u) { xcd_barrier_complete(bar, b.x, nloc, nx); b.st[0] = nloc; b.st[1] = nx; }
        const unsigned old = xb_add(&bar[XB_XSUB(b.x)], 1u);
        const unsigned gen = old / nloc;
        if (old + 1u == (gen + 1u) * nloc) {
            __builtin_amdgcn_fence(__ATOMIC_RELEASE, "agent");
            asm volatile("s_waitcnt vmcnt(0)" ::: "memory");
            const unsigned og = xb_add(&bar[XB_TOP], 1u);
            const unsigned tg = og / nx;
            if (og + 1u == (tg + 1u) * nx) xb_add(&bar[XB_TOPGEN], 1u);
            else XB_SPIN(xb_ld(&bar[XB_TOPGEN]) == tg, bar);
            __builtin_amdgcn_fence(__ATOMIC_ACQUIRE, "agent");
            xb_add(&bar[XB_XGEN(b.x)], 1u);
            asm volatile("s_waitcnt vmcnt(0)" ::: "memory");
        } else {
            XB_SPIN(xb_ld(&bar[XB_XGEN(b.x)]) == gen, bar);
            __builtin_amdgcn_fence(__ATOMIC_ACQUIRE, "agent");
            asm volatile("s_waitcnt vmcnt(0)" ::: "memory");
        }
    }
    __syncthreads();
}

constexpr int DM = 4096, RP = 16384, RSM = 512, R = RP + RSM;
constexpr int SEQ = 2048, DSEQ = 64, PAST = 2048, KVS = PAST + DSEQ;
constexpr int KVROWS = RP + 8 * KVS;
constexpr int NIN = 7936;
constexpr int PC_Z = 1536, PC_XBC = 3584, PC_KPE = 7680, PC_DT = 7744;
constexpr int DFF = 11008, NMEM = 256;
constexpr int NLAYER = 2, NPH = 13;

constexpr size_t O_Y = 0, O_CKV_P = 69206016, O_KPE_P = 85983232, O_CONV_P = 88080384, O_SSM_P = 88276992, O_MK_P = 92471296, O_MV_P = 94568448,
                 O_CKV_S = 96665600, O_KPE_S = 97189888, O_CONV_S = 97255424, O_SSM_S = 97452032, O_END = 101646336;

constexpr size_t al256(size_t x) { return (x + 255) / 256 * 256; }
constexpr size_t WS_CTL = 0, CTL_ZERO_BYTES = 1u << 20;
constexpr int CW_TMO = 0, CW_BAR = 4096, CW_SPLIT = 8192, CW_SS = 16384, CW_SSM = CW_SS + 7 * R;
static_assert((CW_SSM + 2048) * 4 <= (int)CTL_ZERO_BYTES && CW_SPLIT + NLAYER * NPH * 256 <= CW_SS, "ctl");
constexpr size_t WS_ROPE = 1u << 20;
constexpr size_t WS_W = 2u << 20;
constexpr size_t W_IN = WS_W, W_UQ = W_IN + (size_t)NIN * 4096 * 2, W_UKV = W_UQ + (size_t)3072 * 1024 * 2, W_O = W_UKV + (size_t)4096 * 512 * 2,
                 W_XQ = W_O + (size_t)4096 * 4096 * 2, W_XKV = W_XQ + (size_t)512 * 4096 * 2, W_XO = W_XKV + (size_t)1024 * 4096 * 2,
                 W_GU = W_XO + (size_t)4096 * 512 * 2, W_DN = W_GU + (size_t)22016 * 4096 * 2, W_END = W_DN + (size_t)4096 * 11008 * 2;
constexpr size_t A_XB = al256(W_END), A_MB = A_XB + (size_t)R * 4096 * 2, A_MEMF = A_MB + (size_t)2048 * 4096 * 2, A_MEMK = A_MEMF + (size_t)2048 * 1024 * 4,
                 A_MEMV = A_MEMK + (size_t)4096 * 512 * 2, A_XQ = A_MEMV + (size_t)4096 * 512 * 2, A_XO = A_XQ + (size_t)R * 512 * 2, A_DT = A_XO + (size_t)R * 512 * 2,
                 A_CQN = A_DT + (size_t)R * 32 * 4, A_CKV = A_CQN + (size_t)R * 1024 * 2, A_KPE = A_CKV + (size_t)KVROWS * 512 * 2, A_YG = A_KPE + (size_t)KVROWS * 64 * 2,
                 A_MIX = A_YG + (size_t)R * 2048 * 2, A_Q = A_MIX + (size_t)R * 4096 * 2, A_KV = A_Q + (size_t)R * 3072 * 2, A_PROJ = A_KV + (size_t)KVROWS * 4096 * 2,
                 A_XBC = A_PROJ + (size_t)R * NIN * 2, A_WGU2 = A_XBC + (size_t)R * 4096 * 2, A_END = A_WGU2 + (size_t)22016 * 4096 * 2, A_H = A_PROJ;
static_assert((size_t)R * DFF * 2 <= A_WGU2 - A_PROJ, "H overlay");
constexpr size_t WS_NEED = A_END;

constexpr int RING_BYTES = 131072, LDS_BYTES = 163840, MISC_OFF = LDS_BYTES - 256;

struct Args {
    const float* in[38]; float* out; unsigned char* ws; int ph_lo, ph_hi;
};
#define AS4 __attribute__((address_space(4)))
struct Ctx {
    LAS unsigned char* lds; int tid, lane, wave, G, bid;
    const float* const AS4* in; float* out; unsigned char* ws; unsigned* ctl;
};
extern __shared__ __attribute__((aligned(16))) unsigned char lds_raw[];
DI Ctx make_ctx() {
    Ctx F; int tid = threadIdx.x; asm volatile("" : "+v"(tid));
    const AS4 unsigned char* ka = (const AS4 unsigned char*)__builtin_amdgcn_kernarg_segment_ptr(); asm volatile("" : "+s"(ka));
    F.lds = (LAS unsigned char*)lds_raw; F.tid = tid; F.lane = tid & 63; F.wave = __builtin_amdgcn_readfirstlane(tid >> 6); F.G = gridDim.x; F.bid = blockIdx.x;
    F.in = (const float* const AS4*)ka; F.out = *(float* const AS4*)(ka + 38 * 8); F.ws = *(unsigned char* const AS4*)(ka + 39 * 8); F.ctl = (unsigned*)(F.ws + WS_CTL);
    return F;
}
enum { I_XP = 0, I_XS, I_MEM, I_CCKV, I_CKPE, I_SCONV, I_SSSM, I_CMK, I_CMV, I_NMIX, I_WIN, I_QNORM, I_WUQ, I_KVNORM, I_WUKV, I_QNN, I_QNP, I_KNN, I_KNP, I_CONVW, I_CONVB, I_DTB, I_ALOG, I_DSKIP,
       I_SSMN, I_WO, I_NXA, I_MEMN, I_WXQ, I_WXK, I_WXV, I_XNQ, I_XNK, I_WXO, I_NFFN, I_WG, I_WU, I_WD };

DI void p_prologue(const Ctx& F) {
    const int gw = F.bid * 8 + F.wave, NGW = F.G * 8, lane = F.lane;
    float* SS0 = (float*)F.ctl + CW_SS; float* SSM = (float*)F.ctl + CW_SSM;
    bf16* XB = (bf16*)(F.ws + A_XB); bf16* MB = (bf16*)(F.ws + A_MB);
    for (int row = gw; row < R + 2048; row += NGW) {
        const float* src; float* dstf = nullptr; bf16* dstb; float* ssp;
        if (row < RP) { src = F.in[I_XP] + (size_t)row * DM; dstb = XB + (size_t)row * DM; ssp = SS0 + row; }
        else if (row < R) { src = F.in[I_XS] + (size_t)(row - RP) * DM; dstb = XB + (size_t)row * DM; ssp = SS0 + row; }
        else { const int mr = row - R; src = F.in[I_MEM] + (size_t)mr * DM; dstb = MB + (size_t)mr * DM; ssp = SSM + mr; }
        float sq = 0.f;
#pragma unroll
        for (int j = 0; j < 8; ++j) {
            const f32x4 a = __builtin_nontemporal_load((const f32x4*)(src + j * 512 + lane * 8)), b = __builtin_nontemporal_load((const f32x4*)(src + j * 512 + lane * 8 + 4));
            sq += (a[0] * a[0] + a[1] * a[1]) + (a[2] * a[2] + a[3] * a[3]) + (b[0] * b[0] + b[1] * b[1]) + (b[2] * b[2] + b[3] * b[3]);
            if (dstf) { *(f32x4*)(dstf + j * 512 + lane * 8) = a; *(f32x4*)(dstf + j * 512 + lane * 8 + 4) = b; }
            u32x4 w; w.x = pkbf(a[0], a[1]); w.y = pkbf(a[2], a[3]); w.z = pkbf(b[0], b[1]); w.w = pkbf(b[2], b[3]);
            *(u32x4*)(dstb + j * 512 + lane * 8) = w;
        }
        sq = wave_sum(sq);
        if (lane == 0) *ssp = sq;
    }
    float* ctab = (float*)(F.ws + WS_ROPE); float* stab = ctab + KVS * 32;
    for (int i = F.bid * 512 + F.tid; i < KVS * 32; i += F.G * 512) {
        const int pos = i >> 5, k = i & 31;
        const float inv = powf(10000.0f, -(float)k / 32.0f);
        const float ang = (float)pos * inv;
        ctab[i] = cosf(ang); stab[i] = sinf(ang);
    }
}

struct CvItem { const float* src; const float* gain; bf16* dst; int ldw, K, nvalid; };
DI CvItem cv_decode(const Ctx& F, int l, int it) {
    unsigned char* ws = F.ws; CvItem c; c.gain = nullptr; c.nvalid = 64;
    constexpr int N_IN = 122 * 64, N_UQ = 48 * 16, N_UKV = 64 * 8, N_O = 64 * 64, N_XQ = 8 * 64, N_XK = 8 * 64, N_XV = 8 * 64, N_XO = 64 * 8, N_G = 172 * 64, N_U = 172 * 64;
    int r = it;
    if (r < N_IN) { const int kb = r / 122, nb = r % 122, cc = nb * 64; int dr; if (cc < 1536) dr = cc; else if (cc < 1600) dr = PC_KPE; else if (cc < 3648) dr = PC_Z + (cc - 1600); else if (cc < 7744) dr = PC_XBC + (cc - 3648); else { dr = PC_DT; c.nvalid = 32; }
        c.src = F.in[I_WIN] + (size_t)l * 4096 * 7776 + (size_t)kb * 64 * 7776 + cc; c.ldw = 7776; c.gain = F.in[I_NMIX] + l * 4096 + kb * 64; c.K = 4096; c.dst = (bf16*)(ws + W_IN) + (size_t)dr * 4096 + kb * 64; return c; } r -= N_IN;
    if (r < N_UQ) { const int kb = r / 48, nb = r % 48; c.src = F.in[I_WUQ] + (size_t)l * 1024 * 3072 + (size_t)kb * 64 * 3072 + nb * 64; c.ldw = 3072; c.gain = F.in[I_QNORM] + l * 1024 + kb * 64; c.K = 1024; c.dst = (bf16*)(ws + W_UQ) + (size_t)nb * 64 * 1024 + kb * 64; return c; } r -= N_UQ;
    if (r < N_UKV) { const int kb = r / 64, nb = r % 64; c.src = F.in[I_WUKV] + (size_t)l * 512 * 4096 + (size_t)kb * 64 * 4096 + nb * 64; c.ldw = 4096; c.K = 512; c.dst = (bf16*)(ws + W_UKV) + (size_t)nb * 64 * 512 + kb * 64; return c; } r -= N_UKV;
    if (r < N_O) { const int kb = r / 64, nb = r % 64; c.src = F.in[I_WO] + (size_t)l * 4096 * 4096 + (size_t)kb * 64 * 4096 + nb * 64; c.ldw = 4096; c.K = 4096; c.dst = (bf16*)(ws + W_O) + (size_t)nb * 64 * 4096 + kb * 64; return c; } r -= N_O;
    if (r < N_XQ) { const int kb = r / 8, nb = r % 8; c.src = F.in[I_WXQ] + (size_t)l * 4096 * 512 + (size_t)kb * 64 * 512 + nb * 64; c.ldw = 512; c.gain = F.in[I_NXA] + l * 4096 + kb * 64; c.K = 4096; c.dst = (bf16*)(ws + W_XQ) + (size_t)nb * 64 * 4096 + kb * 64; return c; } r -= N_XQ;
    if (r < N_XK) { const int kb = r / 8, nb = r % 8; c.src = F.in[I_WXK] + (size_t)l * 4096 * 512 + (size_t)kb * 64 * 512 + nb * 64; c.ldw = 512; c.gain = F.in[I_MEMN] + l * 4096 + kb * 64; c.K = 4096; c.dst = (bf16*)(ws + W_XKV) + (size_t)nb * 64 * 4096 + kb * 64; return c; } r -= N_XK;
    if (r < N_XV) { const int kb = r / 8, nb = r % 8; c.src = F.in[I_WXV] + (size_t)l * 4096 * 512 + (size_t)kb * 64 * 512 + nb * 64; c.ldw = 512; c.gain = F.in[I_MEMN] + l * 4096 + kb * 64; c.K = 4096; c.dst = (bf16*)(ws + W_XKV) + (size_t)(512 + nb * 64) * 4096 + kb * 64; return c; } r -= N_XV;
    if (r < N_XO) { const int kb = r / 64, nb = r % 64; c.src = F.in[I_WXO] + (size_t)l * 512 * 4096 + (size_t)kb * 64 * 4096 + nb * 64; c.ldw = 4096; c.K = 512; c.dst = (bf16*)(ws + W_XO) + (size_t)nb * 64 * 512 + kb * 64; return c; } r -= N_XO;
    if (r < N_G) { const int kb = r / 172, nb = r % 172; c.src = F.in[I_WG] + (size_t)l * 4096 * DFF + (size_t)kb * 64 * DFF + nb * 64; c.ldw = DFF; c.gain = F.in[I_NFFN] + l * 4096 + kb * 64; c.K = 4096; c.dst = (bf16*)(ws + ((l & 1) ? A_WGU2 : W_GU)) + (size_t)((nb >> 1) * 256 + (nb & 1) * 64) * 4096 + kb * 64; return c; } r -= N_G;
    if (r < N_U) { const int kb = r / 172, nb = r % 172; c.src = F.in[I_WU] + (size_t)l * 4096 * DFF + (size_t)kb * 64 * DFF + nb * 64; c.ldw = DFF; c.gain = F.in[I_NFFN] + l * 4096 + kb * 64; c.K = 4096; c.dst = (bf16*)(ws + ((l & 1) ? A_WGU2 : W_GU)) + (size_t)((nb >> 1) * 256 + 128 + (nb & 1) * 64) * 4096 + kb * 64; return c; } r -= N_U;
    { const int kb = r / 64, nb = r % 64; c.src = F.in[I_WD] + (size_t)l * DFF * 4096 + (size_t)kb * 64 * 4096 + nb * 64; c.ldw = 4096; c.K = DFF; c.dst = (bf16*)(ws + W_DN) + (size_t)nb * 64 * DFF + kb * 64; return c; }
}
constexpr int CV_NITEMS = 122 * 64 + 48 * 16 + 64 * 8 + 64 * 64 + 3 * 8 * 64 + 64 * 8 + 2 * 172 * 64 + 64 * 172;
DI void cv_load(const CvItem& c, f32x4 (&v)[16], int lane) {
    const int n4 = (lane & 15) * 4, kr = lane >> 4; const float* p = c.src + (size_t)kr * c.ldw + n4;
    if (n4 < c.nvalid) {
#pragma unroll
        for (int i = 0; i < 16; ++i) v[i] = __builtin_nontemporal_load((const f32x4*)(p + (size_t)(4 * i) * c.ldw));
    } else {
#pragma unroll
        for (int i = 0; i < 16; ++i) v[i] = (f32x4){0.f, 0.f, 0.f, 0.f};
    }
}
DI void cv_store(const CvItem& c, const f32x4 (&v)[16], LAS unsigned char* scr, int lane) {
    constexpr int RS = 144;
    const int l15 = lane & 15, kr = lane >> 4;
#pragma unroll
    for (int i = 0; i < 16; ++i) { const int k = kr + 4 * i; const float g = c.gain ? c.gain[k] : 1.0f;
        u32x2 w; w.x = pkbf(v[i][0] * g, v[i][1] * g); w.y = pkbf(v[i][2] * g, v[i][3] * g);
        *(LAS u32x2*)(scr + k * RS + l15 * 8) = w; }
    asm volatile("s_waitcnt lgkmcnt(0)" ::: "memory");
    typedef short v4i16_t __attribute__((ext_vector_type(4)));
    const int g4 = lane >> 4, q = l15 >> 2, pp = lane & 3;
#pragma unroll
    for (int cb = 0; cb < 4; ++cb)
#pragma unroll
        for (int kh = 0; kh < 2; ++kh) {
            const LAS unsigned char* a = scr + (32 * kh + 8 * g4 + q) * RS + (16 * cb + 4 * pp) * 2;
            const s16x4 lo = __builtin_bit_cast(s16x4, __builtin_amdgcn_ds_read_tr16_b64_v4i16((LAS v4i16_t*)a));
            const s16x4 hi = __builtin_bit_cast(s16x4, __builtin_amdgcn_ds_read_tr16_b64_v4i16((LAS v4i16_t*)(a + 4 * RS)));
            const bf16x8 o = (bf16x8){lo[0], lo[1], lo[2], lo[3], hi[0], hi[1], hi[2], hi[3]};
            *(bf16x8*)(c.dst + (size_t)(16 * cb + l15) * c.K + 32 * kh + 8 * g4) = o; }
    asm volatile("s_waitcnt lgkmcnt(0)" ::: "memory");
}
constexpr int CV_E3 = 122 * 64 + 48 * 16 + 64 * 8 + 64 * 64 + 3 * 8 * 64 + 64 * 8;
constexpr int CV_GU0 = CV_E3, CV_GU3 = CV_E3 + 2 * 172 * 64, CV_GU1 = CV_GU3 - 7000;
static_assert(CV_GU3 == 37248, "gate/up item range");
constexpr int CV_A0 = 122 * 64 + 48 * 16 + 64 * 8;
constexpr int CV_AGU = 5000;
constexpr int CV_DX = 1500, CV_DG = 2500 + (CV_E3 - CV_A0);
#define CV_MAP(v_) ((v_) < n1 ? la : lb), ((v_) < n1 ? a0 + (v_) : b0 + ((v_) - n1))
#ifndef CV_TAILW
#define CV_TAILW 8
#endif
DI void p_convw_range(const Ctx& F, int la, int a0, int n1, int lb, int b0, int n2, int wg0, int nwg, int nwv = 8, int rank = -1) {
    if (F.wave >= nwv) return;
    LAS unsigned char* scr = F.lds + F.wave * 16384;
    const int gw = (rank >= 0 ? rank : F.bid - wg0) * nwv + F.wave, NGW = nwg * nwv, lane = F.lane;
    const int CV_END = n1 + n2;
    CvItem ca, cb, cc; f32x4 va[16], vb[16], vc[16];
    int nx = gw;
    bool ha = nx < CV_END; if (ha) { ca = cv_decode(F, CV_MAP(nx)); cv_load(ca, va, lane); } nx += NGW;
    bool hb = nx < CV_END; if (hb) { cb = cv_decode(F, CV_MAP(nx)); cv_load(cb, vb, lane); } nx += NGW;
    if (ha) for (;;) {
        const bool hc = nx < CV_END; if (hc) { cc = cv_decode(F, CV_MAP(nx)); cv_load(cc, vc, lane); } nx += NGW;
        cv_store(ca, va, scr, lane);
        if (!hb) break;
        ha = nx < CV_END; if (ha) { ca = cv_decode(F, CV_MAP(nx)); cv_load(ca, va, lane); } nx += NGW;
        cv_store(cb, vb, scr, lane);
        if (!hc) break;
        hb = nx < CV_END; if (hb) { cb = cv_decode(F, CV_MAP(nx)); cv_load(cb, vb, lane); } nx += NGW;
        cv_store(cc, vc, scr, lane);
        if (!ha) break;
    }
}
DI void p_convw(const Ctx& F, int l) {
    if (F.G == 256) { const int s0 = l > 0 ? CV_E3 : 0, s1 = l > 0 ? CV_E3 : CV_A0, d0 = CV_GU3 + CV_DX + CV_DG, d1 = l + 1 < NLAYER ? CV_NITEMS : d0; p_convw_range(F, l, s0, s1 - s0, l, d0, d1 - d0, 0, F.G); }
    else p_convw_range(F, l, 0, CV_NITEMS, l, 0, 0, 0, F.G);
    { unsigned zz = 0u; asm volatile("" : "+v"(zz));
      u32x4 z = {zz, zz, zz, zz}; u32x4* p = (u32x4*)(F.ws + W_IN + (size_t)7808 * 4096 * 2); const int n16 = 128 * 4096 * 2 / 16;
      for (int i = F.bid * 512 + F.tid; i < n16; i += F.G * 512) p[i] = z; }
}

DI void p_post1(const Ctx& F, int l) {
    const int gw = F.bid * 8 + F.wave, NGW = F.G * 8, lane = F.lane;
    unsigned char* ws = F.ws;
    const bf16* PROJ = (const bf16*)(ws + A_PROJ);
    bf16* CQN = (bf16*)(ws + A_CQN); bf16* CKV = (bf16*)(ws + A_CKV); bf16* KPE = (bf16*)(ws + A_KPE); bf16* XBC = (bf16*)(ws + A_XBC); float* DT = (float*)(ws + A_DT);
    const float* ctab = (const float*)(ws + WS_ROPE); const float* stab = ctab + KVS * 32;
    const float* kv_norm = F.in[I_KVNORM] + l * 512; const float* kn_pe = F.in[I_KNP] + l * 64;
    const float* conv_w = F.in[I_CONVW] + l * 4 * 4096; const float* conv_b = F.in[I_CONVB] + l * 4096; const float* dt_bias = F.in[I_DTB] + l * 32;
    f32x4 dk0, dk1, dv0, dv1;
    if (2048 + gw < 4096) { const float* kp = F.in[I_CMK] + ((size_t)l * 2048 + gw) * 512 + lane * 8; dk0 = *(const f32x4*)kp; dk1 = *(const f32x4*)(kp + 4);
        const float* vp = F.in[I_CMV] + ((size_t)l * 2048 + gw) * 512 + lane * 8; dv0 = *(const f32x4*)vp; dv1 = *(const f32x4*)(vp + 4); }
    u32x4 nq0, nq1, nkv; bf16 nk, nd;
#define P1_LOAD(row_) do { const bf16* pr_ = PROJ + (size_t)(row_) * NIN; nq0 = *(const u32x4*)(pr_ + lane * 8); nq1 = *(const u32x4*)(pr_ + 512 + lane * 8); nkv = *(const u32x4*)(pr_ + 1024 + lane * 8); \
        nk = pr_[PC_KPE + lane]; nd = pr_[PC_DT + (lane & 31)]; } while (0)
    f32x4 nc0, nc1; float nkp;
#define P1_CLOAD(i_) do { const int b_ = (i_) >> 11, s_ = (i_) & 2047; const float* cp_ = F.in[I_CCKV] + ((size_t)(l * 8 + b_) * PAST + s_) * 512 + lane * 8; \
        nc0 = __builtin_nontemporal_load((const f32x4*)cp_); nc1 = __builtin_nontemporal_load((const f32x4*)(cp_ + 4)); nkp = F.in[I_CKPE][((size_t)(l * 8 + b_) * PAST + s_) * 64 + lane]; } while (0)
    if (gw < R) P1_LOAD(gw);
    if (gw < 8 * PAST) P1_CLOAD(gw);
    for (int row = gw; row < R; row += NGW) {
        const bool samp = row >= RP; const int b = samp ? (row - RP) >> 6 : row >> 11, t = samp ? (row - RP) & 63 : row & 2047;
        const int pos = samp ? PAST + t : t; const int kvrow = samp ? RP + b * KVS + PAST + t : row;
        const u32x4 cq0 = nq0, cq1 = nq1, ckv = nkv; const bf16 ck = nk, cd = nd;
        const f32x4 cc0 = nc0, cc1 = nc1; const float ckp = nkp;
        if (row + NGW < R) P1_LOAD(row + NGW);
        if (row + NGW < 8 * PAST) P1_CLOAD(row + NGW);
        const float cs_c = ctab[pos * 32 + (lane & 31)], cs_s = stab[pos * 32 + (lane & 31)];
        {   float f0[8], f1[8]; unpack8(cq0, f0); unpack8(cq1, f1);
            float sq = 0.f;
#pragma unroll
            for (int j = 0; j < 8; ++j) sq += f0[j] * f0[j] + f1[j] * f1[j];
            const float rs = __builtin_amdgcn_rsqf(wave_sum(sq) * (1.0f / 1024.0f) + EPS);
#pragma unroll
            for (int j = 0; j < 8; ++j) { f0[j] *= rs; f1[j] *= rs; }
            *(u32x4*)(CQN + (size_t)row * 1024 + lane * 8) = pack8(f0); *(u32x4*)(CQN + (size_t)row * 1024 + 512 + lane * 8) = pack8(f1); }
        {   float f0[8]; unpack8(ckv, f0);
            float sq = 0.f;
#pragma unroll
            for (int j = 0; j < 8; ++j) sq += f0[j] * f0[j];
            const float rs = __builtin_amdgcn_rsqf(wave_sum(sq) * (1.0f / 512.0f) + EPS);
#pragma unroll
            for (int j = 0; j < 8; ++j) f0[j] *= rs * kv_norm[lane * 8 + j];
            float* op = samp ? F.out + O_CKV_S + ((size_t)(l * 8 + b) * 64 + t) * 512 : F.out + O_CKV_P + ((size_t)(l * 8 + b) * 2048 + t) * 512;
            *(f32x4*)(op + lane * 8) = (f32x4){f0[0], f0[1], f0[2], f0[3]}; *(f32x4*)(op + lane * 8 + 4) = (f32x4){f0[4], f0[5], f0[6], f0[7]};
            *(u32x4*)(CKV + (size_t)kvrow * 512 + lane * 8) = pack8(f0); }
        {   const float x = bf2f(ck);
            const float rs = __builtin_amdgcn_rsqf(wave_sum(x * x) * (1.0f / 64.0f) + EPS);
            const float xn = x * rs * kn_pe[lane]; const float other = __shfl_xor(xn, 32);
            const float o = lane < 32 ? xn * cs_c - other * cs_s : other * cs_s + xn * cs_c;
            float* op = samp ? F.out + O_KPE_S + ((size_t)(l * 8 + b) * 64 + t) * 64 : F.out + O_KPE_P + ((size_t)(l * 8 + b) * 2048 + t) * 64;
            op[lane] = o; KPE[(size_t)kvrow * 64 + lane] = f2bf(o); }
        if (lane < 32) { const float v = bf2f(cd) + dt_bias[lane]; DT[(size_t)row * 32 + lane] = v > 20.f ? v : 0.6931471805599453f * __builtin_amdgcn_logf(1.0f + __builtin_amdgcn_exp2f(1.4426950408889634f * v)); }
        if (row < 8 * PAST) { const int cb_ = row >> 11, cs_ = row & 2047; const size_t ckr = (size_t)RP + cb_ * KVS + cs_;
            u32x4 w; w.x = pkbf(cc0[0], cc0[1]); w.y = pkbf(cc0[2], cc0[3]); w.z = pkbf(cc1[0], cc1[1]); w.w = pkbf(cc1[2], cc1[3]);
            *(u32x4*)(CKV + ckr * 512 + lane * 8) = w; KPE[ckr * 64 + lane] = f2bf(ckp); }
    }
#undef P1_LOAD
#undef P1_CLOAD
    const int cvc = (gw & 7) * 512 + lane * 8;
    u32x4 xn[11];
#define P1_XLOAD(it_) do { const int rb_ = (it_) >> 3, r0_ = rb_ * 8; const bool samp_ = r0_ >= RP; const int b_ = samp_ ? (r0_ - RP) >> 6 : r0_ >> 11, t0_ = samp_ ? (r0_ - RP) & 63 : r0_ & 2047; \
        _Pragma("unroll") for (int i = 0; i < 11; ++i) { const int tt = t0_ - 3 + i; \
            if (tt >= 0) xn[i] = *(const u32x4*)(PROJ + (size_t)(r0_ - 3 + i) * NIN + PC_XBC + cvc); \
            else if (samp_) { const float* sp = F.in[I_SCONV] + ((size_t)(l * 8 + b_) * 3 + (tt + 3)) * 4096 + cvc; const f32x4 a0 = *(const f32x4*)sp, a1 = *(const f32x4*)(sp + 4); \
                xn[i].x = pkbf(a0[0], a0[1]); xn[i].y = pkbf(a0[2], a0[3]); xn[i].z = pkbf(a1[0], a1[1]); xn[i].w = pkbf(a1[2], a1[3]); } \
            else xn[i] = (u32x4){0u, 0u, 0u, 0u}; } } while (0)
    const int NCI = (R / 8) * 8;
    if (gw < NCI) P1_XLOAD(gw);
    float wt[4][8], bs[8];
    {   const int c = cvc;
#pragma unroll
        for (int i = 0; i < 4; ++i) { const f32x4 w0 = *(const f32x4*)(conv_w + i * 4096 + c), w1 = *(const f32x4*)(conv_w + i * 4096 + c + 4);
            wt[i][0] = w0[0]; wt[i][1] = w0[1]; wt[i][2] = w0[2]; wt[i][3] = w0[3]; wt[i][4] = w1[0]; wt[i][5] = w1[1]; wt[i][6] = w1[2]; wt[i][7] = w1[3]; }
        { const f32x4 b0 = *(const f32x4*)(conv_b + c), b1 = *(const f32x4*)(conv_b + c + 4); bs[0] = b0[0]; bs[1] = b0[1]; bs[2] = b0[2]; bs[3] = b0[3]; bs[4] = b1[0]; bs[5] = b1[1]; bs[6] = b1[2]; bs[7] = b1[3]; } }
    for (int it = gw; it < NCI; it += NGW) {
        const int rb = it >> 3, r0 = rb * 8, c = cvc;
        const bool samp = r0 >= RP; const int b = samp ? (r0 - RP) >> 6 : r0 >> 11, t0 = samp ? (r0 - RP) & 63 : r0 & 2047, L = samp ? DSEQ : SEQ;
        u32x4 xr[11];
#pragma unroll
        for (int i = 0; i < 11; ++i) xr[i] = xn[i];
        if (it + NGW < NCI) P1_XLOAD(it + NGW);
#pragma unroll
        for (int j = 0; j < 8; ++j) {
            float acc[8];
#pragma unroll
            for (int e = 0; e < 8; ++e) acc[e] = bs[e];
#pragma unroll
            for (int i = 0; i < 4; ++i) { float xv[8]; unpack8(xr[j + i], xv);
#pragma unroll
                for (int e = 0; e < 8; ++e) acc[e] += xv[e] * wt[i][e]; }
#pragma unroll
            for (int e = 0; e < 8; ++e) acc[e] = silu_f(acc[e]);
            *(u32x4*)(XBC + (size_t)(r0 + j) * 4096 + c) = pack8(acc);
            if (t0 + j >= L - 3) { float xv[8]; unpack8(xr[j + 3], xv);
                float* op = (samp ? F.out + O_CONV_S : F.out + O_CONV_P) + ((size_t)(l * 8 + b) * 3 + (t0 + j - (L - 3))) * 4096 + c;
                *(f32x4*)op = (f32x4){xv[0], xv[1], xv[2], xv[3]}; *(f32x4*)(op + 4) = (f32x4){xv[4], xv[5], xv[6], xv[7]}; }
        }
    }
    {   bf16* MEMK = (bf16*)(ws + A_MEMK); bf16* MEMV = (bf16*)(ws + A_MEMV);
        for (int row = 2048 + gw; row < 4096; row += NGW) {
            if (row != 2048 + gw) {
                const int mr = row - 2048;
                const float* kp = F.in[I_CMK] + ((size_t)l * 2048 + mr) * 512 + lane * 8; dk0 = *(const f32x4*)kp; dk1 = *(const f32x4*)(kp + 4);
                const float* vp = F.in[I_CMV] + ((size_t)l * 2048 + mr) * 512 + lane * 8; dv0 = *(const f32x4*)vp; dv1 = *(const f32x4*)(vp + 4);
            }
            u32x4 w; w.x = pkbf(dk0[0], dk0[1]); w.y = pkbf(dk0[2], dk0[3]); w.z = pkbf(dk1[0], dk1[1]); w.w = pkbf(dk1[2], dk1[3]);
            *(u32x4*)(MEMK + (size_t)row * 512 + lane * 8) = w;
            w.x = pkbf(dv0[0], dv0[1]); w.y = pkbf(dv0[2], dv0[3]); w.z = pkbf(dv1[0], dv1[1]); w.w = pkbf(dv1[2], dv1[3]);
            *(u32x4*)(MEMV + (size_t)row * 512 + lane * 8) = w;
        }
    }
}

DI void p_gnorm(const Ctx& F, int l) {
    const int gw = F.bid * 8 + F.wave, NGW = F.G * 8, lane = F.lane;
    const bf16* YG = (const bf16*)(F.ws + A_YG); bf16* MIX = (bf16*)(F.ws + A_MIX);
    const float* sn = F.in[I_SSMN] + l * 2048;
    u32x4 nw[4];
    f32x4 g0[4], g1[4];
#pragma unroll
    for (int p = 0; p < 4; ++p) { const int c = p * 512 + lane * 8; g0[p] = *(const f32x4*)(sn + c); g1[p] = *(const f32x4*)(sn + c + 4); }
    if (gw < R) {
#pragma unroll
        for (int p = 0; p < 4; ++p) nw[p] = *(const u32x4*)(YG + (size_t)gw * 2048 + p * 512 + lane * 8);
    }
    for (int row = gw; row < R; row += NGW) {
        u32x4 w[4];
#pragma unroll
        for (int p = 0; p < 4; ++p) w[p] = nw[p];
        if (row + NGW < R) {
#pragma unroll
            for (int p = 0; p < 4; ++p) nw[p] = *(const u32x4*)(YG + (size_t)(row + NGW) * 2048 + p * 512 + lane * 8);
        }
#pragma unroll
        for (int p = 0; p < 4; ++p) {
            float f[8]; unpack8(w[p], f); float sq = 0.f;
#pragma unroll
            for (int j = 0; j < 8; ++j) sq += f[j] * f[j];
            sq += __shfl_xor(sq, 1); sq += __shfl_xor(sq, 2); sq += __shfl_xor(sq, 4); sq += __shfl_xor(sq, 8); sq += __shfl_xor(sq, 16);
            const float rs = __builtin_amdgcn_rsqf(sq * (1.0f / 256.0f) + EPS);
            const int c = p * 512 + lane * 8;
            f[0] *= rs * g0[p][0]; f[1] *= rs * g0[p][1]; f[2] *= rs * g0[p][2]; f[3] *= rs * g0[p][3]; f[4] *= rs * g1[p][0]; f[5] *= rs * g1[p][1]; f[6] *= rs * g1[p][2]; f[7] *= rs * g1[p][3];
            *(u32x4*)(MIX + (size_t)row * 4096 + 2048 + c) = pack8(f);
        }
    }
}

namespace att {
#define KSWZ(row, colB) ((row) * 256 + ((colB) ^ (((row) & 7) << 4)))
#define PSWZ(row, colB) ((row) * 128 + ((colB) ^ (((row) & 7) << 4)))
#define SBAR() __builtin_amdgcn_sched_barrier(0)
constexpr int SHM_K = 16384, SHM_V = 16384, SHM_P = 8192, BUF = SHM_K + SHM_V + SHM_P, NBUF = 3, WSOFF = NBUF * BUF, QPOFF = WSOFF + 2048, ATT_END = QPOFF + 32768;
DI int crow(int r, int hi) { return (r & 3) + 8 * (r >> 2) + 4 * hi; }
DI int v_st(int k, int c) { const int kk = (k & ~0xC) | ((k & 4) << 1) | ((k & 8) >> 1); return ((kk >> 3) * 4 + (c >> 5)) * 512 + ((kk & 7) * 32 + (c & 31)) * 2; }
DI int v_rd_base(int lane) { return ((lane & 3) << 3) | (((lane >> 2) & 3) << 6) | (((lane >> 4) & 1) << 5) | (((lane >> 5) & 1) << 8); }
constexpr int v_rd_off(int d0, int ks, int half) { return d0 * 512 + ks * 4096 + half * 2048; }
template <int OFF> DI s16x4 tr_read(int vb) { s16x4 r; asm volatile("ds_read_b64_tr_b16 %0, %1 offset:%2" : "=&v"(r) : "v"(vb), "i"(OFF) : "memory"); return r; }
struct VFrag { s16x4 l0, h0, l1, h1, l2, h2, l3, h3; };
template <int D0> DI void v_read(VFrag& f, int vb) {
    f.l0 = tr_read<v_rd_off(D0, 0, 0)>(vb); f.h0 = tr_read<v_rd_off(D0, 0, 1)>(vb); f.l1 = tr_read<v_rd_off(D0, 1, 0)>(vb); f.h1 = tr_read<v_rd_off(D0, 1, 1)>(vb);
    f.l2 = tr_read<v_rd_off(D0, 2, 0)>(vb); f.h2 = tr_read<v_rd_off(D0, 2, 1)>(vb); f.l3 = tr_read<v_rd_off(D0, 3, 0)>(vb); f.h3 = tr_read<v_rd_off(D0, 3, 1)>(vb);
}
DI void pv_mma(f32x16& od, const VFrag& f, bf16x8 pa0, bf16x8 pa1, bf16x8 pa2, bf16x8 pa3) {
#define PKV(L, H) (bf16x8){L[0], L[1], L[2], L[3], H[0], H[1], H[2], H[3]}
    od = __builtin_amdgcn_mfma_f32_32x32x16_bf16(pa0, PKV(f.l0, f.h0), od, 0, 0, 0);
    od = __builtin_amdgcn_mfma_f32_32x32x16_bf16(pa1, PKV(f.l1, f.h1), od, 0, 0, 0);
    od = __builtin_amdgcn_mfma_f32_32x32x16_bf16(pa2, PKV(f.l2, f.h2), od, 0, 0, 0);
    od = __builtin_amdgcn_mfma_f32_32x32x16_bf16(pa3, PKV(f.l3, f.h3), od, 0, 0, 0);
#undef PKV
}
DI void pv_all(f32x16* o, int vb, bf16x8 pa0, bf16x8 pa1, bf16x8 pa2, bf16x8 pa3) {
    VFrag fa, fb;
    v_read<0>(fa, vb);
    v_read<1>(fb, vb); asm volatile("s_waitcnt lgkmcnt(8)" ::: "memory"); SBAR(); pv_mma(o[0], fa, pa0, pa1, pa2, pa3); SBAR();
    v_read<2>(fa, vb); asm volatile("s_waitcnt lgkmcnt(8)" ::: "memory"); SBAR(); pv_mma(o[1], fb, pa0, pa1, pa2, pa3); SBAR();
    v_read<3>(fb, vb); asm volatile("s_waitcnt lgkmcnt(8)" ::: "memory"); SBAR(); pv_mma(o[2], fa, pa0, pa1, pa2, pa3); SBAR();
    asm volatile("s_waitcnt lgkmcnt(0)" ::: "memory"); SBAR(); pv_mma(o[3], fb, pa0, pa1, pa2, pa3);
}
template <int DPE, int ABL = 0>
DI void attn_unit(LAS unsigned char* lds, const bf16* Qrow, const bf16* Kn, int ldk, const bf16* Kp, const bf16* Vh, int ldv, bf16* Ow, int ldo,
                  int NT, int wnt, bool active, float scale, const float* g_nope, const float* g_pe, const float* ctab, const float* stab, int pos, int tid) {
    const int wid = __builtin_amdgcn_readfirstlane(tid >> 6), lane = tid & 63, r32 = lane & 31, hi = lane >> 5;
    LAS float* li_l = (LAS float*)(lds + WSOFF) + wid * 64; LAS float* al_l = li_l + 32;
    const float C = scale * 1.4426950408889634f;
    constexpr int NQ = 8 + DPE / 16;
    bf16x8 qr[8];
    LAS unsigned char* qpl = lds + QPOFF + wid * 4096 + lane * 16;
    if (active) {
        const bf16* Qw = Qrow + hi * 8;
        if constexpr (DPE == 64) {
            float pe[4][8]; float sp = 0.f;
#pragma unroll
            for (int db = 0; db < 4; ++db) { const u32x4 rw = *(const u32x4*)(Qw + 128 + db * 16); unpack8(rw, pe[db]);
#pragma unroll
                for (int j = 0; j < 8; ++j) sp += pe[db][j] * pe[db][j]; }
            sp += __shfl_xor(sp, 32);
            const float rp = __builtin_amdgcn_rsqf(sp * (1.0f / 64.0f) + EPS);
#pragma unroll
            for (int db = 0; db < 2; ++db) { const int i0 = db * 16 + hi * 8; float o1[8], o2[8];
#pragma unroll
                for (int j = 0; j < 8; ++j) { const float x1 = pe[db][j] * rp * g_pe[i0 + j], x2 = pe[db + 2][j] * rp * g_pe[32 + i0 + j];
                    const float cj = ctab[pos * 32 + i0 + j], sj = stab[pos * 32 + i0 + j]; o1[j] = x1 * cj - x2 * sj; o2[j] = x1 * sj + x2 * cj; }
                const u32x4 w1 = pack8(o1), w2 = pack8(o2); *(LAS u32x4*)(qpl + 1024 * db) = w1; *(LAS u32x4*)(qpl + 1024 * (2 + db)) = w2; }
            asm volatile("" ::: "memory");
        }
        float sq = 0.f; u32x4 raw[8];
#pragma unroll
        for (int d0 = 0; d0 < 8; ++d0) raw[d0] = *(const u32x4*)(Qw + d0 * 16);
#pragma unroll
        for (int d0 = 0; d0 < 8; ++d0) { float f[8]; unpack8(raw[d0], f);
#pragma unroll
            for (int j = 0; j < 8; ++j) sq += f[j] * f[j]; }
        sq += __shfl_xor(sq, 32);
        const float rs = __builtin_amdgcn_rsqf(sq * (1.0f / 128.0f) + EPS);
#pragma unroll
        for (int d0 = 0; d0 < 8; ++d0) { float f[8]; unpack8(raw[d0], f); const int c = d0 * 16 + hi * 8;
            const f32x4 g0 = *(const f32x4*)(g_nope + c), g1 = *(const f32x4*)(g_nope + c + 4);
            f[0] *= rs * g0[0]; f[1] *= rs * g0[1]; f[2] *= rs * g0[2]; f[3] *= rs * g0[3]; f[4] *= rs * g1[0]; f[5] *= rs * g1[1]; f[6] *= rs * g1[2]; f[7] *= rs * g1[3];
            const u32x4 w = pack8(f); qr[d0] = __builtin_bit_cast(bf16x8, w); }
    } else {
#pragma unroll
        for (int d0 = 0; d0 < 8; ++d0) qr[d0] = (bf16x8){0, 0, 0, 0, 0, 0, 0, 0};
    }
    int offK[2], offV[2], offP;
#pragma unroll
    for (int i = 0; i < 2; ++i) { const int ob = i * 8192 + wid * 1024 + lane * 16;
        { const int row = ob >> 8, cb = (ob & 255) ^ ((row & 7) << 4); offK[i] = row * ldk * 2 + cb; }
        { const int sub = ob >> 9, kk = (sub >> 2) * 8 + ((ob & 511) >> 6), k = (kk & ~0xC) | ((kk & 4) << 1) | ((kk & 8) >> 1), cc = (sub & 3) * 32 + ((ob & 63) >> 1); offV[i] = k * ldv * 2 + cc * 2; } }
    { const int ob = wid * 1024 + lane * 16, row = ob >> 7, cb = (ob & 127) ^ ((row & 7) << 4); offP = row * 128 + cb; }
    const int vb0 = (int)(uintptr_t)(lds + SHM_K) + v_rd_base(lane);
    const int sw_ = (r32 & 7) << 4;
    const int ka0 = r32 * 256 + ((0 * 32 + hi * 16) ^ sw_), ka1 = r32 * 256 + ((1 * 32 + hi * 16) ^ sw_), ka2 = r32 * 256 + ((2 * 32 + hi * 16) ^ sw_), ka3 = r32 * 256 + ((3 * 32 + hi * 16) ^ sw_);
    const int pa_0 = r32 * 128 + ((0 * 32 + hi * 16) ^ sw_), pa_1 = r32 * 128 + ((1 * 32 + hi * 16) ^ sw_), pa_2 = r32 * 128 + ((2 * 32 + hi * 16) ^ sw_), pa_3 = r32 * 128 + ((3 * 32 + hi * 16) ^ sw_);
#define STAGE(j_, b_) do { const size_t k0_ = (size_t)(j_) * 64; const char* kb_ = (const char*)Kn + k0_ * ldk * 2; const char* vbp_ = (const char*)Vh + k0_ * ldv * 2; LAS unsigned char* bb_ = lds + (b_) * BUF + wid * 1024; \
        __builtin_amdgcn_global_load_lds((const unsigned*)(kb_ + offK[0]), (LAS unsigned*)(bb_), 16, 0, 0); __builtin_amdgcn_global_load_lds((const unsigned*)(kb_ + offK[1]), (LAS unsigned*)(bb_ + 8192), 16, 0, 0); \
        __builtin_amdgcn_global_load_lds((const unsigned*)(vbp_ + offV[0]), (LAS unsigned*)(bb_ + SHM_K), 16, 0, 0); __builtin_amdgcn_global_load_lds((const unsigned*)(vbp_ + offV[1]), (LAS unsigned*)(bb_ + SHM_K + 8192), 16, 0, 0); \
        if constexpr (DPE == 64) __builtin_amdgcn_global_load_lds((const unsigned*)((const char*)Kp + k0_ * 128 + offP), (LAS unsigned*)(bb_ + SHM_K + SHM_V), 16, 0, 0); } while (0)
    constexpr int NLD = DPE == 64 ? 5 : 4;
#define STAGE_WAIT1() do { if constexpr (NLD == 5) asm volatile("s_waitcnt vmcnt(5)" ::: "memory"); else asm volatile("s_waitcnt vmcnt(4)" ::: "memory"); __builtin_amdgcn_s_barrier(); asm volatile("" ::: "memory"); } while (0)
#define STAGE_WAIT0() do { asm volatile("s_waitcnt vmcnt(0)" ::: "memory"); __builtin_amdgcn_s_barrier(); asm volatile("" ::: "memory"); } while (0)
    if constexpr (ABL != 4) { STAGE(0, 0); if (NT > 1) STAGE(1, 1); } if (NT > 1) STAGE_WAIT1(); else STAGE_WAIT0();
    float m_reg = -1e30f, l_reg = 0.f; f32x16 o[4];
#pragma unroll
    for (int d = 0; d < 4; ++d)
#pragma unroll
        for (int r = 0; r < 16; ++r) o[d][r] = 0.f;
    const float thr_raw = 8.0f / scale;
    int buf = 0;
    for (int j = 0; j < NT; ++j) {
        const int bn2 = buf == 0 ? 2 : buf - 1;
        if constexpr (ABL != 4) { if (j + 2 < NT) STAGE(j + 2, bn2); }
        if (active && j < wnt) {
            const LAS unsigned char* Ks = lds + buf * BUF; const LAS unsigned char* Ps = Ks + SHM_K + SHM_V;
            f32x16 p0, p1;
#pragma unroll
            for (int r = 0; r < 16; ++r) { p0[r] = 0.f; p1[r] = 0.f; }
            if constexpr (ABL != 3) {
            const int kbo = (int)(uintptr_t)Ks;
            bf16x8 fa0, fa1, fb0, fb1;
#define KRD(dst, addr, off) asm volatile("ds_read_b128 %0, %1 offset:%2" : "=&v"(dst) : "v"(addr), "i"(off) : "memory")
#define KRD2(f0, f1, ka_, m_) do { KRD(f0, kbo + ka_, (m_) * 128); KRD(f1, kbo + ka_, (m_) * 128 + 8192); } while (0)
#define KMMA(f0, f1, q_) do { p0 = __builtin_amdgcn_mfma_f32_32x32x16_bf16(f0, q_, p0, 0, 0, 0); p1 = __builtin_amdgcn_mfma_f32_32x32x16_bf16(f1, q_, p1, 0, 0, 0); } while (0)
#define KWAIT(n_) do { asm volatile("s_waitcnt lgkmcnt(" #n_ ")" ::: "memory"); SBAR(); } while (0)
            KRD2(fa0, fa1, ka0, 0); KRD2(fb0, fb1, ka1, 0);
            KWAIT(2); KMMA(fa0, fa1, qr[0]); SBAR(); KRD2(fa0, fa1, ka2, 0);
            KWAIT(2); KMMA(fb0, fb1, qr[1]); SBAR(); KRD2(fb0, fb1, ka3, 0);
            KWAIT(2); KMMA(fa0, fa1, qr[2]); SBAR(); KRD2(fa0, fa1, ka0, 1);
            KWAIT(2); KMMA(fb0, fb1, qr[3]); SBAR(); KRD2(fb0, fb1, ka1, 1);
            KWAIT(2); KMMA(fa0, fa1, qr[4]); SBAR(); KRD2(fa0, fa1, ka2, 1);
            KWAIT(2); KMMA(fb0, fb1, qr[5]); SBAR(); KRD2(fb0, fb1, ka3, 1);
            if constexpr (DPE == 64) {
                const int pbo = (int)(uintptr_t)Ps; const int qpo = (int)(uintptr_t)qpl; bf16x8 qfa, qfb;
#define PRD3(f0, f1, qf, pa_, d_) do { KRD(f0, pbo + pa_, 0); KRD(f1, pbo + pa_, 4096); KRD(qf, qpo, (d_) * 1024); } while (0)
                KWAIT(2); KMMA(fa0, fa1, qr[6]); SBAR(); PRD3(fa0, fa1, qfa, pa_0, 0);
                KWAIT(3); KMMA(fb0, fb1, qr[7]); SBAR(); PRD3(fb0, fb1, qfb, pa_1, 1);
                KWAIT(3); KMMA(fa0, fa1, qfa); SBAR(); PRD3(fa0, fa1, qfa, pa_2, 2);
                KWAIT(3); KMMA(fb0, fb1, qfb); SBAR(); PRD3(fb0, fb1, qfb, pa_3, 3);
                KWAIT(3); KMMA(fa0, fa1, qfa); SBAR();
                KWAIT(0); KMMA(fb0, fb1, qfb);
#undef PRD3
            } else {
                KWAIT(2); KMMA(fa0, fa1, qr[6]); SBAR();
                KWAIT(0); KMMA(fb0, fb1, qr[7]);
            }
#undef KRD
#undef KRD2
#undef KMMA
#undef KWAIT
            } else { asm volatile("" : "+v"(p0), "+v"(p1)); }
            float alpha = 1.f;
            if constexpr (ABL != 1) {
            float pmax = p0[0];
#pragma unroll
            for (int r = 1; r < 16; ++r) pmax = fmaxf(pmax, p0[r]);
#pragma unroll
            for (int r = 0; r < 16; ++r) pmax = fmaxf(pmax, p1[r]);
            { auto rr = __builtin_amdgcn_permlane32_swap(__float_as_uint(pmax), __float_as_uint(pmax), false, false); pmax = fmaxf(__uint_as_float(rr[0]), __uint_as_float(rr[1])); }
            float mn;
            if (__all(pmax - m_reg <= thr_raw)) { mn = m_reg; alpha = 1.f; }
            else { mn = fmaxf(m_reg, pmax); alpha = __builtin_amdgcn_exp2f((m_reg - mn) * C); m_reg = mn; }
            const float mnC = -mn * C;
#pragma unroll
            for (int r = 0; r < 16; ++r) { p0[r] = __builtin_amdgcn_exp2f(fmaf(p0[r], C, mnC)); p1[r] = __builtin_amdgcn_exp2f(fmaf(p1[r], C, mnC)); }
            float ps = 0.f;
#pragma unroll
            for (int r = 0; r < 16; ++r) ps += p0[r] + p1[r];
            { auto rr = __builtin_amdgcn_permlane32_swap(__float_as_uint(ps), __float_as_uint(ps), false, false); ps = __uint_as_float(rr[0]) + __uint_as_float(rr[1]); }
            l_reg = l_reg * alpha + ps;
            }
            bf16x8 pa0, pa1, pa2, pa3;
#define PK4(P, BASE, OUT) do { unsigned a0 = pkbf(P[BASE + 0], P[BASE + 1]), a1 = pkbf(P[BASE + 2], P[BASE + 3]); \
        unsigned b0_ = pkbf(P[BASE + 4], P[BASE + 5]), b1_ = pkbf(P[BASE + 6], P[BASE + 7]); \
        auto r0 = __builtin_amdgcn_permlane32_swap(a0, b0_, false, false); auto r1 = __builtin_amdgcn_permlane32_swap(a1, b1_, false, false); \
        u32x4 w_ = {r0[0], r1[0], r0[1], r1[1]}; OUT = __builtin_bit_cast(bf16x8, w_); } while (0)
            PK4(p0, 0, pa0); PK4(p0, 8, pa1); PK4(p1, 0, pa2); PK4(p1, 8, pa3);
#undef PK4
            if (__any(alpha < 1.f)) { if (hi == 0) al_l[r32] = alpha; asm volatile("s_waitcnt lgkmcnt(0)" ::: "memory");
#pragma unroll
                for (int r = 0; r < 16; ++r) { const float a = al_l[crow(r, hi)];
#pragma unroll
                    for (int d = 0; d < 4; ++d) o[d][r] *= a; } }
            const int vb = vb0 + buf * BUF;
            if constexpr (ABL != 2) pv_all(o, vb, pa0, pa1, pa2, pa3); else asm volatile("" :: "v"(pa0), "v"(pa1), "v"(pa2), "v"(pa3), "v"(vb));
        }
        asm volatile("s_waitcnt lgkmcnt(0)" ::: "memory");
        if (j + 2 < NT) STAGE_WAIT1(); else STAGE_WAIT0();
        buf = buf == 2 ? 0 : buf + 1;
    }
#undef STAGE
#undef STAGE_WAIT0
#undef STAGE_WAIT1
    if (active) {
        if (hi == 0) li_l[r32] = l_reg;
        asm volatile("s_waitcnt lgkmcnt(0)" ::: "memory");
        int le = lane; asm volatile("" : "+v"(le));
        const int r32e = le & 31, hie = le >> 5;
        bf16* Owl = Ow + r32e;
#pragma unroll
        for (int r = 0; r < 16; ++r) { const int orow = crow(r, hie); const float rl = __builtin_amdgcn_rcpf(li_l[orow]); bf16* orp = Owl + (size_t)orow * ldo;
#pragma unroll
            for (int d0 = 0; d0 < 4; ++d0) orp[d0 * 32] = f2bf(o[d0][r] * rl); }
    }
    __syncthreads();
}
}

namespace ssd {
constexpr int RSC = 272, RSX = 144;
constexpr int CS = 0, BS = CS + 64 * RSC, XD = BS + 64 * RSC, XW = XD + 64 * RSX, TSET = XW + 64 * RSX, LS = 2 * TSET, HS = LS + 64 * RSX, HSET = 64 * RSC, END = HS + 2 * HSET;
typedef short v4i16_t __attribute__((ext_vector_type(4)));
DI s16x4 vtr(const LAS unsigned char* p) { return __builtin_bit_cast(s16x4, __builtin_amdgcn_ds_read_tr16_b64_v4i16((LAS v4i16_t*)p)); }
DI bf16x8 tr_frag(const LAS unsigned char* tile, int rsb, int jb, int col0, int lane) {
    const int g = lane >> 4, q = (lane & 15) >> 2, pp = lane & 3;
    const LAS unsigned char* a = tile + (jb + 8 * g + q) * rsb + (col0 + 4 * pp) * 2;
    const s16x4 lo = vtr(a), hi = vtr(a + 4 * rsb);
    return (bf16x8){lo[0], lo[1], lo[2], lo[3], hi[0], hi[1], hi[2], hi[3]};
}
DI bf16x8 row_frag(const LAS unsigned char* tile, int rsb, int row, int k0, int lane) {
    return *(const LAS bf16x8*)(tile + row * rsb + (k0 + 8 * (lane >> 4)) * 2);
}
DI float wave_iscan(float v) {
#define SSD_DPP_ADD(ctrl_, rmask_) v += __builtin_bit_cast(float, __builtin_amdgcn_update_dpp(0, __builtin_bit_cast(int, v), (ctrl_), (rmask_), 0xf, false))
    SSD_DPP_ADD(0x111, 0xf); SSD_DPP_ADD(0x112, 0xf); SSD_DPP_ADD(0x114, 0xf); SSD_DPP_ADD(0x118, 0xf);
    SSD_DPP_ADD(0x142, 0xa);
    SSD_DPP_ADD(0x143, 0xc);
#undef SSD_DPP_ADD
    return v;
}
#define MFMA16(a, b, c) __builtin_amdgcn_mfma_f32_16x16x32_bf16((a), (b), (c), 0, 0, 0)

DI void ssd_unit(LAS unsigned char* lds, const bf16* XBC, const float* DT, const bf16* PROJ, bf16* YG, int rb, int NC, int h, float A, float Dsk, const float* h0, float* hout, int tid) {
    const int wid = tid >> 6, lane = tid & 63, l15 = lane & 15, quad = lane >> 4;
    const int g = h >> 2;
    const int pbk = wid & 3, nb0 = 4 * (wid >> 2);
    f32x4 hacc[4];
#pragma unroll
    for (int t = 0; t < 4; ++t) {
        hacc[t] = h0 ? *(const f32x4*)(h0 + (16 * pbk + l15) * 128 + 16 * (nb0 + t) + 4 * quad) : (f32x4){0.f, 0.f, 0.f, 0.f};
        u32x2 w; w.x = pkbf(hacc[t][0], hacc[t][1]); w.y = pkbf(hacc[t][2], hacc[t][3]);
        *(LAS u32x2*)(lds + HS + (16 * pbk + l15) * RSC + (16 * (nb0 + t) + 4 * quad) * 2) = w;
    }
    const int srow = tid >> 3, sc16 = (tid & 7) * 16, sc8 = (tid & 7) * 8;
    u32x4 rC0, rC1, rB0, rB1, rX; float rdt;
#define SSD_LOAD(c_) do { const size_t row_ = (size_t)rb + (size_t)(c_) * 64 + srow; const bf16* xr_ = XBC + row_ * 4096; \
        rX = *(const u32x4*)(xr_ + h * 64 + sc8); rB0 = *(const u32x4*)(xr_ + 2048 + g * 128 + sc16); rB1 = *(const u32x4*)(xr_ + 2048 + g * 128 + sc16 + 8); \
        rC0 = *(const u32x4*)(xr_ + 3072 + g * 128 + sc16); rC1 = *(const u32x4*)(xr_ + 3072 + g * 128 + sc16 + 8); \
        rdt = DT[((size_t)rb + (size_t)(c_) * 64 + lane) * 32 + h]; } while (0)
#define SSD_STAGE(ts_, acn_, atn_) do { acn_ = rdt * A; \
        acn_ = wave_iscan(acn_); \
        atn_ = __builtin_bit_cast(float, __builtin_amdgcn_readlane(__builtin_bit_cast(int, acn_), 63)); const float dtj_ = __shfl(rdt, srow), acj_ = __shfl(acn_, srow), wj_ = __expf(atn_ - acj_); \
        LAS unsigned char* tb_ = lds + (ts_) * TSET; \
        *(LAS u32x4*)(tb_ + CS + srow * RSC + sc16 * 2) = rC0; *(LAS u32x4*)(tb_ + CS + srow * RSC + sc16 * 2 + 16) = rC1; \
        *(LAS u32x4*)(tb_ + BS + srow * RSC + sc16 * 2) = rB0; *(LAS u32x4*)(tb_ + BS + srow * RSC + sc16 * 2 + 16) = rB1; \
        { float f_[8], fw_[8]; unpack8(rX, f_); _Pragma("unroll") for (int j_ = 0; j_ < 8; ++j_) { f_[j_] *= dtj_; fw_[j_] = f_[j_] * wj_; } \
          *(LAS u32x4*)(tb_ + XD + srow * RSX + sc8 * 2) = pack8(f_); *(LAS u32x4*)(tb_ + XW + srow * RSX + sc8 * 2) = pack8(fw_); } } while (0)
    float ac, atot;
    SSD_LOAD(0);
    SSD_STAGE(0, ac, atot);
    if (NC > 1) SSD_LOAD(1);
    __syncthreads();
    const int ib = wid >> 1;
    u32x2 ngx[2], ngz[2];
#define SSD_GLOAD(c_) do { const size_t gr_ = (size_t)rb + (size_t)(c_) * 64 + 16 * ib + l15; _Pragma("unroll") for (int pt = 0; pt < 2; ++pt) { const int p0 = 16 * (2 * (wid & 1) + pt) + 4 * quad; \
        ngx[pt] = *(const u32x2*)(XBC + gr_ * 4096 + h * 64 + p0); ngz[pt] = *(const u32x2*)(PROJ + gr_ * NIN + PC_Z + h * 64 + p0); } } while (0)
    SSD_GLOAD(0);
    for (int c = 0; c < NC; ++c) {
        const int row0 = rb + c * 64, ts = c & 1;
        const LAS unsigned char* T = lds + ts * TSET;
        const LAS unsigned char* Hc = lds + HS + ts * HSET; LAS unsigned char* Hn = lds + HS + (ts ^ 1) * HSET;
        const int i = 16 * ib + l15; const float ac_i = __shfl(ac, i);
        u32x2 gx[2], gz[2];
#pragma unroll
        for (int pt = 0; pt < 2; ++pt) { gx[pt] = ngx[pt]; gz[pt] = ngz[pt]; }
        if (c + 1 < NC) SSD_GLOAD(c + 1);
        bf16x8 cf[4];
#pragma unroll
        for (int s = 0; s < 4; ++s) cf[s] = row_frag(T + CS, RSC, 16 * ib + l15, 32 * s, lane);
#pragma unroll
        for (int jt = 0; jt < 2; ++jt) {
            const int jb = 2 * (wid & 1) + jt; u32x2 w = {0u, 0u};
            if (jb <= ib) {
                f32x4 acc = {0.f, 0.f, 0.f, 0.f};
#pragma unroll
                for (int s = 0; s < 4; ++s) acc = MFMA16(row_frag(T + BS, RSC, 16 * jb + l15, 32 * s, lane), cf[s], acc);
                float v[4];
#pragma unroll
                for (int r = 0; r < 4; ++r) { const int j = 16 * jb + 4 * quad + r; const float ac_j = __shfl(ac, j); v[r] = (j <= i) ? acc[r] * __expf(ac_i - ac_j) : 0.f; }
                w.x = pkbf(v[0], v[1]); w.y = pkbf(v[2], v[3]);
            }
            *(LAS u32x2*)(lds + LS + i * RSX + (16 * jb + 4 * quad) * 2) = w;
        }
        float acn = 0.f, atn = 0.f;
        if (c + 1 < NC) { SSD_STAGE(ts ^ 1, acn, atn); if (c + 2 < NC) SSD_LOAD(c + 2); }
        __syncthreads();
        const float ei = __expf(ac_i);
        bf16x8 lf[2];
#pragma unroll
        for (int s = 0; s < 2; ++s) if (32 * s <= 16 * ib + 15) lf[s] = row_frag(lds + LS, RSX, 16 * ib + l15, 32 * s, lane);
#pragma unroll
        for (int pt = 0; pt < 2; ++pt) {
            const int pb = 2 * (wid & 1) + pt; f32x4 y = {0.f, 0.f, 0.f, 0.f};
#pragma unroll
            for (int s = 0; s < 4; ++s) y = MFMA16(row_frag(Hc, RSC, 16 * pb + l15, 32 * s, lane), cf[s], y);
            y *= ei;
#pragma unroll
            for (int s = 0; s < 2; ++s) if (32 * s <= 16 * ib + 15) y = MFMA16(tr_frag(T + XD, RSX, 32 * s, 16 * pb, lane), lf[s], y);
            const float x0 = bf_lo(gx[pt].x), x1 = bf_hi(gx[pt].x), x2 = bf_lo(gx[pt].y), x3 = bf_hi(gx[pt].y);
            const float z0 = bf_lo(gz[pt].x), z1 = bf_hi(gz[pt].x), z2 = bf_lo(gz[pt].y), z3 = bf_hi(gz[pt].y);
            u32x2 w; w.x = pkbf((y[0] + Dsk * x0) * silu_f(z0), (y[1] + Dsk * x1) * silu_f(z1)); w.y = pkbf((y[2] + Dsk * x2) * silu_f(z2), (y[3] + Dsk * x3) * silu_f(z3));
            *(u32x2*)(YG + (size_t)(row0 + i) * 2048 + h * 64 + 16 * pb + 4 * quad) = w;
        }
        const float et = __expf(atot);
#pragma unroll
        for (int t = 0; t < 4; ++t) hacc[t] *= et;
#pragma unroll
        for (int s = 0; s < 2; ++s) {
            const bf16x8 xf = tr_frag(T + XW, RSX, 32 * s, 16 * pbk, lane);
#pragma unroll
            for (int t = 0; t < 4; ++t) hacc[t] = MFMA16(tr_frag(T + BS, RSC, 32 * s, 16 * (nb0 + t), lane), xf, hacc[t]);
        }
#pragma unroll
        for (int t = 0; t < 4; ++t) { u32x2 w; w.x = pkbf(hacc[t][0], hacc[t][1]); w.y = pkbf(hacc[t][2], hacc[t][3]);
            *(LAS u32x2*)(Hn + (16 * pbk + l15) * RSC + (16 * (nb0 + t) + 4 * quad) * 2) = w; }
        ac = acn; atot = atn;
        __syncthreads();
    }
#undef SSD_LOAD
#undef SSD_STAGE
#undef SSD_GLOAD
#pragma unroll
    for (int t = 0; t < 4; ++t) *(f32x4*)(hout + (16 * pbk + l15) * 128 + 16 * (nb0 + t) + 4 * quad) = hacc[t];
}
}

#ifndef PHMASK
#define PHMASK 0xFFFFFFF
#endif
#define PHON(k) (((PHMASK) >> (k)) & 1)
#ifndef PHREP
#define PHREP 0
#endif
#ifndef PG8_SP2V
#define PG8_SP2V true
#endif
#define NREP(k) (1 + (((PHREP) >> (k)) & 1))
__global__ void __launch_bounds__(512, 2) mk_fwd(Args args) {
    {
        LAS unsigned char* lds0 = (LAS unsigned char*)lds_raw;
        for (int u = threadIdx.x; u < (LDS_BYTES - RING_BYTES) / 4; u += 512) ((LAS unsigned*)(lds0 + RING_BYTES))[u] = 0u;
        __syncthreads();
    }
    const int lo = args.ph_lo, hi = args.ph_hi;
    const bool multi = (hi - lo) > 1;
    unsigned* const barw = (unsigned*)(args.ws + WS_CTL) + CW_BAR;
    XcdBarrier bar; bar.bar = barw; bar.x = 0; bar.st = nullptr;
    if (multi) bar = xcd_barrier_post(barw, (volatile LAS unsigned*)((LAS unsigned char*)lds_raw + MISC_OFF) + 8);
#define IN(k) (lo <= (k) && (k) < hi)
#define SEAM(k) do { if (IN(k) && IN((k) + 1)) xcd_barrier(bar); } while (0)
#define RUN_GEMM(EpiT, Ap, Bp, M_, N_, K_, cid, ...) do { pg8::Gemm g_{(const pg8::bf16_t*)(Ap), (const pg8::bf16_t*)(Bp), M_, N_, K_}; pg8::SplitOrder S_; S_.init(M_, N_, K_, F.G, (cid), EpiT::SPLITK && (K_) >= 8192);     \
        const EpiT E_{__VA_ARGS__}; pg8::gemm_phase<EpiT, pg8::SplitOrder, true, PG8_SP2V>(F.lds, g_, S_, E_); } while (0)
#define SPCNT(k_) ((unsigned*)F.ctl + CW_SPLIT + (l * NPH + (k_)) * 256)
#define SSP(i_) ((float*)F.ctl + CW_SS + (size_t)(i_) * R)

    if (PHON(13) && IN(0)) { const Ctx F = make_ctx(); p_prologue(F); }
    for (int l = 0; l < NLAYER; ++l) {
        const int pb = 1 + NPH * l;
        const bool cv_skip = l > 0 && l + 1 == NLAYER && gridDim.x == 256;
        if (PHON(0) && IN(pb + 0) && !cv_skip) for (int rep_ = 0; rep_ < NREP(0); ++rep_) { if (rep_) xcd_barrier(bar); const Ctx F = make_ctx(); p_convw(F, l); }
        if (!cv_skip) SEAM(pb + 0);
        if (PHON(1) && IN(pb + 1)) for (int rep_ = 0; rep_ < NREP(1); ++rep_) { if (rep_) xcd_barrier(bar);
            { const Ctx F = make_ctx(); unsigned char* ws = F.ws; RUN_GEMM(pg8::EpiScaleBf16, ws + A_XB, ws + W_IN, R, NIN, 4096, F.bid, (pg8::bf16_t*)(ws + A_PROJ), NIN, SSP(3 * l)); }
        }
        SEAM(pb + 1);
        if (PHON(2) && IN(pb + 2)) for (int rep_ = 0; rep_ < NREP(2); ++rep_) { if (rep_) xcd_barrier(bar); const Ctx F = make_ctx(); p_post1(F, l); }
        SEAM(pb + 2);
        if (PHON(3) && IN(pb + 3)) for (int rep_ = 0; rep_ < NREP(3); ++rep_) { if (rep_) xcd_barrier(bar);
            { const Ctx F = make_ctx(); unsigned char* ws = F.ws; RUN_GEMM(pg8::EpiScaleBf16, ws + A_CQN, ws + W_UQ, R, 3072, 1024, F.G - 1 - F.bid, (pg8::bf16_t*)(ws + A_Q), 3072, nullptr); }
            { const Ctx F = make_ctx(); unsigned char* ws = F.ws; RUN_GEMM(pg8::EpiKVNorm, ws + A_CKV, ws + W_UKV, KVROWS, 4096, 512, F.bid, (pg8::bf16_t*)(ws + A_KV), F.in[I_KNN] + l * 128, KVROWS); }
        }
        SEAM(pb + 3);
        if (PHON(5) && IN(pb + 5)) for (int rep_ = 0; rep_ < NREP(5); ++rep_) { if (rep_) xcd_barrier(bar); const int F0g = gridDim.x;
#ifndef NO_SSD
            for (int r2_ = 0; r2_ < NREP(14); ++r2_) {   const Ctx F = make_ctx(); unsigned char* ws = F.ws;
                const bf16* XBC = (const bf16*)(ws + A_XBC); const float* DT = (const float*)(ws + A_DT); const bf16* PROJ = (const bf16*)(ws + A_PROJ); bf16* YG = (bf16*)(ws + A_YG);
                for (int it = F.bid; it < 512; it += F.G) {
                    const int k = it >> 8, u = it & 255, b = u >> 5, h = u & 31;
                    const float A = -__expf(F.in[I_ALOG][l * 32 + h]), Dsk = F.in[I_DSKIP][l * 32 + h];
                    const size_t so = ((size_t)(l * 8 + b) * 32 + h) * 8192;
                    ssd::ssd_unit(F.lds, XBC, DT, PROJ, YG, k ? RP + b * DSEQ : b * SEQ, k ? 1 : SEQ / 64, h, A, Dsk, k ? F.in[I_SSSM] + so : nullptr, F.out + (k ? O_SSM_S : O_SSM_P) + so, F.tid);
                }
            }
#endif
#ifndef NO_ATT
            for (int r2_ = 0; r2_ < NREP(15); ++r2_) {   const Ctx F = make_ctx(); unsigned char* ws = F.ws;
                const bf16* Q = (const bf16*)(ws + A_Q); const bf16* KV = (const bf16*)(ws + A_KV); const bf16* KPE = (const bf16*)(ws + A_KPE); bf16* MIX = (bf16*)(ws + A_MIX);
                const float* ctab = (const float*)(ws + WS_ROPE); const float* stab = ctab + KVS * 32;
                const float* qnn = F.in[I_QNN] + l * 128; const float* qnp = F.in[I_QNP] + l * 64;
                const float scale = 0.07216878364870322f;
                const int wid = F.wave, r32 = F.lane & 31;
                for (int it = F.bid; it < 1280; it += F.G) {
                    const int slot = it >> 8, w = it & 255, xcd = w & 7, r = w >> 3, g = r >> 2, k = r & 3;
                    const bool smp = slot == 4;
                    if (smp && k >= 2) continue;
                    const int bh = (xcd * 8 + g) * 2 + (smp ? k : (slot >> 1));
                    const int qb = (slot & 1) ? k : 7 - k;
                    const int b = bh >> 4, h = bh & 15;
                    const bool act = smp ? wid < 2 : true; const int wo = act ? wid * 32 : 0;
                    const int row0 = smp ? RP + b * DSEQ : b * SEQ + qb * 256; const size_t kr0 = smp ? (size_t)RP + (size_t)b * KVS : (size_t)b * SEQ;
                    const int NT = smp ? KVS / 64 : 4 * qb + 4, wnt = smp ? KVS / 64 : 4 * qb + (wid >> 1) + 1, pos = (smp ? PAST : qb * 256) + wid * 32 + r32;
#if defined(PROBE_ATT_ABL)
                    if (r2_) att::attn_unit<64, PROBE_ATT_ABL>(F.lds, Q + (size_t)(row0 + wo + (act ? r32 : 0)) * 3072 + h * 192, KV + ((size_t)h * KVROWS + kr0) * 256, 256, KPE + kr0 * 64,
                                       KV + ((size_t)h * KVROWS + kr0) * 256 + 128, 256, (bf16*)(ws + A_CQN) + (size_t)wo * 128, 128, NT, wnt, act, scale, qnn, qnp, ctab, stab, pos, F.tid); else
#endif
                    att::attn_unit<64>(F.lds, Q + (size_t)(row0 + wo + (act ? r32 : 0)) * 3072 + h * 192, KV + ((size_t)h * KVROWS + kr0) * 256, 256, KPE + kr0 * 64,
                                       KV + ((size_t)h * KVROWS + kr0) * 256 + 128, 256, MIX + (size_t)(row0 + wo) * 4096 + h * 128, 4096, NT, wnt, act, scale, qnn, qnp, ctab, stab, pos, F.tid);
                }
            }
#endif
            if (rep_ == 0 && F0g == 256 && ((blockIdx.x >> 3) & 3) >= 2) { __syncthreads();     const Ctx F3 = make_ctx(); const int rk = ((F3.bid >> 5) << 4) | ((((F3.bid >> 3) & 3) - 2) << 3) | (F3.bid & 7);
                p_convw_range(F3, l, CV_A0, CV_E3 - CV_A0, l, 0, 0, 0, 128, 8, rk); }
        }
        SEAM(pb + 5);
        if (PHON(6) && IN(pb + 6)) for (int rep_ = 0; rep_ < NREP(6); ++rep_) { if (rep_) xcd_barrier(bar); const Ctx F = make_ctx(); p_gnorm(F, l); }
        SEAM(pb + 6);
        if (PHON(7) && IN(pb + 7)) for (int rep_ = 0; rep_ < NREP(7); ++rep_) { if (rep_) xcd_barrier(bar); const Ctx F = make_ctx(); unsigned char* ws = F.ws;
#if defined(PROBE_NULLEPI)
            if (rep_) RUN_GEMM(pg8::EpiNull, ws + A_MIX, ws + W_O, R, 4096, 4096, F.bid); else
#endif
            RUN_GEMM(pg8::EpiResid, ws + A_MIX, ws + W_O, R, 4096, 4096, F.bid, (float*)nullptr, (pg8::bf16_t*)(ws + A_XB), SSP(3 * l + 1), SPCNT(7), ws + A_KV);
            if (F.G == 256 && F.bid >= 32) { const Ctx F3 = make_ctx(); p_convw_range(F3, l, CV_GU0, CV_GU1 - CV_GU0, l, 0, 0, 32, 224, CV_TAILW); } }
        SEAM(pb + 7);
        if (PHON(8) && IN(pb + 8)) for (int rep_ = 0; rep_ < NREP(8); ++rep_) { if (rep_) xcd_barrier(bar); const Ctx F = make_ctx(); unsigned char* ws = F.ws; RUN_GEMM(pg8::EpiScaleBf16, ws + A_XB, ws + W_XQ, R, 512, 4096, F.bid, (pg8::bf16_t*)(ws + A_XQ), 512, SSP(3 * l + 1));
            { const Ctx F2 = make_ctx(); unsigned char* ws2 = F2.ws; pg8::Gemm g2{(const pg8::bf16_t*)(ws2 + A_MB), (const pg8::bf16_t*)(ws2 + W_XKV), 2048, 1024, 4096}; pg8::SplitOrder S2; S2.init(2048, 1024, 4096, F2.G, (F2.bid + F2.G - 132) % F2.G, false);
              const pg8::EpiMemKV E2{(const float*)F2.ctl + CW_SSM, F2.in[I_XNK] + l * 128, F2.out + O_MK_P + (size_t)l * 2048 * 512, F2.out + O_MV_P + (size_t)l * 2048 * 512, (pg8::bf16_t*)(ws2 + A_MEMK), (pg8::bf16_t*)(ws2 + A_MEMV)};
              pg8::gemm_phase<pg8::EpiMemKV, pg8::SplitOrder, true, true>(F2.lds, g2, S2, E2); }
            if (F.G == 256 && F.bid >= 164) { const Ctx F3 = make_ctx(); p_convw_range(F3, l, CV_GU1, CV_GU3 - CV_GU1, l, 0, 0, 164, 92, CV_TAILW); } }
        SEAM(pb + 8);
        if (PHON(9) && IN(pb + 9)) for (int rep_ = 0; rep_ < NREP(9); ++rep_) { if (rep_) xcd_barrier(bar);
            const Ctx F = make_ctx(); unsigned char* ws = F.ws;
            const bf16* XQ = (const bf16*)(ws + A_XQ); const bf16* MEMK = (const bf16*)(ws + A_MEMK); const bf16* MEMV = (const bf16*)(ws + A_MEMV); bf16* XO = (bf16*)(ws + A_XO);
            const float* xnq = F.in[I_XNQ] + l * 128; const float scale = 0.08838834764831845f;
            const int wid = F.wave, r32 = F.lane & 31;
            for (int it = F.bid; it < 512; it += F.G) {
                if (it >= 288) continue;
                const bool smp = it >= 256; const int u = it & 255;
                const int b = smp ? u >> 2 : u >> 5, h = smp ? u & 3 : (u >> 3) & 3, qb = u & 7;
                const bool act = smp ? wid < 2 : true; const int wo = act ? wid * 32 : 0;
                const int row0 = smp ? RP + b * DSEQ : b * SEQ + qb * 256; const size_t mr0 = (size_t)(smp ? 2048 : 0) + (size_t)b * NMEM;
                att::attn_unit<0>(F.lds, XQ + (size_t)(row0 + wo + (act ? r32 : 0)) * 512 + h * 128, MEMK + mr0 * 512 + h * 128, 512, nullptr,
                                  MEMV + mr0 * 512 + h * 128, 512, XO + (size_t)(row0 + wo) * 512 + h * 128, 512, 4, 4, act, scale, xnq, nullptr, nullptr, nullptr, 0, F.tid);
            }
        }
        SEAM(pb + 9);
        if (PHON(10) && IN(pb + 10)) for (int rep_ = 0; rep_ < NREP(10); ++rep_) { if (rep_) xcd_barrier(bar); const Ctx F = make_ctx(); unsigned char* ws = F.ws; RUN_GEMM(pg8::EpiResid, ws + A_XO, ws + W_XO, R, 4096, 512, F.bid, (float*)nullptr, (pg8::bf16_t*)(ws + A_XB), SSP(3 * l + 2), SPCNT(10), ws + A_KV);
            if (F.G == 256 && F.bid >= 32) { const Ctx F3 = make_ctx(); p_convw_range(F3, l, CV_GU3, CV_DX, l, 0, 0, 32, 224, CV_TAILW); } }
        SEAM(pb + 10);
        if (PHON(11) && IN(pb + 11)) for (int rep_ = 0; rep_ < NREP(11); ++rep_) { if (rep_) xcd_barrier(bar); const Ctx F = make_ctx(); unsigned char* ws = F.ws;
#if defined(PROBE_NULLEPI)
            if (rep_) RUN_GEMM(pg8::EpiNull, ws + A_XB, ws + ((l & 1) ? A_WGU2 : W_GU), R, 22016, 4096, F.bid); else
#endif
            RUN_GEMM(pg8::EpiGU, ws + A_XB, ws + ((l & 1) ? A_WGU2 : W_GU), R, 22016, 4096, F.bid, (pg8::bf16_t*)(ws + A_H), SSP(3 * l + 2), SPCNT(11), ws + A_KV);
            if (F.G == 256 && F.bid >= 44) { const Ctx F3 = make_ctx(); const bool more = l + 1 < NLAYER; p_convw_range(F3, l + 1, 0, more ? CV_A0 : 0, l, CV_GU3 + CV_DX, more ? CV_DG : CV_NITEMS - CV_GU3 - CV_DX, 44, 212, CV_TAILW); } }
        SEAM(pb + 11);
        if (PHON(12) && IN(pb + 12)) for (int rep_ = 0; rep_ < NREP(12); ++rep_) { if (rep_) xcd_barrier(bar); const Ctx F = make_ctx(); unsigned char* ws = F.ws; const bool more = l + 1 < NLAYER;
#if defined(PROBE_NULLEPI)
            if (rep_) RUN_GEMM(pg8::EpiNull, ws + A_H, ws + W_DN, R, 4096, DFF, F.bid); else
#endif
            RUN_GEMM(pg8::EpiResid, ws + A_H, ws + W_DN, R, 4096, DFF, F.bid, more ? (float*)nullptr : F.out + O_Y, (pg8::bf16_t*)(ws + A_XB), SSP(3 * l + 3), SPCNT(12), ws + A_KV); }
        SEAM(pb + 12);
    }
#undef IN
#undef SEAM
#undef RUN_GEMM
#undef SSP
#undef SPCNT
}

#ifndef MK_SPLIT
#define MK_SPLIT 0
#endif
extern "C" void kernel_launch(void* const* d_in, const int* in_sizes, int n_in, void* d_out, int out_size, void* d_ws, size_t ws_size, hipStream_t stream) {
    static int grid = 0;
    if (grid == 0) {
        if (n_in != 38 || out_size < (int)O_END || ws_size < WS_NEED) { fprintf(stderr, "kernel_launch: n_in %d out %d ws %zu (need 38, %zu, >= %zu): nothing launched\n", n_in, out_size, ws_size, (size_t)O_END, (size_t)WS_NEED); grid = -1; return; }
        int dev = 0, cus = 0, per_cu = 0;
        if (hipGetDevice(&dev) != hipSuccess || hipDeviceGetAttribute(&cus, hipDeviceAttributeMultiprocessorCount, dev) != hipSuccess) { grid = -1; return; }
        if (hipFuncSetAttribute((const void*)mk_fwd, hipFuncAttributeMaxDynamicSharedMemorySize, LDS_BYTES) != hipSuccess) { fprintf(stderr, "kernel_launch: hipFuncSetAttribute failed\n"); grid = -1; return; }
        if (hipOccupancyMaxActiveBlocksPerMultiprocessor(&per_cu, (const void*)mk_fwd, 512, LDS_BYTES) != hipSuccess || per_cu < 1) fprintf(stderr, "kernel_launch: occupancy query says %d\n", per_cu);
        (void)hipGetLastError();
        grid = cus;
    }
    if (grid < 0) return;
    if (hipMemsetAsync((char*)d_ws + WS_CTL, 0, CTL_ZERO_BYTES, stream) != hipSuccess) return;
    Args a{};
    for (int i = 0; i < 38; ++i) a.in[i] = (const float*)d_in[i];
    a.out = (float*)d_out; a.ws = (unsigned char*)d_ws;
    constexpr int NPHASE = 1 + NLAYER * NPH;
#if MK_SPLIT
    for (int p = 0; p < NPHASE; ++p) { a.ph_lo = p; a.ph_hi = p + 1; hipLaunchKernelGGL(mk_fwd, dim3(grid), dim3(512), LDS_BYTES, stream, a); }
#else
    a.ph_lo = 0; a.ph_hi = NPHASE; hipLaunchKernelGGL(mk_fwd, dim3(grid), dim3(512), LDS_BYTES, stream, a);
#endif
    const hipError_t le = hipPeekAtLastError();
    if (le != hipSuccess) fprintf(stderr, "kernel_launch: launch failed: %s\n", hipGetErrorName(le));
}
```

```cpp
#include <hip/hip_runtime.h>
#include <cstdio>
#include <cstdint>

#define LAS __attribute__((address_space(3)))
#define GAS __attribute__((address_space(1)))
#define DI __device__ __forceinline__

namespace pg8 {
#define PG8_LAS __attribute__((address_space(3)))
typedef unsigned short bf16_t;
typedef short bf16x8 __attribute__((ext_vector_type(8)));
typedef float f32x4 __attribute__((ext_vector_type(4)));
typedef unsigned u32x4 __attribute__((ext_vector_type(4)));
constexpr int BM = 256, BK = 64, HALF = 128, HTB = HALF * BK * 2  , STAGE_BYTES = 8 * HTB, NXCD = 8, WGM = 8;

__host__ __device__ __forceinline__ int lds_byte(int r, int c) { const int st = (r >> 4) * 2 + (c >> 5), rr = r & 15, cc = c & 31, ob = rr * 64 + cc * 2; return st * 1024 + (ob ^ (((ob >> 9) & 1) << 5)); }
__host__ __device__ __forceinline__ void stage_rc(int b, int& R, int& C) { const int st = b / 1024, sb = b % 1024, swz = sb ^ (((sb >> 9) & 1) << 5); R = (st >> 1) * 16 + swz / 64; C = (st & 1) * 32 + (swz % 64) / 2; }
__host__ __device__ __forceinline__ int perm32(int rho) { const int n = rho >> 4, i = rho & 15; return 8 * (i >> 2) + 4 * n + (i & 3); }

struct Unit { int pm, pn, kt0, nt, split, np, part; };
struct Gemm { const bf16_t* A; const bf16_t* Bt; int M, N, K; };

struct StaticOrder {
    int nM, nN, nwg, G, c;
    __host__ __device__ void init(int M, int N, int G_, int c_) { nM = M / BM; nN = N / BM; nwg = nM * nN; G = G_; c = c_; }
    __host__ __device__ bool next(int i, Unit& u) const {
        const long L = (long)i * G + c; if (L >= nwg) return false;
        int wgid = (int)L; { const int q = nwg / NXCD, r = nwg % NXCD, xcd = wgid % NXCD, off = wgid / NXCD; wgid = (xcd < r ? xcd * (q + 1) : r * (q + 1) + (xcd - r) * q) + off; }
        const int nig = WGM * nN, gid = wgid / nig, fm = gid * WGM, gsz = (nM - fm) < WGM ? (nM - fm) : WGM;
        u.pm = fm + ((wgid % nig) % gsz); u.pn = (wgid % nig) / gsz; u.kt0 = 0; u.nt = 0; u.split = -1; u.np = 1; u.part = 0; return true;
    }
    __device__ __forceinline__ void a_ready(const Unit&) const {}
    __device__ __forceinline__ void done(const Unit&) const {}
};

__device__ __forceinline__ unsigned cvt_pk_bf16(float lo, float hi) { unsigned r; asm volatile("v_cvt_pk_bf16_f32 %0, %1, %2" : "=v"(r) : "v"(lo), "v"(hi)); return r; }

struct SplitOrder {
    int nM, nN, nwg, G, c, F, Rm, P, ntot, nbase, nextra;
    __device__ __forceinline__ void init(int M, int N, int K, int G_, int c_, bool allow_split) {
        nM = M / BM; nN = N / BM; nwg = nM * nN; G = G_; c = c_; ntot = K / BK; F = nwg / G; Rm = nwg - F * G; P = 1;
        if (allow_split && Rm > 0 && F > 0 && Rm <= 128) {     int p = G / Rm; if (p > 8) p = 8; const int pk = ntot / 4; if (p > pk) p = pk; if (p >= 2) P = p; }
        nbase = (ntot / P) & ~1; nextra = (ntot - nbase * P) / 2;
    }
    __device__ __forceinline__ void map(int L, Unit& u) const {
        int wgid = L; { const int q = nwg / NXCD, r = nwg % NXCD, xcd = wgid % NXCD, off = wgid / NXCD; wgid = (xcd < r ? xcd * (q + 1) : r * (q + 1) + (xcd - r) * q) + off; }
        const int nig = WGM * nN, gid = wgid / nig, fm = gid * WGM, gsz = (nM - fm) < WGM ? (nM - fm) : WGM;
        u.pm = fm + ((wgid % nig) % gsz); u.pn = (wgid % nig) / gsz;
    }
    __device__ __forceinline__ bool next(int i, Unit& u) const {
        if (P == 1) { const long L = (long)i * G + c; if (L >= nwg) return false; map((int)L, u); u.kt0 = 0; u.nt = ntot; u.split = -1; u.np = 1; u.part = 0; return true; }
        const bool has_part = c < Rm * P;
        if (i > 0 || !has_part) { const int ii = has_part ? i - 1 : i; if (ii >= F) return false; map(ii * G + c, u); u.kt0 = 0; u.nt = ntot; u.split = -1; u.np = 1; u.part = 0; return true; }
        const int s = c / P, part = c - s * P; map(F * G + s, u);
        u.kt0 = part * nbase + 2 * (part < nextra ? part : nextra); u.nt = nbase + (part < nextra ? 2 : 0); u.split = s; u.np = P; u.part = part; return true;
    }
    __device__ __forceinline__ void a_ready(const Unit&) const {}
    __device__ __forceinline__ void done(const Unit&) const {}
};

constexpr float RMS_EPS = 1e-6f;
typedef float f32x2v __attribute__((ext_vector_type(2)));
typedef __bf16 bf16x2v __attribute__((ext_vector_type(2)));
__device__ __forceinline__ unsigned pkbf(float lo, float hi) { f32x2v v = {lo, hi}; bf16x2v b = __builtin_convertvector(v, bf16x2v); return __builtin_bit_cast(unsigned, b); }

struct EpiScaleBf16 {
    static constexpr bool PERM = true, AFTER_DRAIN = false, SPLITK = false, USES_LDS = false;
    bf16_t* O; int ldc; const float* ss;
    __device__ __forceinline__ void operator()(const f32x4 (&acc)[2][2][4][2], const Unit& u, int wr, int wc, int fr, int fq) const {
        const int row0 = u.pm * BM + wr * 64 + fr, col0 = u.pn * BM + wc * 32 + 8 * fq;
#pragma unroll
        for (int ai = 0; ai < 2; ++ai)
#pragma unroll
            for (int m = 0; m < 4; ++m) {
                const int r = row0 + ai * HALF + m * 16;
                const float s = ss ? __builtin_amdgcn_rsqf(ss[r] * (1.0f / 4096.0f) + RMS_EPS) : 1.0f;
                bf16_t* rowp = O + (size_t)r * ldc + col0;
#pragma unroll
                for (int bj = 0; bj < 2; ++bj) { const f32x4 v0 = acc[ai][bj][m][0] * s, v1 = acc[ai][bj][m][1] * s;
                    u32x4 w; w.x = pkbf(v0[0], v0[1]); w.y = pkbf(v0[2], v0[3]); w.z = pkbf(v1[0], v1[1]); w.w = pkbf(v1[2], v1[3]);
                    *(u32x4*)(rowp + bj * HALF) = w; } }
    }
};
struct EpiScaleF32 {
    static constexpr bool PERM = true, AFTER_DRAIN = false, SPLITK = false, USES_LDS = false;
    float* O; int ldc; const float* ss;
    __device__ __forceinline__ void operator()(const f32x4 (&acc)[2][2][4][2], const Unit& u, int wr, int wc, int fr, int fq) const {
        const int row0 = u.pm * BM + wr * 64 + fr, col0 = u.pn * BM + wc * 32 + 8 * fq;
#pragma unroll
        for (int ai = 0; ai < 2; ++ai)
#pragma unroll
            for (int m = 0; m < 4; ++m) {
                const int r = row0 + ai * HALF + m * 16;
                const float s = ss ? __builtin_amdgcn_rsqf(ss[r] * (1.0f / 4096.0f) + RMS_EPS) : 1.0f;
                float* rowp = O + (size_t)r * ldc + col0;
#pragma unroll
                for (int bj = 0; bj < 2; ++bj) { *(f32x4*)(rowp + bj * HALF) = acc[ai][bj][m][0] * s; *(f32x4*)(rowp + bj * HALF + 4) = acc[ai][bj][m][1] * s; } }
    }
};
struct EpiResid {
    static constexpr bool PERM = true, AFTER_DRAIN = false, SPLITK = true, USES_LDS = false;
    float* Y; bf16_t* XB; float* ssq; unsigned* cnt; unsigned char* slab;
    __device__ __forceinline__ void operator()(const f32x4 (&acc)[2][2][4][2], const Unit& u, int wr, int wc, int fr, int fq) const {
        const int row0 = u.pm * BM + wr * 64 + fr, col0 = u.pn * BM + wc * 32 + 8 * fq;
#pragma unroll
        for (int ai = 0; ai < 2; ++ai)
#pragma unroll
            for (int m = 0; m < 4; ++m) {
                const int r = row0 + ai * HALF + m * 16;
                bf16_t* xp = XB + (size_t)r * 4096 + col0; float sq = 0.f;
                const u32x4 o0 = *(const u32x4*)xp, o1 = *(const u32x4*)(xp + HALF);
#pragma unroll
                for (int bj = 0; bj < 2; ++bj) {
                    const u32x4 o = bj ? o1 : o0;
                    f32x4 a = {__uint_as_float(o.x << 16), __uint_as_float(o.x & 0xffff0000u), __uint_as_float(o.y << 16), __uint_as_float(o.y & 0xffff0000u)};
                    f32x4 b = {__uint_as_float(o.z << 16), __uint_as_float(o.z & 0xffff0000u), __uint_as_float(o.w << 16), __uint_as_float(o.w & 0xffff0000u)};
                    a += acc[ai][bj][m][0]; b += acc[ai][bj][m][1];
                    if (Y) { float* yp = Y + (size_t)r * 4096 + col0 + bj * HALF; *(f32x4*)yp = a; *(f32x4*)(yp + 4) = b; }
                    else {
                        sq += (a[0] * a[0] + a[1] * a[1]) + (a[2] * a[2] + a[3] * a[3]) + (b[0] * b[0] + b[1] * b[1]) + (b[2] * b[2] + b[3] * b[3]);
                        u32x4 w; w.x = pkbf(a[0], a[1]); w.y = pkbf(a[2], a[3]); w.z = pkbf(b[0], b[1]); w.w = pkbf(b[2], b[3]);
                        *(u32x4*)(xp + bj * HALF) = w; } }
                if (!Y) { sq += __shfl_xor(sq, 16); sq += __shfl_xor(sq, 32); if (fq == 0) unsafeAtomicAdd(ssq + r, sq); }
            }
    }
    __device__ __forceinline__ void partial(const f32x4 (&acc)[2][2][4][2], const Unit& u, int wr, int wc, int fr, int fq, PG8_LAS unsigned char* lds, int tid) const {
        const int wid = __builtin_amdgcn_readfirstlane(tid >> 6), lane = tid & 63;
        unsigned char* tile_slabs = slab + (size_t)u.split * 8 * 262144;
        const int myp = u.part;
        { __amdgpu_buffer_rsrc_t rs = __builtin_amdgcn_make_buffer_rsrc((void*)(tile_slabs + (size_t)myp * 262144), (short)0, 262144, 0x00020000);
#pragma unroll
          for (int ai = 0; ai < 2; ++ai)
#pragma unroll
            for (int bj = 0; bj < 2; ++bj)
#pragma unroll
                for (int m = 0; m < 4; ++m)
#pragma unroll
                    for (int n = 0; n < 2; ++n) { const int k = ((ai * 2 + bj) * 4 + m) * 2 + n;
                        __builtin_amdgcn_raw_buffer_store_b128(__builtin_bit_cast(u32x4, acc[ai][bj][m][n]), rs, ((wid * 32 + k) * 64 + lane) * 16, 0, 16); } }
        asm volatile("s_waitcnt vmcnt(0)" ::: "memory");
        __builtin_amdgcn_s_barrier();
        PG8_LAS unsigned* bw = (PG8_LAS unsigned*)(lds + 131072 + 320 + 64);
        if (tid == 0) { const unsigned old = __hip_atomic_fetch_add(cnt + u.split, 1u, __ATOMIC_RELAXED, __HIP_MEMORY_SCOPE_AGENT); *bw = old; }
        asm volatile("s_waitcnt vmcnt(0) lgkmcnt(0)" ::: "memory");
        __builtin_amdgcn_s_barrier();
        const unsigned old = *bw;
        asm volatile("s_waitcnt lgkmcnt(0)" ::: "memory");
        if (old == (unsigned)(u.np - 1)) {
            f32x4 z[2][2][4][2];
#pragma unroll
            for (int a = 0; a < 2; ++a)
#pragma unroll
                for (int b = 0; b < 2; ++b)
#pragma unroll
                    for (int m = 0; m < 4; ++m)
#pragma unroll
                        for (int n = 0; n < 2; ++n) z[a][b][m][n] = (f32x4){0.f, 0.f, 0.f, 0.f};
            for (int p = 0; p < u.np; ++p) {
                __amdgpu_buffer_rsrc_t rs = __builtin_amdgcn_make_buffer_rsrc((void*)(tile_slabs + (size_t)p * 262144), (short)0, 262144, 0x00020000);
#pragma unroll
                for (int ai = 0; ai < 2; ++ai)
#pragma unroll
                    for (int bj = 0; bj < 2; ++bj)
#pragma unroll
                        for (int m = 0; m < 4; ++m)
#pragma unroll
                            for (int n = 0; n < 2; ++n) { const int k = ((ai * 2 + bj) * 4 + m) * 2 + n;
                                z[ai][bj][m][n] += __builtin_bit_cast(f32x4, __builtin_amdgcn_raw_buffer_load_b128(rs, ((wid * 32 + k) * 64 + lane) * 16, 0, 16)); }
            }
            (*this)(z, u, wr, wc, fr, fq);
        }
    }
};
struct EpiGU {
    static constexpr bool PERM = true, AFTER_DRAIN = false, SPLITK = false, USES_LDS = false;
    bf16_t* H; const float* ss; unsigned* cnt; unsigned char* slab;
    __device__ __forceinline__ void operator()(const f32x4 (&acc)[2][2][4][2], const Unit& u, int wr, int wc, int fr, int fq) const {
        const int row0 = u.pm * BM + wr * 64 + fr, col0 = u.pn * HALF + wc * 32 + 8 * fq;
#pragma unroll
        for (int ai = 0; ai < 2; ++ai)
#pragma unroll
            for (int m = 0; m < 4; ++m) {
                const int r = row0 + ai * HALF + m * 16;
                const float s = __builtin_amdgcn_rsqf(ss[r] * (1.0f / 4096.0f) + RMS_EPS);
                float hv[8];
#pragma unroll
                for (int n = 0; n < 2; ++n)
#pragma unroll
                    for (int j = 0; j < 4; ++j) { const float g = acc[ai][0][m][n][j] * s, up = acc[ai][1][m][n][j] * s;
                        hv[n * 4 + j] = g * __builtin_amdgcn_rcpf(1.0f + __builtin_amdgcn_exp2f(-1.4426950408889634f * g)) * up; }
                u32x4 w; w.x = pkbf(hv[0], hv[1]); w.y = pkbf(hv[2], hv[3]); w.z = pkbf(hv[4], hv[5]); w.w = pkbf(hv[6], hv[7]);
                *(u32x4*)(H + (size_t)r * 11008 + col0) = w; }
    }
    __device__ __forceinline__ void partial(const f32x4 (&acc)[2][2][4][2], const Unit& u, int wr, int wc, int fr, int fq, PG8_LAS unsigned char* lds, int tid) const {
        const int wid = __builtin_amdgcn_readfirstlane(tid >> 6), lane = tid & 63;
        unsigned char* tile_slabs = slab + (size_t)u.split * 8 * 262144;
        const int myp = u.part;
        { __amdgpu_buffer_rsrc_t rs = __builtin_amdgcn_make_buffer_rsrc((void*)(tile_slabs + (size_t)myp * 262144), (short)0, 262144, 0x00020000);
#pragma unroll
          for (int ai = 0; ai < 2; ++ai)
#pragma unroll
            for (int bj = 0; bj < 2; ++bj)
#pragma unroll
                for (int m = 0; m < 4; ++m)
#pragma unroll
                    for (int n = 0; n < 2; ++n) { const int k = ((ai * 2 + bj) * 4 + m) * 2 + n;
                        __builtin_amdgcn_raw_buffer_store_b128(__builtin_bit_cast(u32x4, acc[ai][bj][m][n]), rs, ((wid * 32 + k) * 64 + lane) * 16, 0, 16); } }
        asm volatile("s_waitcnt vmcnt(0)" ::: "memory");
        __builtin_amdgcn_s_barrier();
        PG8_LAS unsigned* bw = (PG8_LAS unsigned*)(lds + 131072 + 320 + 64);
        if (tid == 0) { const unsigned old = __hip_atomic_fetch_add(cnt + u.split, 1u, __ATOMIC_RELAXED, __HIP_MEMORY_SCOPE_AGENT); *bw = old; }
        asm volatile("s_waitcnt vmcnt(0) lgkmcnt(0)" ::: "memory");
        __builtin_amdgcn_s_barrier();
        const unsigned old = *bw;
        asm volatile("s_waitcnt lgkmcnt(0)" ::: "memory");
        if (old == (unsigned)(u.np - 1)) {
            f32x4 z[2][2][4][2];
#pragma unroll
            for (int a = 0; a < 2; ++a)
#pragma unroll
                for (int b = 0; b < 2; ++b)
#pragma unroll
                    for (int m = 0; m < 4; ++m)
#pragma unroll
                        for (int n = 0; n < 2; ++n) z[a][b][m][n] = (f32x4){0.f, 0.f, 0.f, 0.f};
            for (int p = 0; p < u.np; ++p) {
                __amdgpu_buffer_rsrc_t rs = __builtin_amdgcn_make_buffer_rsrc((void*)(tile_slabs + (size_t)p * 262144), (short)0, 262144, 0x00020000);
#pragma unroll
                for (int ai = 0; ai < 2; ++ai)
#pragma unroll
                    for (int bj = 0; bj < 2; ++bj)
#pragma unroll
                        for (int m = 0; m < 4; ++m)
#pragma unroll
                            for (int n = 0; n < 2; ++n) { const int k = ((ai * 2 + bj) * 4 + m) * 2 + n;
                                z[ai][bj][m][n] += __builtin_bit_cast(f32x4, __builtin_amdgcn_raw_buffer_load_b128(rs, ((wid * 32 + k) * 64 + lane) * 16, 0, 16)); }
            }
            (*this)(z, u, wr, wc, fr, fq);
        }
    }
};

struct EpiKVNorm {
    static constexpr bool PERM = true, AFTER_DRAIN = false, SPLITK = false, USES_LDS = true;
    bf16_t* O; const float* gain; int Mrows;
    __device__ __forceinline__ void operator()(const f32x4 (&acc)[2][2][4][2], const Unit& u, int wr, int wc, int fr, int fq) const {}
    __device__ __forceinline__ void with_lds(const f32x4 (&acc)[2][2][4][2], const Unit& u, int wr, int wc, int fr, int fq, PG8_LAS unsigned char* lds) const {
        PG8_LAS float* part = (PG8_LAS float*)(lds + 131072 + 1024);
        const int rb = wr * 64 + fr;
#pragma unroll
        for (int ai = 0; ai < 2; ++ai)
#pragma unroll
            for (int m = 0; m < 4; ++m) { const f32x4 a = acc[ai][0][m][0], b = acc[ai][0][m][1];
                float s = (a[0] * a[0] + a[1] * a[1]) + (a[2] * a[2] + a[3] * a[3]) + (b[0] * b[0] + b[1] * b[1]) + (b[2] * b[2] + b[3] * b[3]);
                s += __shfl_xor(s, 16); s += __shfl_xor(s, 32);
                if (fq == 0) part[(ai * HALF + rb + m * 16) * 4 + wc] = s; }
        asm volatile("s_waitcnt lgkmcnt(0)" ::: "memory"); __builtin_amdgcn_s_barrier(); asm volatile("" ::: "memory");
        const int cl = wc * 32 + 8 * fq; const f32x4 g0 = *(const f32x4*)(gain + cl), g1 = *(const f32x4*)(gain + cl + 4);
        const int row0 = u.pm * BM + rb;
#pragma unroll
        for (int ai = 0; ai < 2; ++ai)
#pragma unroll
            for (int m = 0; m < 4; ++m) {
                const f32x4 p = *(const PG8_LAS f32x4*)(part + (ai * HALF + rb + m * 16) * 4);
                const float rs = __builtin_amdgcn_rsqf(((p[0] + p[1]) + (p[2] + p[3])) * (1.0f / 128.0f) + RMS_EPS);
                bf16_t* rowp = O + ((size_t)u.pn * Mrows + (size_t)(row0 + ai * HALF + m * 16)) * 256 + cl;
                const f32x4 k0 = acc[ai][0][m][0] * rs * g0, k1 = acc[ai][0][m][1] * rs * g1, v0 = acc[ai][1][m][0], v1 = acc[ai][1][m][1];
                u32x4 w; w.x = pkbf(k0[0], k0[1]); w.y = pkbf(k0[2], k0[3]); w.z = pkbf(k1[0], k1[1]); w.w = pkbf(k1[2], k1[3]);
                *(u32x4*)rowp = w;
                w.x = pkbf(v0[0], v0[1]); w.y = pkbf(v0[2], v0[3]); w.z = pkbf(v1[0], v1[1]); w.w = pkbf(v1[2], v1[3]);
                *(u32x4*)(rowp + HALF) = w; }
    }
};

struct EpiMemKV {
    static constexpr bool PERM = true, AFTER_DRAIN = false, SPLITK = false, USES_LDS = true;
    const float* ssm; const float* gain; float* outK; float* outV; bf16_t* MK; bf16_t* MV;
    __device__ __forceinline__ void operator()(const f32x4 (&acc)[2][2][4][2], const Unit& u, int wr, int wc, int fr, int fq) const {}
    __device__ __forceinline__ void with_lds(const f32x4 (&acc)[2][2][4][2], const Unit& u, int wr, int wc, int fr, int fq, PG8_LAS unsigned char* lds) const {
        PG8_LAS float* part = (PG8_LAS float*)(lds + 131072 + 1024);
        const int rb = wr * 64 + fr, cl = wc * 32 + 8 * fq; const bool isk = u.pn < 2;
        float sr[2][4];
#pragma unroll
        for (int ai = 0; ai < 2; ++ai)
#pragma unroll
            for (int m = 0; m < 4; ++m) sr[ai][m] = __builtin_amdgcn_rsqf(ssm[u.pm * BM + ai * HALF + rb + m * 16] * (1.0f / 4096.0f) + RMS_EPS);
        if (isk) {
#pragma unroll
            for (int ai = 0; ai < 2; ++ai)
#pragma unroll
                for (int m = 0; m < 4; ++m)
#pragma unroll
                    for (int bj = 0; bj < 2; ++bj) { const f32x4 a = acc[ai][bj][m][0], b = acc[ai][bj][m][1];
                        float s = (a[0] * a[0] + a[1] * a[1]) + (a[2] * a[2] + a[3] * a[3]) + (b[0] * b[0] + b[1] * b[1]) + (b[2] * b[2] + b[3] * b[3]);
                        s *= sr[ai][m] * sr[ai][m]; s += __shfl_xor(s, 16); s += __shfl_xor(s, 32);
                        if (fq == 0) part[((ai * HALF + rb + m * 16) * 2 + bj) * 4 + wc] = s; }
            asm volatile("s_waitcnt lgkmcnt(0)" ::: "memory"); __builtin_amdgcn_s_barrier(); asm volatile("" ::: "memory");
        }
        const f32x4 g0 = *(const f32x4*)(gain + cl), g1 = *(const f32x4*)(gain + cl + 4);
        float* outp = isk ? outK : outV; bf16_t* outb = isk ? MK : MV; const int ct = (isk ? u.pn : u.pn - 2) * BM + cl;
#pragma unroll
        for (int ai = 0; ai < 2; ++ai)
#pragma unroll
            for (int m = 0; m < 4; ++m) { const int r = u.pm * BM + ai * HALF + rb + m * 16;
#pragma unroll
                for (int bj = 0; bj < 2; ++bj) {
                    f32x4 v0 = acc[ai][bj][m][0] * sr[ai][m], v1 = acc[ai][bj][m][1] * sr[ai][m];
                    if (isk) { const f32x4 p = *(const PG8_LAS f32x4*)(part + ((ai * HALF + rb + m * 16) * 2 + bj) * 4);
                        const float rs = __builtin_amdgcn_rsqf(((p[0] + p[1]) + (p[2] + p[3])) * (1.0f / 128.0f) + RMS_EPS); v0 = v0 * rs * g0; v1 = v1 * rs * g1; }
                    float* op = outp + (size_t)r * 512 + ct + bj * HALF; *(f32x4*)op = v0; *(f32x4*)(op + 4) = v1;
                    u32x4 w; w.x = pkbf(v0[0], v0[1]); w.y = pkbf(v0[2], v0[3]); w.z = pkbf(v1[0], v1[1]); w.w = pkbf(v1[2], v1[3]);
                    *(u32x4*)(outb + (size_t)r * 512 + ct + bj * HALF) = w; } }
    }
};

#ifndef PROBE_NULLSPLIT
#define PROBE_NULLSPLIT false
#endif
struct EpiNull {
    static constexpr bool PERM = true, AFTER_DRAIN = false, SPLITK = PROBE_NULLSPLIT, USES_LDS = false;
    __device__ __forceinline__ void partial(const f32x4 (&acc)[2][2][4][2], const Unit& u, int wr, int wc, int fr, int fq, PG8_LAS unsigned char* lds, int tid) const { (*this)(acc, u, wr, wc, fr, fq); }
    __device__ __forceinline__ void operator()(const f32x4 (&acc)[2][2][4][2], const Unit& u, int wr, int wc, int fr, int fq) const {
#pragma unroll
        for (int ai = 0; ai < 2; ++ai)
#pragma unroll
            for (int bj = 0; bj < 2; ++bj)
#pragma unroll
                for (int m = 0; m < 4; ++m) asm volatile("" :: "v"(acc[ai][bj][m][0]), "v"(acc[ai][bj][m][1]));
    }
};

template <class Epi, class Sched, bool ALIGN_EPI = false, bool SP2 = false>
__device__ __forceinline__ void gemm_phase(PG8_LAS unsigned char* lds, const Gemm g, const Sched& S, const Epi& E) {
    int tid_o = threadIdx.x; asm volatile("" : "+v"(tid_o));
    const int tid = tid_o, wid = __builtin_amdgcn_readfirstlane(tid >> 6), lane = tid & 63, wr = wid >> 2, wc = wid & 3, fr = lane & 15, fq = lane >> 4;
    const int K = g.K;
    unsigned voffA[2], voffB[2];
#pragma unroll
    for (int i = 0; i < 2; ++i) { int R, C; stage_rc(tid * 16 + i * 8192, R, C); const int Rb = Epi::PERM ? ((R & ~31) + perm32(R & 31)) : R;
        voffA[i] = (unsigned)(R * K + C) * 2u; voffB[i] = (unsigned)(Rb * K + C) * 2u; }
    const size_t kstep = (size_t)(BK * 2);
    const size_t hstep = (size_t)HALF * K * 2;
    const size_t tstep = 2 * hstep;
    const unsigned ldsw = (unsigned)wid * 1024u;
    const int aoff = lds_byte(wr * 64 + fr, fq * 8), boff = lds_byte(wc * 32 + fr, fq * 8);
#define PG8_SA(b, h) (((b) * 2 + (h)) * HTB)
#define PG8_SB(b, h) ((4 + (b) * 2 + (h)) * HTB)
#define PG8_STAGE(bufoff, gbase, voff) do { _Pragma("unroll") for (int _i = 0; _i < 2; ++_i) \
        __builtin_amdgcn_global_load_lds((const unsigned*)((const char*)(gbase) + (voff)[_i]), (PG8_LAS unsigned*)(lds + (bufoff) + ldsw + _i * 8192), 16, 0, 0); } while (0)
#define PG8_LDA(dst, b, h) do { _Pragma("unroll") for (int m = 0; m < 4; ++m) _Pragma("unroll") for (int k = 0; k < 2; ++k) dst[m][k] = *(const PG8_LAS bf16x8*)(lds + PG8_SA(b, h) + aoff + m * 2048 + k * 1024); } while (0)
#define PG8_LDB(dst, b, h) do { _Pragma("unroll") for (int n = 0; n < 2; ++n) _Pragma("unroll") for (int k = 0; k < 2; ++k) dst[n][k] = *(const PG8_LAS bf16x8*)(lds + PG8_SB(b, h) + boff + n * 2048 + k * 1024); } while (0)
#define PG8_MMA(ai, bj, At, Bt) do { __builtin_amdgcn_s_setprio(1); _Pragma("unroll") for (int m = 0; m < 4; ++m) _Pragma("unroll") for (int n = 0; n < 2; ++n) _Pragma("unroll") for (int k = 0; k < 2; ++k) \
        acc[ai][bj][m][n] = __builtin_amdgcn_mfma_f32_16x16x32_bf16(Bt[n][k], At[m][k], acc[ai][bj][m][n], 0, 0, 0); __builtin_amdgcn_s_setprio(0); } while (0)
#define PG8_WAIT_V(n) asm volatile("s_waitcnt vmcnt(" #n ")" ::: "memory")
#define PG8_WAIT_L(n) asm volatile("s_waitcnt lgkmcnt(" #n ")" ::: "memory")
#define PG8_BAR __builtin_amdgcn_s_barrier()
#define PG8_SCHED __builtin_amdgcn_sched_barrier(0)
    Unit cur, nxt; int ui = 0;
    if (!S.next(0, cur)) return;
    f32x4 acc[2][2][4][2];
#pragma unroll
    for (int a = 0; a < 2; ++a)
#pragma unroll
        for (int b = 0; b < 2; ++b)
#pragma unroll
            for (int m = 0; m < 4; ++m)
#pragma unroll
                for (int n = 0; n < 2; ++n) acc[a][b][m][n] = (f32x4){0.f, 0.f, 0.f, 0.f};
    bf16x8 At[4][2], B0[2][2], B1[2][2];
    const char* cA = (const char*)g.A + (size_t)cur.pm * tstep + (size_t)cur.kt0 * kstep; const char* cB = (const char*)g.Bt + (size_t)cur.pn * tstep + (size_t)cur.kt0 * kstep;
    S.a_ready(cur);
    if constexpr (SP2) {
        PG8_STAGE(PG8_SB(0, 0), cB, voffB); PG8_STAGE(PG8_SB(0, 1), cB + hstep, voffB); PG8_STAGE(PG8_SA(0, 0), cA, voffA); PG8_STAGE(PG8_SA(0, 1), cA + hstep, voffA);
        if (wr == 1) PG8_BAR;
        PG8_WAIT_V(2); PG8_BAR;
        PG8_STAGE(PG8_SB(1, 0), cB + kstep, voffB); PG8_STAGE(PG8_SA(1, 0), cA + kstep, voffA); PG8_STAGE(PG8_SB(1, 1), cB + hstep + kstep, voffB);
        PG8_WAIT_V(6); PG8_BAR;
    } else {
        PG8_STAGE(PG8_SB(0, 0), cB, voffB); PG8_STAGE(PG8_SA(0, 0), cA, voffA); PG8_STAGE(PG8_SB(0, 1), cB + hstep, voffB); PG8_STAGE(PG8_SA(0, 1), cA + hstep, voffA);
        if (wr == 1) PG8_BAR;
        PG8_WAIT_V(4); PG8_BAR;
        PG8_STAGE(PG8_SB(1, 0), cB + kstep, voffB); PG8_STAGE(PG8_SA(1, 0), cA + kstep, voffA); PG8_STAGE(PG8_SB(1, 1), cB + hstep + kstep, voffB);
        PG8_WAIT_V(6); PG8_BAR;
    }
    for (;;) {
        const bool has_next = S.next(ui + 1, nxt);
        const char* nA = has_next ? (const char*)g.A + (size_t)nxt.pm * tstep + (size_t)nxt.kt0 * kstep : cA; const char* nB = has_next ? (const char*)g.Bt + (size_t)nxt.pn * tstep + (size_t)nxt.kt0 * kstep : cB;
        const int nt = cur.nt;
        for (int t = 0; t < nt; t += 2) {
            const bool last = (t == nt - 2);
            const char* a1 = cA + (size_t)(t + 1) * kstep;
            const char* a2 = last ? nA : cA + (size_t)(t + 2) * kstep; const char* b2 = last ? nB : cB + (size_t)(t + 2) * kstep;
            const char* a3 = a2 + kstep; const char* b3 = b2 + kstep;
            if (last && has_next) S.a_ready(nxt);
            if constexpr (SP2) {
            PG8_LDB(B0, 0, 0); PG8_LDB(B1, 0, 1); PG8_SCHED; PG8_LDA(At, 0, 0); PG8_STAGE(PG8_SA(1, 1), a1 + hstep, voffA);
            PG8_WAIT_V(8); PG8_WAIT_L(0); PG8_BAR; PG8_MMA(0, 0, At, B0); PG8_MMA(0, 1, At, B1); PG8_BAR; PG8_SCHED;
            PG8_LDA(At, 0, 1); PG8_STAGE(PG8_SB(0, 0), b2, voffB); PG8_STAGE(PG8_SB(0, 1), b2 + hstep, voffB); PG8_STAGE(PG8_SA(0, 0), a2, voffA);
            PG8_WAIT_V(8); PG8_WAIT_L(0); PG8_BAR; PG8_MMA(1, 0, At, B0); PG8_MMA(1, 1, At, B1); PG8_BAR; PG8_SCHED;
            PG8_LDB(B0, 1, 0); PG8_LDB(B1, 1, 1); PG8_SCHED; PG8_LDA(At, 1, 0); PG8_STAGE(PG8_SA(0, 1), a2 + hstep, voffA);
            PG8_WAIT_V(8); PG8_WAIT_L(0); PG8_BAR; PG8_MMA(0, 0, At, B0); PG8_MMA(0, 1, At, B1); PG8_BAR; PG8_SCHED;
            PG8_LDA(At, 1, 1); PG8_STAGE(PG8_SB(1, 0), b3, voffB); PG8_STAGE(PG8_SB(1, 1), b3 + hstep, voffB); PG8_STAGE(PG8_SA(1, 0), a3, voffA);
            PG8_WAIT_V(8); PG8_WAIT_L(0); PG8_BAR; PG8_MMA(1, 0, At, B0); PG8_MMA(1, 1, At, B1); PG8_BAR; PG8_SCHED;
            } else {
            PG8_LDB(B0, 0, 0); PG8_SCHED; PG8_LDA(At, 0, 0); PG8_STAGE(PG8_SA(1, 1), a1 + hstep, voffA);
            PG8_WAIT_L(8); PG8_BAR; PG8_WAIT_L(0); PG8_MMA(0, 0, At, B0); PG8_BAR; PG8_SCHED;
            PG8_LDB(B1, 0, 1); PG8_STAGE(PG8_SB(0, 0), b2, voffB);
            PG8_BAR; PG8_WAIT_L(0); PG8_MMA(0, 1, At, B1); PG8_BAR;
            PG8_LDA(At, 0, 1); PG8_STAGE(PG8_SA(0, 0), a2, voffA);
            PG8_BAR; PG8_WAIT_L(0); PG8_MMA(1, 0, At, B0); PG8_BAR; PG8_SCHED;
            PG8_STAGE(PG8_SB(0, 1), b2 + hstep, voffB);
            PG8_WAIT_V(6); PG8_BAR; PG8_MMA(1, 1, At, B1); PG8_BAR;
            PG8_LDB(B0, 1, 0); PG8_SCHED; PG8_LDA(At, 1, 0); PG8_STAGE(PG8_SA(0, 1), a2 + hstep, voffA);
            PG8_WAIT_L(8); PG8_BAR; PG8_WAIT_L(0); PG8_MMA(0, 0, At, B0); PG8_BAR; PG8_SCHED;
            PG8_LDB(B1, 1, 1); PG8_STAGE(PG8_SB(1, 0), b3, voffB);
            PG8_BAR; PG8_WAIT_L(0); PG8_MMA(0, 1, At, B1); PG8_BAR;
            PG8_LDA(At, 1, 1); PG8_STAGE(PG8_SA(1, 0), a3, voffA);
            PG8_BAR; PG8_WAIT_L(0); PG8_MMA(1, 0, At, B0); PG8_BAR; PG8_SCHED;
            PG8_STAGE(PG8_SB(1, 1), b3 + hstep, voffB);
            PG8_WAIT_V(6); PG8_BAR; PG8_MMA(1, 1, At, B1); PG8_BAR;
            }
        }
        if constexpr (ALIGN_EPI) { if (wr == 0) PG8_BAR; }
        if constexpr (!Epi::AFTER_DRAIN) { if constexpr (Epi::SPLITK) { if (cur.split >= 0) E.partial(acc, cur, wr, wc, fr, fq, lds, tid); else E(acc, cur, wr, wc, fr, fq); } else if constexpr (Epi::USES_LDS) E.with_lds(acc, cur, wr, wc, fr, fq, lds); else E(acc, cur, wr, wc, fr, fq); S.done(cur); }
        if (!has_next) break;
#pragma unroll
        for (int a = 0; a < 2; ++a)
#pragma unroll
            for (int b = 0; b < 2; ++b)
#pragma unroll
                for (int m = 0; m < 4; ++m)
#pragma unroll
                    for (int n = 0; n < 2; ++n) acc[a][b][m][n] = (f32x4){0.f, 0.f, 0.f, 0.f};
        cur = nxt; cA = nA; cB = nB; ++ui;
        if constexpr (ALIGN_EPI) { if (wr == 1) PG8_BAR; }
    }
    PG8_WAIT_V(0);
    if constexpr (!ALIGN_EPI) { if (wr == 0) PG8_BAR; }
    PG8_BAR;
    if constexpr (Epi::AFTER_DRAIN) { E.fused(acc, cur, wr, wc, fr, fq, lds, wid, lane); S.done(cur); }
#undef PG8_SA
#undef PG8_SB
#undef PG8_STAGE
#undef PG8_LDA
#undef PG8_LDB
#undef PG8_MMA
#undef PG8_WAIT_V
#undef PG8_WAIT_L
#undef PG8_BAR
#undef PG8_SCHED
}
}

typedef unsigned short bf16;
typedef short bf16x8 __attribute__((ext_vector_type(8)));
typedef short s16x4 __attribute__((ext_vector_type(4)));
typedef float f32x4 __attribute__((ext_vector_type(4)));
typedef float f32x16 __attribute__((ext_vector_type(16)));
typedef unsigned u32x4 __attribute__((ext_vector_type(4)));
typedef unsigned u32x2 __attribute__((ext_vector_type(2)));
using pg8::pkbf;
constexpr float EPS = 1e-6f;
DI float bf_lo(unsigned w) { return __uint_as_float(w << 16); }
DI float bf_hi(unsigned w) { return __uint_as_float(w & 0xffff0000u); }
DI float bf2f(bf16 v) { return __uint_as_float((unsigned)v << 16); }
DI bf16 f2bf(float f) { return (bf16)(pkbf(f, f) & 0xffffu); }
DI void unpack8(const u32x4 w, float (&f)[8]) { f[0] = bf_lo(w.x); f[1] = bf_hi(w.x); f[2] = bf_lo(w.y); f[3] = bf_hi(w.y); f[4] = bf_lo(w.z); f[5] = bf_hi(w.z); f[6] = bf_lo(w.w); f[7] = bf_hi(w.w); }
DI u32x4 pack8(const float (&f)[8]) { u32x4 w; w.x = pkbf(f[0], f[1]); w.y = pkbf(f[2], f[3]); w.z = pkbf(f[4], f[5]); w.w = pkbf(f[6], f[7]); return w; }
DI float wave_sum(float v) {
#pragma unroll
    for (int o = 1; o < 64; o <<= 1) v += __shfl_xor(v, o);
    return v;
}
DI float silu_f(float x) { return x * __builtin_amdgcn_rcpf(1.0f + __builtin_amdgcn_exp2f(-1.4426950408889634f * x)); }

#define XB_TMO      128
#define XB_XCNT(j)  (256  + 64 * (j))
#define XB_XSUB(j)  (1280 + 64 * (j))
#define XB_XGEN(j)  (2304 + 64 * (j))
#define XB_TOP      3328
#define XB_TOPGEN   3392
#define XCD_BAR_WORDS 3456
#define XB_SPIN_CAP (1u << 18)

__device__ __forceinline__ unsigned xb_ld(unsigned* p)              { return __hip_atomic_load(p, __ATOMIC_RELAXED, __HIP_MEMORY_SCOPE_AGENT); }
__device__ __forceinline__ unsigned xb_add(unsigned* p, unsigned v) { return __hip_atomic_fetch_add(p, v, __ATOMIC_RELAXED, __HIP_MEMORY_SCOPE_AGENT); }
__device__ __forceinline__ unsigned xb_xcc_id() { return (unsigned)__builtin_amdgcn_s_getreg((3 << 11) | 20) & 0xFu; }
#define XB_SPIN(cond, bar) do { unsigned _sp = 0; while (cond) { __builtin_amdgcn_s_sleep(1); \
    if ((++_sp & 255u) == 0u) { if (xb_ld(&(bar)[XB_TMO])) break; if (_sp > XB_SPIN_CAP) { atomicAdd(&(bar)[XB_TMO], 1u); break; } } } } while (0)

struct XcdBarrier {
    unsigned* bar; unsigned x;
    volatile LAS unsigned* st;
};

__device__ __forceinline__ XcdBarrier xcd_barrier_post(unsigned* bar, volatile LAS unsigned* st) {
    XcdBarrier b; b.bar = bar; b.x = xb_xcc_id(); b.st = st;
    if (threadIdx.x == 0) (void)xb_add(&bar[XB_XCNT(b.x)], 1u);
    return b;
}
__device__ __forceinline__ void xcd_barrier_complete(unsigned* bar, unsigned x, unsigned& nloc, unsigned& nx) {
    const unsigned G = gridDim.x * gridDim.y * gridDim.z;
    unsigned sum, cnt, mine, sp = 0u;
    for (;;) {
        sum = 0u; cnt = 0u; mine = 0u;
#pragma unroll
        for (unsigned j = 0; j < 16; ++j) { const unsigned c = xb_ld(&bar[XB_XCNT(j)]); sum += c; cnt += (c > 0u) ? 1u : 0u; mine = (j == x) ? c : mine; }
        if (sum == G) break;
        __builtin_amdgcn_s_sleep(1);
        if ((++sp & 255u) == 0u) { if (xb_ld(&bar[XB_TMO])) break; if (sp > XB_SPIN_CAP) { atomicAdd(&bar[XB_TMO], 1u); break; } }
    }
    nloc = mine > 0u ? mine : 1u; nx = cnt > 0u ? cnt : 1u;
}

__device__ __forceinline__ void xcd_barrier(const XcdBarrier& b) {
    asm volatile("s_waitcnt vmcnt(0)" ::: "memory");
    __syncthreads();
    if (threadIdx.x == 0) {
        unsigned* bar = b.bar;
        __builtin_amdgcn_s_waitcnt(0);
        unsigned nloc = b.st[0], nx = b.st[1];
        if (nloc == 0u) { xcd_barrier_complete(bar, b.x, nloc, nx); b.st[0] = nloc; b.st[1] = nx; }
        const unsigned old = xb_add(&bar[XB_XSUB(b.x)], 1u);
        const unsigned gen = old / nloc;
        if (old + 1u == (gen + 1u) * nloc) {
            __builtin_amdgcn_fence(__ATOMIC_RELEASE, "agent");
            asm volatile("s_waitcnt vmcnt(0)" ::: "memory");
            const unsigned og = xb_add(&bar[XB_TOP], 1u);
            const unsigned tg = og / nx;
            if (og + 1u == (tg + 1u) * nx) xb_add(&bar[XB_TOPGEN], 1u);
            else XB_SPIN(xb_ld(&bar[XB_TOPGEN]) == tg, bar);
            __builtin_amdgcn_fence(__ATOMIC_ACQUIRE, "agent");
            xb_add(&bar[XB_XGEN(b.x)], 1u);
            asm volatile("s_waitcnt vmcnt(0)" ::: "memory");
        } else {
            XB_SPIN(xb_ld(&bar[XB_XGEN(b.x)]) == gen, bar);
            __builtin_amdgcn_fence(__ATOMIC_ACQUIRE, "agent");
            asm volatile("s_waitcnt vmcnt(0)" ::: "memory");
        }
    }
    __syncthreads();
}

constexpr int DM = 4096, RP = 16384, RSM = 512, R = RP + RSM;
constexpr int SEQ = 2048, DSEQ = 64, PAST = 2048, KVS = PAST + DSEQ;
constexpr int KVROWS = RP + 8 * KVS;
constexpr int NIN = 7936;
constexpr int PC_Z = 1536, PC_XBC = 3584, PC_KPE = 7680, PC_DT = 7744;
constexpr int DFF = 11008, NMEM = 256;
constexpr int NLAYER = 2, NPH = 13;

constexpr size_t O_Y = 0, O_CKV_P = 69206016, O_KPE_P = 85983232, O_CONV_P = 88080384, O_SSM_P = 88276992, O_MK_P = 92471296, O_MV_P = 94568448,
                 O_CKV_S = 96665600, O_KPE_S = 97189888, O_CONV_S = 97255424, O_SSM_S = 97452032, O_END = 101646336;

constexpr size_t al256(size_t x) { return (x + 255) / 256 * 256; }
constexpr size_t WS_CTL = 0, CTL_ZERO_BYTES = 1u << 20;
constexpr int CW_TMO = 0, CW_BAR = 4096, CW_SPLIT = 8192, CW_SS = 16384, CW_SSM = CW_SS + 7 * R;
static_assert((CW_SSM + 2048) * 4 <= (int)CTL_ZERO_BYTES && CW_SPLIT + NLAYER * NPH * 256 <= CW_SS, "ctl");
constexpr size_t WS_ROPE = 1u << 20;
constexpr size_t WS_W = 2u << 20;
constexpr size_t W_IN = WS_W, W_UQ = W_IN + (size_t)NIN * 4096 * 2, W_UKV = W_UQ + (size_t)3072 * 1024 * 2, W_O = W_UKV + (size_t)4096 * 512 * 2,
                 W_XQ = W_O + (size_t)4096 * 4096 * 2, W_XKV = W_XQ + (size_t)512 * 4096 * 2, W_XO = W_XKV + (size_t)1024 * 4096 * 2,
                 W_GU = W_XO + (size_t)4096 * 512 * 2, W_DN = W_GU + (size_t)22016 * 4096 * 2, W_END = W_DN + (size_t)4096 * 11008 * 2;
constexpr size_t A_XB = al256(W_END), A_MB = A_XB + (size_t)R * 4096 * 2, A_MEMF = A_MB + (size_t)2048 * 4096 * 2, A_MEMK = A_MEMF + (size_t)2048 * 1024 * 4,
                 A_MEMV = A_MEMK + (size_t)4096 * 512 * 2, A_XQ = A_MEMV + (size_t)4096 * 512 * 2, A_XO = A_XQ + (size_t)R * 512 * 2, A_DT = A_XO + (size_t)R * 512 * 2,
                 A_CQN = A_DT + (size_t)R * 32 * 4, A_CKV = A_CQN + (size_t)R * 1024 * 2, A_KPE = A_CKV + (size_t)KVROWS * 512 * 2, A_YG = A_KPE + (size_t)KVROWS * 64 * 2,
                 A_MIX = A_YG + (size_t)R * 2048 * 2, A_Q = A_MIX + (size_t)R * 4096 * 2, A_KV = A_Q + (size_t)R * 3072 * 2, A_PROJ = A_KV + (size_t)KVROWS * 4096 * 2,
                 A_XBC = A_PROJ + (size_t)R * NIN * 2, A_WGU2 = A_XBC + (size_t)R * 4096 * 2, A_END = A_WGU2 + (size_t)22016 * 4096 * 2, A_H = A_PROJ;
static_assert((size_t)R * DFF * 2 <= A_WGU2 - A_PROJ, "H overlay");
constexpr size_t WS_NEED = A_END;

constexpr int RING_BYTES = 131072, LDS_BYTES = 163840, MISC_OFF = LDS_BYTES - 256;

struct Args {
    const float* in[38]; float* out; unsigned char* ws; int ph_lo, ph_hi;
};
#define AS4 __attribute__((address_space(4)))
struct Ctx {
    LAS unsigned char* lds; int tid, lane, wave, G, bid;
    const float* const AS4* in; float* out; unsigned char* ws; unsigned* ctl;
};
extern __shared__ __attribute__((aligned(16))) unsigned char lds_raw[];
DI Ctx make_ctx() {
    Ctx F; int tid = threadIdx.x; asm volatile("" : "+v"(tid));
    const AS4 unsigned char* ka = (const AS4 unsigned char*)__builtin_amdgcn_kernarg_segment_ptr(); asm volatile("" : "+s"(ka));
    F.lds = (LAS unsigned char*)lds_raw; F.tid = tid; F.lane = tid & 63; F.wave = __builtin_amdgcn_readfirstlane(tid >> 6); F.G = gridDim.x; F.bid = blockIdx.x;
    F.in = (const float* const AS4*)ka; F.out = *(float* const AS4*)(ka + 38 * 8); F.ws = *(unsigned char* const AS4*)(ka + 39 * 8); F.ctl = (unsigned*)(F.ws + WS_CTL);
    return F;
}
enum { I_XP = 0, I_XS, I_MEM, I_CCKV, I_CKPE, I_SCONV, I_SSSM, I_CMK, I_CMV, I_NMIX, I_WIN, I_QNORM, I_WUQ, I_KVNORM, I_WUKV, I_QNN, I_QNP, I_KNN, I_KNP, I_CONVW, I_CONVB, I_DTB, I_ALOG, I_DSKIP,
       I_SSMN, I_WO, I_NXA, I_MEMN, I_WXQ, I_WXK, I_WXV, I_XNQ, I_XNK, I_WXO, I_NFFN, I_WG, I_WU, I_WD };

DI void p_prologue(const Ctx& F) {
    const int gw = F.bid * 8 + F.wave, NGW = F.G * 8, lane = F.lane;
    float* SS0 = (float*)F.ctl + CW_SS; float* SSM = (float*)F.ctl + CW_SSM;
    bf16* XB = (bf16*)(F.ws + A_XB); bf16* MB = (bf16*)(F.ws + A_MB);
    for (int row = gw; row < R + 2048; row += NGW) {
        const float* src; float* dstf = nullptr; bf16* dstb; float* ssp;
        if (row < RP) { src = F.in[I_XP] + (size_t)row * DM; dstb = XB + (size_t)row * DM; ssp = SS0 + row; }
        else if (row < R) { src = F.in[I_XS] + (size_t)(row - RP) * DM; dstb = XB + (size_t)row * DM; ssp = SS0 + row; }
        else { const int mr = row - R; src = F.in[I_MEM] + (size_t)mr * DM; dstb = MB + (size_t)mr * DM; ssp = SSM + mr; }
        float sq = 0.f;
#pragma unroll
        for (int j = 0; j < 8; ++j) {
            const f32x4 a = __builtin_nontemporal_load((const f32x4*)(src + j * 512 + lane * 8)), b = __builtin_nontemporal_load((const f32x4*)(src + j * 512 + lane * 8 + 4));
            sq += (a[0] * a[0] + a[1] * a[1]) + (a[2] * a[2] + a[3] * a[3]) + (b[0] * b[0] + b[1] * b[1]) + (b[2] * b[2] + b[3] * b[3]);
            if (dstf) { *(f32x4*)(dstf + j * 512 + lane * 8) = a; *(f32x4*)(dstf + j * 512 + lane * 8 + 4) = b; }
            u32x4 w; w.x = pkbf(a[0], a[1]); w.y = pkbf(a[2], a[3]); w.z = pkbf(b[0], b[1]); w.w = pkbf(b[2], b[3]);
            *(u32x4*)(dstb + j * 512 + lane * 8) = w;
        }
        sq = wave_sum(sq);
        if (lane == 0) *ssp = sq;
    }
    float* ctab = (float*)(F.ws + WS_ROPE); float* stab = ctab + KVS * 32;
    for (int i = F.bid * 512 + F.tid; i < KVS * 32; i += F.G * 512) {
        const int pos = i >> 5, k = i & 31;
        const float inv = powf(10000.0f, -(float)k / 32.0f);
        const float ang = (float)pos * inv;
        ctab[i] = cosf(ang); stab[i] = sinf(ang);
    }
}

struct CvItem { const float* src; const float* gain; bf16* dst; int ldw, K, nvalid; };
DI CvItem cv_decode(const Ctx& F, int l, int it) {
    unsigned char* ws = F.ws; CvItem c; c.gain = nullptr; c.nvalid = 64;
    constexpr int N_IN = 122 * 64, N_UQ = 48 * 16, N_UKV = 64 * 8, N_O = 64 * 64, N_XQ = 8 * 64, N_XK = 8 * 64, N_XV = 8 * 64, N_XO = 64 * 8, N_G = 172 * 64, N_U = 172 * 64;
    int r = it;
    if (r < N_IN) { const int kb = r / 122, nb = r % 122, cc = nb * 64; int dr; if (cc < 1536) dr = cc; else if (cc < 1600) dr = PC_KPE; else if (cc < 3648) dr = PC_Z + (cc - 1600); else if (cc < 7744) dr = PC_XBC + (cc - 3648); else { dr = PC_DT; c.nvalid = 32; }
        c.src = F.in[I_WIN] + (size_t)l * 4096 * 7776 + (size_t)kb * 64 * 7776 + cc; c.ldw = 7776; c.gain = F.in[I_NMIX] + l * 4096 + kb * 64; c.K = 4096; c.dst = (bf16*)(ws + W_IN) + (size_t)dr * 4096 + kb * 64; return c; } r -= N_IN;
    if (r < N_UQ) { const int kb = r / 48, nb = r % 48; c.src = F.in[I_WUQ] + (size_t)l * 1024 * 3072 + (size_t)kb * 64 * 3072 + nb * 64; c.ldw = 3072; c.gain = F.in[I_QNORM] + l * 1024 + kb * 64; c.K = 1024; c.dst = (bf16*)(ws + W_UQ) + (size_t)nb * 64 * 1024 + kb * 64; return c; } r -= N_UQ;
    if (r < N_UKV) { const int kb = r / 64, nb = r % 64; c.src = F.in[I_WUKV] + (size_t)l * 512 * 4096 + (size_t)kb * 64 * 4096 + nb * 64; c.ldw = 4096; c.K = 512; c.dst = (bf16*)(ws + W_UKV) + (size_t)nb * 64 * 512 + kb * 64; return c; } r -= N_UKV;
    if (r < N_O) { const int kb = r / 64, nb = r % 64; c.src = F.in[I_WO] + (size_t)l * 4096 * 4096 + (size_t)kb * 64 * 4096 + nb * 64; c.ldw = 4096; c.K = 4096; c.dst = (bf16*)(ws + W_O) + (size_t)nb * 64 * 4096 + kb * 64; return c; } r -= N_O;
    if (r < N_XQ) { const int kb = r / 8, nb = r % 8; c.src = F.in[I_WXQ] + (size_t)l * 4096 * 512 + (size_t)kb * 64 * 512 + nb * 64; c.ldw = 512; c.gain = F.in[I_NXA] + l * 4096 + kb * 64; c.K = 4096; c.dst = (bf16*)(ws + W_XQ) + (size_t)nb * 64 * 4096 + kb * 64; return c; } r -= N_XQ;
    if (r < N_XK) { const int kb = r / 8, nb = r % 8; c.src = F.in[I_WXK] + (size_t)l * 4096 * 512 + (size_t)kb * 64 * 512 + nb * 64; c.ldw = 512; c.gain = F.in[I_MEMN] + l * 4096 + kb * 64; c.K = 4096; c.dst = (bf16*)(ws + W_XKV) + (size_t)nb * 64 * 4096 + kb * 64; return c; } r -= N_XK;
    if (r < N_XV) { const int kb = r / 8, nb = r % 8; c.src = F.in[I_WXV] + (size_t)l * 4096 * 512 + (size_t)kb * 64 * 512 + nb * 64; c.ldw = 512; c.gain = F.in[I_MEMN] + l * 4096 + kb * 64; c.K = 4096; c.dst = (bf16*)(ws + W_XKV) + (size_t)(512 + nb * 64) * 4096 + kb * 64; return c; } r -= N_XV;
    if (r < N_XO) { const int kb = r / 64, nb = r % 64; c.src = F.in[I_WXO] + (size_t)l * 512 * 4096 + (size_t)kb * 64 * 4096 + nb * 64; c.ldw = 4096; c.K = 512; c.dst = (bf16*)(ws + W_XO) + (size_t)nb * 64 * 512 + kb * 64; return c; } r -= N_XO;
    if (r < N_G) { const int kb = r / 172, nb = r % 172; c.src = F.in[I_WG] + (size_t)l * 4096 * DFF + (size_t)kb * 64 * DFF + nb * 64; c.ldw = DFF; c.gain = F.in[I_NFFN] + l * 4096 + kb * 64; c.K = 4096; c.dst = (bf16*)(ws + ((l & 1) ? A_WGU2 : W_GU)) + (size_t)((nb >> 1) * 256 + (nb & 1) * 64) * 4096 + kb * 64; return c; } r -= N_G;
    if (r < N_U) { const int kb = r / 172, nb = r % 172; c.src = F.in[I_WU] + (size_t)l * 4096 * DFF + (size_t)kb * 64 * DFF + nb * 64; c.ldw = DFF; c.gain = F.in[I_NFFN] + l * 4096 + kb * 64; c.K = 4096; c.dst = (bf16*)(ws + ((l & 1) ? A_WGU2 : W_GU)) + (size_t)((nb >> 1) * 256 + 128 + (nb & 1) * 64) * 4096 + kb * 64; return c; } r -= N_U;
    { const int kb = r / 64, nb = r % 64; c.src = F.in[I_WD] + (size_t)l * DFF * 4096 + (size_t)kb * 64 * 4096 + nb * 64; c.ldw = 4096; c.K = DFF; c.dst = (bf16*)(ws + W_DN) + (size_t)nb * 64 * DFF + kb * 64; return c; }
}
constexpr int CV_NITEMS = 122 * 64 + 48 * 16 + 64 * 8 + 64 * 64 + 3 * 8 * 64 + 64 * 8 + 2 * 172 * 64 + 64 * 172;
DI void cv_load(const CvItem& c, f32x4 (&v)[16], int lane) {
    const int n4 = (lane & 15) * 4, kr = lane >> 4; const float* p = c.src + (size_t)kr * c.ldw + n4;
    if (n4 < c.nvalid) {
#pragma unroll
        for (int i = 0; i < 16; ++i) v[i] = __builtin_nontemporal_load((const f32x4*)(p + (size_t)(4 * i) * c.ldw));
    } else {
#pragma unroll
        for (int i = 0; i < 16; ++i) v[i] = (f32x4){0.f, 0.f, 0.f, 0.f};
    }
}
DI void cv_store(const CvItem& c, const f32x4 (&v)[16], LAS unsigned char* scr, int lane) {
    constexpr int RS = 144;
    const int l15 = lane & 15, kr = lane >> 4;
#pragma unroll
    for (int i = 0; i < 16; ++i) { const int k = kr + 4 * i; const float g = c.gain ? c.gain[k] : 1.0f;
        u32x2 w; w.x = pkbf(v[i][0] * g, v[i][1] * g); w.y = pkbf(v[i][2] * g, v[i][3] * g);
        *(LAS u32x2*)(scr + k * RS + l15 * 8) = w; }
    asm volatile("s_waitcnt lgkmcnt(0)" ::: "memory");
    typedef short v4i16_t __attribute__((ext_vector_type(4)));
    const int g4 = lane >> 4, q = l15 >> 2, pp = lane & 3;
#pragma unroll
    for (int cb = 0; cb < 4; ++cb)
#pragma unroll
        for (int kh = 0; kh < 2; ++kh) {
            const LAS unsigned char* a = scr + (32 * kh + 8 * g4 + q) * RS + (16 * cb + 4 * pp) * 2;
            const s16x4 lo = __builtin_bit_cast(s16x4, __builtin_amdgcn_ds_read_tr16_b64_v4i16((LAS v4i16_t*)a));
            const s16x4 hi = __builtin_bit_cast(s16x4, __builtin_amdgcn_ds_read_tr16_b64_v4i16((LAS v4i16_t*)(a + 4 * RS)));
            const bf16x8 o = (bf16x8){lo[0], lo[1], lo[2], lo[3], hi[0], hi[1], hi[2], hi[3]};
            *(bf16x8*)(c.dst + (size_t)(16 * cb + l15) * c.K + 32 * kh + 8 * g4) = o; }
    asm volatile("s_waitcnt lgkmcnt(0)" ::: "memory");
}
constexpr int CV_E3 = 122 * 64 + 48 * 16 + 64 * 8 + 64 * 64 + 3 * 8 * 64 + 64 * 8;
constexpr int CV_GU0 = CV_E3, CV_GU3 = CV_E3 + 2 * 172 * 64, CV_GU1 = CV_GU3 - 7000;
static_assert(CV_GU3 == 37248, "gate/up item range");
constexpr int CV_A0 = 122 * 64 + 48 * 16 + 64 * 8;
constexpr int CV_AGU = 5000;
constexpr int CV_DX = 2500, CV_DO = 1000, CV_DG = 4000 + (CV_E3 - CV_A0) - CV_DX - CV_DO + 0;
static_assert(CV_DX + CV_DO + CV_DG == 4000 + (CV_E3 - CV_A0), "down item shares");
#define CV_MAP(v_) ((v_) < n1 ? la : lb), ((v_) < n1 ? a0 + (v_) : b0 + ((v_) - n1))
#ifndef CV_TAILW
#define CV_TAILW 8
#endif
DI void p_convw_range(const Ctx& F, int la, int a0, int n1, int lb, int b0, int n2, int wg0, int nwg, int nwv = 8, int rank = -1) {
    if (F.wave >= nwv) return;
    LAS unsigned char* scr = F.lds + F.wave * 16384;
    const int gw = (rank >= 0 ? rank : F.bid - wg0) * nwv + F.wave, NGW = nwg * nwv, lane = F.lane;
    const int CV_END = n1 + n2;
    CvItem ca, cb, cc; f32x4 va[16], vb[16], vc[16];
    int nx = gw;
    bool ha = nx < CV_END; if (ha) { ca = cv_decode(F, CV_MAP(nx)); cv_load(ca, va, lane); } nx += NGW;
    bool hb = nx < CV_END; if (hb) { cb = cv_decode(F, CV_MAP(nx)); cv_load(cb, vb, lane); } nx += NGW;
    if (ha) for (;;) {
        const bool hc = nx < CV_END; if (hc) { cc = cv_decode(F, CV_MAP(nx)); cv_load(cc, vc, lane); } nx += NGW;
        cv_store(ca, va, scr, lane);
        if (!hb) break;
        ha = nx < CV_END; if (ha) { ca = cv_decode(F, CV_MAP(nx)); cv_load(ca, va, lane); } nx += NGW;
        cv_store(cb, vb, scr, lane);
        if (!hc) break;
        hb = nx < CV_END; if (hb) { cb = cv_decode(F, CV_MAP(nx)); cv_load(cb, vb, lane); } nx += NGW;
        cv_store(cc, vc, scr, lane);
        if (!ha) break;
    }
}
DI void p_convw(const Ctx& F, int l) {
    if (F.G == 256) { const int s0 = l > 0 ? CV_E3 : 0, s1 = l > 0 ? CV_E3 : CV_A0, d0 = CV_GU3 + CV_DX + CV_DO + CV_DG, d1 = l + 1 < NLAYER ? CV_NITEMS : d0; p_convw_range(F, l, s0, s1 - s0, l, d0, d1 - d0, 0, F.G); }
    else p_convw_range(F, l, 0, CV_NITEMS, l, 0, 0, 0, F.G);
    { unsigned zz = 0u; asm volatile("" : "+v"(zz));
      u32x4 z = {zz, zz, zz, zz}; u32x4* p = (u32x4*)(F.ws + W_IN + (size_t)7808 * 4096 * 2); const int n16 = 128 * 4096 * 2 / 16;
      for (int i = F.bid * 512 + F.tid; i < n16; i += F.G * 512) p[i] = z; }
}

DI void p_post1(const Ctx& F, int l) {
    const int gw = F.bid * 8 + F.wave, NGW = F.G * 8, lane = F.lane;
    unsigned char* ws = F.ws;
    const bf16* PROJ = (const bf16*)(ws + A_PROJ);
    bf16* CQN = (bf16*)(ws + A_CQN); bf16* CKV = (bf16*)(ws + A_CKV); bf16* KPE = (bf16*)(ws + A_KPE); bf16* XBC = (bf16*)(ws + A_XBC); float* DT = (float*)(ws + A_DT);
    const float* ctab = (const float*)(ws + WS_ROPE); const float* stab = ctab + KVS * 32;
    const float* kv_norm = F.in[I_KVNORM] + l * 512; const float* kn_pe = F.in[I_KNP] + l * 64;
    const float* conv_w = F.in[I_CONVW] + l * 4 * 4096; const float* conv_b = F.in[I_CONVB] + l * 4096; const float* dt_bias = F.in[I_DTB] + l * 32;
    f32x4 dk0, dk1, dv0, dv1;
    if (2048 + gw < 4096) { const float* kp = F.in[I_CMK] + ((size_t)l * 2048 + gw) * 512 + lane * 8; dk0 = *(const f32x4*)kp; dk1 = *(const f32x4*)(kp + 4);
        const float* vp = F.in[I_CMV] + ((size_t)l * 2048 + gw) * 512 + lane * 8; dv0 = *(const f32x4*)vp; dv1 = *(const f32x4*)(vp + 4); }
    u32x4 nq0, nq1, nkv; bf16 nk, nd;
#define P1_LOAD(row_) do { const bf16* pr_ = PROJ + (size_t)(row_) * NIN; nq0 = *(const u32x4*)(pr_ + lane * 8); nq1 = *(const u32x4*)(pr_ + 512 + lane * 8); nkv = *(const u32x4*)(pr_ + 1024 + lane * 8); \
        nk = pr_[PC_KPE + lane]; nd = pr_[PC_DT + (lane & 31)]; } while (0)
    f32x4 nc0, nc1; float nkp;
#define P1_CLOAD(i_) do { const int b_ = (i_) >> 11, s_ = (i_) & 2047; const float* cp_ = F.in[I_CCKV] + ((size_t)(l * 8 + b_) * PAST + s_) * 512 + lane * 8; \
        nc0 = __builtin_nontemporal_load((const f32x4*)cp_); nc1 = __builtin_nontemporal_load((const f32x4*)(cp_ + 4)); nkp = F.in[I_CKPE][((size_t)(l * 8 + b_) * PAST + s_) * 64 + lane]; } while (0)
    if (gw < R) P1_LOAD(gw);
    if (gw < 8 * PAST) P1_CLOAD(gw);
    for (int row = gw; row < R; row += NGW) {
        const bool samp = row >= RP; const int b = samp ? (row - RP) >> 6 : row >> 11, t = samp ? (row - RP) & 63 : row & 2047;
        const int pos = samp ? PAST + t : t; const int kvrow = samp ? RP + b * KVS + PAST + t : row;
        const u32x4 cq0 = nq0, cq1 = nq1, ckv = nkv; const bf16 ck = nk, cd = nd;
        const f32x4 cc0 = nc0, cc1 = nc1; const float ckp = nkp;
        if (row + NGW < R) P1_LOAD(row + NGW);
        if (row + NGW < 8 * PAST) P1_CLOAD(row + NGW);
        const float cs_c = ctab[pos * 32 + (lane & 31)], cs_s = stab[pos * 32 + (lane & 31)];
        {   float f0[8], f1[8]; unpack8(cq0, f0); unpack8(cq1, f1);
            float sq = 0.f;
#pragma unroll
            for (int j = 0; j < 8; ++j) sq += f0[j] * f0[j] + f1[j] * f1[j];
            const float rs = __builtin_amdgcn_rsqf(wave_sum(sq) * (1.0f / 1024.0f) + EPS);
#pragma unroll
            for (int j = 0; j < 8; ++j) { f0[j] *= rs; f1[j] *= rs; }
            *(u32x4*)(CQN + (size_t)row * 1024 + lane * 8) = pack8(f0); *(u32x4*)(CQN + (size_t)row * 1024 + 512 + lane * 8) = pack8(f1); }
        {   float f0[8]; unpack8(ckv, f0);
            float sq = 0.f;
#pragma unroll
            for (int j = 0; j < 8; ++j) sq += f0[j] * f0[j];
            const float rs = __builtin_amdgcn_rsqf(wave_sum(sq) * (1.0f / 512.0f) + EPS);
#pragma unroll
            for (int j = 0; j < 8; ++j) f0[j] *= rs * kv_norm[lane * 8 + j];
            float* op = samp ? F.out + O_CKV_S + ((size_t)(l * 8 + b) * 64 + t) * 512 : F.out + O_CKV_P + ((size_t)(l * 8 + b) * 2048 + t) * 512;
            *(f32x4*)(op + lane * 8) = (f32x4){f0[0], f0[1], f0[2], f0[3]}; *(f32x4*)(op + lane * 8 + 4) = (f32x4){f0[4], f0[5], f0[6], f0[7]};
            *(u32x4*)(CKV + (size_t)kvrow * 512 + lane * 8) = pack8(f0); }
        {   const float x = bf2f(ck);
            const float rs = __builtin_amdgcn_rsqf(wave_sum(x * x) * (1.0f / 64.0f) + EPS);
            const float xn = x * rs * kn_pe[lane]; const float other = __shfl_xor(xn, 32);
            const float o = lane < 32 ? xn * cs_c - other * cs_s : other * cs_s + xn * cs_c;
            float* op = samp ? F.out + O_KPE_S + ((size_t)(l * 8 + b) * 64 + t) * 64 : F.out + O_KPE_P + ((size_t)(l * 8 + b) * 2048 + t) * 64;
            op[lane] = o; KPE[(size_t)kvrow * 64 + lane] = f2bf(o); }
        if (lane < 32) { const float v = bf2f(cd) + dt_bias[lane]; DT[(size_t)row * 32 + lane] = v > 20.f ? v : 0.6931471805599453f * __builtin_amdgcn_logf(1.0f + __builtin_amdgcn_exp2f(1.4426950408889634f * v)); }
        if (row < 8 * PAST) { const int cb_ = row >> 11, cs_ = row & 2047; const size_t ckr = (size_t)RP + cb_ * KVS + cs_;
            u32x4 w; w.x = pkbf(cc0[0], cc0[1]); w.y = pkbf(cc0[2], cc0[3]); w.z = pkbf(cc1[0], cc1[1]); w.w = pkbf(cc1[2], cc1[3]);
            *(u32x4*)(CKV + ckr * 512 + lane * 8) = w; KPE[ckr * 64 + lane] = f2bf(ckp); }
    }
#undef P1_LOAD
#undef P1_CLOAD
    const int cvc = (gw & 7) * 512 + lane * 8;
    u32x4 xn[11];
#define P1_XLOAD(it_) do { const int rb_ = (it_) >> 3, r0_ = rb_ * 8; const bool samp_ = r0_ >= RP; const int b_ = samp_ ? (r0_ - RP) >> 6 : r0_ >> 11, t0_ = samp_ ? (r0_ - RP) & 63 : r0_ & 2047; \
        _Pragma("unroll") for (int i = 0; i < 11; ++i) { const int tt = t0_ - 3 + i; \
            if (tt >= 0) xn[i] = *(const u32x4*)(PROJ + (size_t)(r0_ - 3 + i) * NIN + PC_XBC + cvc); \
            else if (samp_) { const float* sp = F.in[I_SCONV] + ((size_t)(l * 8 + b_) * 3 + (tt + 3)) * 4096 + cvc; const f32x4 a0 = *(const f32x4*)sp, a1 = *(const f32x4*)(sp + 4); \
                xn[i].x = pkbf(a0[0], a0[1]); xn[i].y = pkbf(a0[2], a0[3]); xn[i].z = pkbf(a1[0], a1[1]); xn[i].w = pkbf(a1[2], a1[3]); } \
            else xn[i] = (u32x4){0u, 0u, 0u, 0u}; } } while (0)
    const int NCI = (R / 8) * 8;
    if (gw < NCI) P1_XLOAD(gw);
    float wt[4][8], bs[8];
    {   const int c = cvc;
#pragma unroll
        for (int i = 0; i < 4; ++i) { const f32x4 w0 = *(const f32x4*)(conv_w + i * 4096 + c), w1 = *(const f32x4*)(conv_w + i * 4096 + c + 4);
            wt[i][0] = w0[0]; wt[i][1] = w0[1]; wt[i][2] = w0[2]; wt[i][3] = w0[3]; wt[i][4] = w1[0]; wt[i][5] = w1[1]; wt[i][6] = w1[2]; wt[i][7] = w1[3]; }
        { const f32x4 b0 = *(const f32x4*)(conv_b + c), b1 = *(const f32x4*)(conv_b + c + 4); bs[0] = b0[0]; bs[1] = b0[1]; bs[2] = b0[2]; bs[3] = b0[3]; bs[4] = b1[0]; bs[5] = b1[1]; bs[6] = b1[2]; bs[7] = b1[3]; } }
    for (int it = gw; it < NCI; it += NGW) {
        const int rb = it >> 3, r0 = rb * 8, c = cvc;
        const bool samp = r0 >= RP; const int b = samp ? (r0 - RP) >> 6 : r0 >> 11, t0 = samp ? (r0 - RP) & 63 : r0 & 2047, L = samp ? DSEQ : SEQ;
        u32x4 xr[11];
#pragma unroll
        for (int i = 0; i < 11; ++i) xr[i] = xn[i];
        if (it + NGW < NCI) P1_XLOAD(it + NGW);
#pragma unroll
        for (int j = 0; j < 8; ++j) {
            float acc[8];
#pragma unroll
            for (int e = 0; e < 8; ++e) acc[e] = bs[e];
#pragma unroll
            for (int i = 0; i < 4; ++i) { float xv[8]; unpack8(xr[j + i], xv);
#pragma unroll
                for (int e = 0; e < 8; ++e) acc[e] += xv[e] * wt[i][e]; }
#pragma unroll
            for (int e = 0; e < 8; ++e) acc[e] = silu_f(acc[e]);
            *(u32x4*)(XBC + (size_t)(r0 + j) * 4096 + c) = pack8(acc);
            if (t0 + j >= L - 3) { float xv[8]; unpack8(xr[j + 3], xv);
                float* op = (samp ? F.out + O_CONV_S : F.out + O_CONV_P) + ((size_t)(l * 8 + b) * 3 + (t0 + j - (L - 3))) * 4096 + c;
                *(f32x4*)op = (f32x4){xv[0], xv[1], xv[2], xv[3]}; *(f32x4*)(op + 4) = (f32x4){xv[4], xv[5], xv[6], xv[7]}; }
        }
    }
    {   bf16* MEMK = (bf16*)(ws + A_MEMK); bf16* MEMV = (bf16*)(ws + A_MEMV);
        for (int row = 2048 + gw; row < 4096; row += NGW) {
            if (row != 2048 + gw) {
                const int mr = row - 2048;
                const float* kp = F.in[I_CMK] + ((size_t)l * 2048 + mr) * 512 + lane * 8; dk0 = *(const f32x4*)kp; dk1 = *(const f32x4*)(kp + 4);
                const float* vp = F.in[I_CMV] + ((size_t)l * 2048 + mr) * 512 + lane * 8; dv0 = *(const f32x4*)vp; dv1 = *(const f32x4*)(vp + 4);
            }
            u32x4 w; w.x = pkbf(dk0[0], dk0[1]); w.y = pkbf(dk0[2], dk0[3]); w.z = pkbf(dk1[0], dk1[1]); w.w = pkbf(dk1[2], dk1[3]);
            *(u32x4*)(MEMK + (size_t)row * 512 + lane * 8) = w;
            w.x = pkbf(dv0[0], dv0[1]); w.y = pkbf(dv0[2], dv0[3]); w.z = pkbf(dv1[0], dv1[1]); w.w = pkbf(dv1[2], dv1[3]);
            *(u32x4*)(MEMV + (size_t)row * 512 + lane * 8) = w;
        }
    }
}

DI void p_gnorm(const Ctx& F, int l) {
    const int gw = F.bid * 8 + F.wave, NGW = F.G * 8, lane = F.lane;
    const bf16* YG = (const bf16*)(F.ws + A_YG); bf16* MIX = (bf16*)(F.ws + A_MIX);
    const float* sn = F.in[I_SSMN] + l * 2048;
    u32x4 nw[4];
    f32x4 g0[4], g1[4];
#pragma unroll
    for (int p = 0; p < 4; ++p) { const int c = p * 512 + lane * 8; g0[p] = *(const f32x4*)(sn + c); g1[p] = *(const f32x4*)(sn + c + 4); }
    if (gw < R) {
#pragma unroll
        for (int p = 0; p < 4; ++p) nw[p] = __builtin_nontemporal_load((const u32x4*)(YG + (size_t)gw * 2048 + p * 512 + lane * 8));
    }
    for (int row = gw; row < R; row += NGW) {
        u32x4 w[4];
#pragma unroll
        for (int p = 0; p < 4; ++p) w[p] = nw[p];
        if (row + NGW < R) {
#pragma unroll
            for (int p = 0; p < 4; ++p) nw[p] = __builtin_nontemporal_load((const u32x4*)(YG + (size_t)(row + NGW) * 2048 + p * 512 + lane * 8));
        }
#pragma unroll
        for (int p = 0; p < 4; ++p) {
            float f[8]; unpack8(w[p], f); float sq = 0.f;
#pragma unroll
            for (int j = 0; j < 8; ++j) sq += f[j] * f[j];
            sq += __shfl_xor(sq, 1); sq += __shfl_xor(sq, 2); sq += __shfl_xor(sq, 4); sq += __shfl_xor(sq, 8); sq += __shfl_xor(sq, 16);
            const float rs = __builtin_amdgcn_rsqf(sq * (1.0f / 256.0f) + EPS);
            const int c = p * 512 + lane * 8;
            f[0] *= rs * g0[p][0]; f[1] *= rs * g0[p][1]; f[2] *= rs * g0[p][2]; f[3] *= rs * g0[p][3]; f[4] *= rs * g1[p][0]; f[5] *= rs * g1[p][1]; f[6] *= rs * g1[p][2]; f[7] *= rs * g1[p][3];
            *(u32x4*)(MIX + (size_t)row * 4096 + 2048 + c) = pack8(f);
        }
    }
}

namespace att {
#define KSWZ(row, colB) ((row) * 256 + ((colB) ^ (((row) & 7) << 4)))
#define PSWZ(row, colB) ((row) * 128 + ((colB) ^ (((row) & 7) << 4)))
#define SBAR() __builtin_amdgcn_sched_barrier(0)
constexpr int SHM_K = 16384, SHM_V = 16384, SHM_P = 8192, BUF = SHM_K + SHM_V + SHM_P, NBUF = 3, WSOFF = NBUF * BUF, QPOFF = WSOFF + 2048, ATT_END = QPOFF + 32768;
DI int crow(int r, int hi) { return (r & 3) + 8 * (r >> 2) + 4 * hi; }
DI int v_st(int k, int c) { const int kk = (k & ~0xC) | ((k & 4) << 1) | ((k & 8) >> 1); return ((kk >> 3) * 4 + (c >> 5)) * 512 + ((kk & 7) * 32 + (c & 31)) * 2; }
DI int v_rd_base(int lane) { return ((lane & 3) << 3) | (((lane >> 2) & 3) << 6) | (((lane >> 4) & 1) << 5) | (((lane >> 5) & 1) << 8); }
constexpr int v_rd_off(int d0, int ks, int half) { return d0 * 512 + ks * 4096 + half * 2048; }
template <int OFF> DI s16x4 tr_read(int vb) { s16x4 r; asm volatile("ds_read_b64_tr_b16 %0, %1 offset:%2" : "=&v"(r) : "v"(vb), "i"(OFF) : "memory"); return r; }
struct VFrag { s16x4 l0, h0, l1, h1, l2, h2, l3, h3; };
template <int D0> DI void v_read(VFrag& f, int vb) {
    f.l0 = tr_read<v_rd_off(D0, 0, 0)>(vb); f.h0 = tr_read<v_rd_off(D0, 0, 1)>(vb); f.l1 = tr_read<v_rd_off(D0, 1, 0)>(vb); f.h1 = tr_read<v_rd_off(D0, 1, 1)>(vb);
    f.l2 = tr_read<v_rd_off(D0, 2, 0)>(vb); f.h2 = tr_read<v_rd_off(D0, 2, 1)>(vb); f.l3 = tr_read<v_rd_off(D0, 3, 0)>(vb); f.h3 = tr_read<v_rd_off(D0, 3, 1)>(vb);
}
DI void pv_mma(f32x16& od, const VFrag& f, bf16x8 pa0, bf16x8 pa1, bf16x8 pa2, bf16x8 pa3) {
#define PKV(L, H) (bf16x8){L[0], L[1], L[2], L[3], H[0], H[1], H[2], H[3]}
    od = __builtin_amdgcn_mfma_f32_32x32x16_bf16(pa0, PKV(f.l0, f.h0), od, 0, 0, 0);
    od = __builtin_amdgcn_mfma_f32_32x32x16_bf16(pa1, PKV(f.l1, f.h1), od, 0, 0, 0);
    od = __builtin_amdgcn_mfma_f32_32x32x16_bf16(pa2, PKV(f.l2, f.h2), od, 0, 0, 0);
    od = __builtin_amdgcn_mfma_f32_32x32x16_bf16(pa3, PKV(f.l3, f.h3), od, 0, 0, 0);
#undef PKV
}
DI void pv_all(f32x16* o, int vb, bf16x8 pa0, bf16x8 pa1, bf16x8 pa2, bf16x8 pa3) {
    VFrag fa, fb;
    v_read<0>(fa, vb);
    v_read<1>(fb, vb); asm volatile("s_waitcnt lgkmcnt(8)" ::: "memory"); SBAR(); pv_mma(o[0], fa, pa0, pa1, pa2, pa3); SBAR();
    v_read<2>(fa, vb); asm volatile("s_waitcnt lgkmcnt(8)" ::: "memory"); SBAR(); pv_mma(o[1], fb, pa0, pa1, pa2, pa3); SBAR();
    v_read<3>(fb, vb); asm volatile("s_waitcnt lgkmcnt(8)" ::: "memory"); SBAR(); pv_mma(o[2], fa, pa0, pa1, pa2, pa3); SBAR();
    asm volatile("s_waitcnt lgkmcnt(0)" ::: "memory"); SBAR(); pv_mma(o[3], fb, pa0, pa1, pa2, pa3);
}
template <int DPE, int ABL = 0>
DI void attn_unit(LAS unsigned char* lds, const bf16* Qrow, const bf16* Kn, int ldk, const bf16* Kp, const bf16* Vh, int ldv, bf16* Ow, int ldo,
                  int NT, int wnt, bool active, float scale, const float* g_nope, const float* g_pe, const float* ctab, const float* stab, int pos, int tid) {
    const int wid = __builtin_amdgcn_readfirstlane(tid >> 6), lane = tid & 63, r32 = lane & 31, hi = lane >> 5;
    LAS float* li_l = (LAS float*)(lds + WSOFF) + wid * 64; LAS float* al_l = li_l + 32;
    const float C = scale * 1.4426950408889634f;
    constexpr int NQ = 8 + DPE / 16;
    bf16x8 qr[8];
    LAS unsigned char* qpl = lds + QPOFF + wid * 4096 + lane * 16;
    if (active) {
        const bf16* Qw = Qrow + hi * 8;
        if constexpr (DPE == 64) {
            float pe[4][8]; float sp = 0.f;
#pragma unroll
            for (int db = 0; db < 4; ++db) { const u32x4 rw = *(const u32x4*)(Qw + 128 + db * 16); unpack8(rw, pe[db]);
#pragma unroll
                for (int j = 0; j < 8; ++j) sp += pe[db][j] * pe[db][j]; }
            sp += __shfl_xor(sp, 32);
            const float rp = __builtin_amdgcn_rsqf(sp * (1.0f / 64.0f) + EPS);
#pragma unroll
            for (int db = 0; db < 2; ++db) { const int i0 = db * 16 + hi * 8; float o1[8], o2[8];
#pragma unroll
                for (int j = 0; j < 8; ++j) { const float x1 = pe[db][j] * rp * g_pe[i0 + j], x2 = pe[db + 2][j] * rp * g_pe[32 + i0 + j];
                    const float cj = ctab[pos * 32 + i0 + j], sj = stab[pos * 32 + i0 + j]; o1[j] = x1 * cj - x2 * sj; o2[j] = x1 * sj + x2 * cj; }
                const u32x4 w1 = pack8(o1), w2 = pack8(o2); *(LAS u32x4*)(qpl + 1024 * db) = w1; *(LAS u32x4*)(qpl + 1024 * (2 + db)) = w2; }
            asm volatile("" ::: "memory");
        }
        float sq = 0.f; u32x4 raw[8];
#pragma unroll
        for (int d0 = 0; d0 < 8; ++d0) raw[d0] = *(const u32x4*)(Qw + d0 * 16);
#pragma unroll
        for (int d0 = 0; d0 < 8; ++d0) { float f[8]; unpack8(raw[d0], f);
#pragma unroll
            for (int j = 0; j < 8; ++j) sq += f[j] * f[j]; }
        sq += __shfl_xor(sq, 32);
        const float rs = __builtin_amdgcn_rsqf(sq * (1.0f / 128.0f) + EPS);
#pragma unroll
        for (int d0 = 0; d0 < 8; ++d0) { float f[8]; unpack8(raw[d0], f); const int c = d0 * 16 + hi * 8;
            const f32x4 g0 = *(const f32x4*)(g_nope + c), g1 = *(const f32x4*)(g_nope + c + 4);
            f[0] *= rs * g0[0]; f[1] *= rs * g0[1]; f[2] *= rs * g0[2]; f[3] *= rs * g0[3]; f[4] *= rs * g1[0]; f[5] *= rs * g1[1]; f[6] *= rs * g1[2]; f[7] *= rs * g1[3];
            const u32x4 w = pack8(f); qr[d0] = __builtin_bit_cast(bf16x8, w); }
    } else {
#pragma unroll
        for (int d0 = 0; d0 < 8; ++d0) qr[d0] = (bf16x8){0, 0, 0, 0, 0, 0, 0, 0};
    }
    int offK[2], offV[2], offP;
#pragma unroll
    for (int i = 0; i < 2; ++i) { const int ob = i * 8192 + wid * 1024 + lane * 16;
        { const int row = ob >> 8, cb = (ob & 255) ^ ((row & 7) << 4); offK[i] = row * ldk * 2 + cb; }
        { const int sub = ob >> 9, kk = (sub >> 2) * 8 + ((ob & 511) >> 6), k = (kk & ~0xC) | ((kk & 4) << 1) | ((kk & 8) >> 1), cc = (sub & 3) * 32 + ((ob & 63) >> 1); offV[i] = k * ldv * 2 + cc * 2; } }
    { const int ob = wid * 1024 + lane * 16, row = ob >> 7, cb = (ob & 127) ^ ((row & 7) << 4); offP = row * 128 + cb; }
    const int vb0 = (int)(uintptr_t)(lds + SHM_K) + v_rd_base(lane);
    const int sw_ = (r32 & 7) << 4;
    const int ka0 = r32 * 256 + ((0 * 32 + hi * 16) ^ sw_), ka1 = r32 * 256 + ((1 * 32 + hi * 16) ^ sw_), ka2 = r32 * 256 + ((2 * 32 + hi * 16) ^ sw_), ka3 = r32 * 256 + ((3 * 32 + hi * 16) ^ sw_);
    const int pa_0 = r32 * 128 + ((0 * 32 + hi * 16) ^ sw_), pa_1 = r32 * 128 + ((1 * 32 + hi * 16) ^ sw_), pa_2 = r32 * 128 + ((2 * 32 + hi * 16) ^ sw_), pa_3 = r32 * 128 + ((3 * 32 + hi * 16) ^ sw_);
#define STAGE(j_, b_) do { const size_t k0_ = (size_t)(j_) * 64; const char* kb_ = (const char*)Kn + k0_ * ldk * 2; const char* vbp_ = (const char*)Vh + k0_ * ldv * 2; LAS unsigned char* bb_ = lds + (b_) * BUF + wid * 1024; \
        __builtin_amdgcn_global_load_lds((const unsigned*)(kb_ + offK[0]), (LAS unsigned*)(bb_), 16, 0, 0); __builtin_amdgcn_global_load_lds((const unsigned*)(kb_ + offK[1]), (LAS unsigned*)(bb_ + 8192), 16, 0, 0); \
        __builtin_amdgcn_global_load_lds((const unsigned*)(vbp_ + offV[0]), (LAS unsigned*)(bb_ + SHM_K), 16, 0, 0); __builtin_amdgcn_global_load_lds((const unsigned*)(vbp_ + offV[1]), (LAS unsigned*)(bb_ + SHM_K + 8192), 16, 0, 0); \
        if constexpr (DPE == 64) __builtin_amdgcn_global_load_lds((const unsigned*)((const char*)Kp + k0_ * 128 + offP), (LAS unsigned*)(bb_ + SHM_K + SHM_V), 16, 0, 0); } while (0)
    constexpr int NLD = DPE == 64 ? 5 : 4;
#define STAGE_WAIT1() do { if constexpr (NLD == 5) asm volatile("s_waitcnt vmcnt(5)" ::: "memory"); else asm volatile("s_waitcnt vmcnt(4)" ::: "memory"); __builtin_amdgcn_s_barrier(); asm volatile("" ::: "memory"); } while (0)
#define STAGE_WAIT0() do { asm volatile("s_waitcnt vmcnt(0)" ::: "memory"); __builtin_amdgcn_s_barrier(); asm volatile("" ::: "memory"); } while (0)
    if constexpr (ABL != 4) { STAGE(0, 0); if (NT > 1) STAGE(1, 1); } if (NT > 1) STAGE_WAIT1(); else STAGE_WAIT0();
    float m_reg = -1e30f, l_reg = 0.f; f32x16 o[4];
#pragma unroll
    for (int d = 0; d < 4; ++d)
#pragma unroll
        for (int r = 0; r < 16; ++r) o[d][r] = 0.f;
    const float thr_raw = 8.0f / scale;
    int buf = 0;
    for (int j = 0; j < NT; ++j) {
        const int bn2 = buf == 0 ? 2 : buf - 1;
        if constexpr (ABL != 4) { if (j + 2 < NT) STAGE(j + 2, bn2); }
        if (active && j < wnt) {
            const LAS unsigned char* Ks = lds + buf * BUF; const LAS unsigned char* Ps = Ks + SHM_K + SHM_V;
            f32x16 p0, p1;
#pragma unroll
            for (int r = 0; r < 16; ++r) { p0[r] = 0.f; p1[r] = 0.f; }
            if constexpr (ABL != 3) {
            const int kbo = (int)(uintptr_t)Ks;
            bf16x8 fa0, fa1, fb0, fb1;
#define KRD(dst, addr, off) asm volatile("ds_read_b128 %0, %1 offset:%2" : "=&v"(dst) : "v"(addr), "i"(off) : "memory")
#define KRD2(f0, f1, ka_, m_) do { KRD(f0, kbo + ka_, (m_) * 128); KRD(f1, kbo + ka_, (m_) * 128 + 8192); } while (0)
#define KMMA(f0, f1, q_) do { p0 = __builtin_amdgcn_mfma_f32_32x32x16_bf16(f0, q_, p0, 0, 0, 0); p1 = __builtin_amdgcn_mfma_f32_32x32x16_bf16(f1, q_, p1, 0, 0, 0); } while (0)
#define KWAIT(n_) do { asm volatile("s_waitcnt lgkmcnt(" #n_ ")" ::: "memory"); SBAR(); } while (0)
            KRD2(fa0, fa1, ka0, 0); KRD2(fb0, fb1, ka1, 0);
            KWAIT(2); KMMA(fa0, fa1, qr[0]); SBAR(); KRD2(fa0, fa1, ka2, 0);
            KWAIT(2); KMMA(fb0, fb1, qr[1]); SBAR(); KRD2(fb0, fb1, ka3, 0);
            KWAIT(2); KMMA(fa0, fa1, qr[2]); SBAR(); KRD2(fa0, fa1, ka0, 1);
            KWAIT(2); KMMA(fb0, fb1, qr[3]); SBAR(); KRD2(fb0, fb1, ka1, 1);
            KWAIT(2); KMMA(fa0, fa1, qr[4]); SBAR(); KRD2(fa0, fa1, ka2, 1);
            KWAIT(2); KMMA(fb0, fb1, qr[5]); SBAR(); KRD2(fb0, fb1, ka3, 1);
            if constexpr (DPE == 64) {
                const int pbo = (int)(uintptr_t)Ps; const int qpo = (int)(uintptr_t)qpl; bf16x8 qfa, qfb;
#define PRD3(f0, f1, qf, pa_, d_) do { KRD(f0, pbo + pa_, 0); KRD(f1, pbo + pa_, 4096); KRD(qf, qpo, (d_) * 1024); } while (0)
                KWAIT(2); KMMA(fa0, fa1, qr[6]); SBAR(); PRD3(fa0, fa1, qfa, pa_0, 0);
                KWAIT(3); KMMA(fb0, fb1, qr[7]); SBAR(); PRD3(fb0, fb1, qfb, pa_1, 1);
                KWAIT(3); KMMA(fa0, fa1, qfa); SBAR(); PRD3(fa0, fa1, qfa, pa_2, 2);
                KWAIT(3); KMMA(fb0, fb1, qfb); SBAR(); PRD3(fb0, fb1, qfb, pa_3, 3);
                KWAIT(3); KMMA(fa0, fa1, qfa); SBAR();
                KWAIT(0); KMMA(fb0, fb1, qfb);
#undef PRD3
            } else {
                KWAIT(2); KMMA(fa0, fa1, qr[6]); SBAR();
                KWAIT(0); KMMA(fb0, fb1, qr[7]);
            }
#undef KRD
#undef KRD2
#undef KMMA
#undef KWAIT
            } else { asm volatile("" : "+v"(p0), "+v"(p1)); }
            float alpha = 1.f;
            if constexpr (ABL != 1) {
            float pmax = p0[0];
#pragma unroll
            for (int r = 1; r < 16; ++r) pmax = fmaxf(pmax, p0[r]);
#pragma unroll
            for (int r = 0; r < 16; ++r) pmax = fmaxf(pmax, p1[r]);
            { auto rr = __builtin_amdgcn_permlane32_swap(__float_as_uint(pmax), __float_as_uint(pmax), false, false); pmax = fmaxf(__uint_as_float(rr[0]), __uint_as_float(rr[1])); }
            float mn;
            if (__all(pmax - m_reg <= thr_raw)) { mn = m_reg; alpha = 1.f; }
            else { mn = fmaxf(m_reg, pmax); alpha = __builtin_amdgcn_exp2f((m_reg - mn) * C); m_reg = mn; }
            const float mnC = -mn * C;
#pragma unroll
            for (int r = 0; r < 16; ++r) { p0[r] = __builtin_amdgcn_exp2f(fmaf(p0[r], C, mnC)); p1[r] = __builtin_amdgcn_exp2f(fmaf(p1[r], C, mnC)); }
            float ps = 0.f;
#pragma unroll
            for (int r = 0; r < 16; ++r) ps += p0[r] + p1[r];
            { auto rr = __builtin_amdgcn_permlane32_swap(__float_as_uint(ps), __float_as_uint(ps), false, false); ps = __uint_as_float(rr[0]) + __uint_as_float(rr[1]); }
            l_reg = l_reg * alpha + ps;
            }
            bf16x8 pa0, pa1, pa2, pa3;
#define PK4(P, BASE, OUT) do { unsigned a0 = pkbf(P[BASE + 0], P[BASE + 1]), a1 = pkbf(P[BASE + 2], P[BASE + 3]); \
        unsigned b0_ = pkbf(P[BASE + 4], P[BASE + 5]), b1_ = pkbf(P[BASE + 6], P[BASE + 7]); \
        auto r0 = __builtin_amdgcn_permlane32_swap(a0, b0_, false, false); auto r1 = __builtin_amdgcn_permlane32_swap(a1, b1_, false, false); \
        u32x4 w_ = {r0[0], r1[0], r0[1], r1[1]}; OUT = __builtin_bit_cast(bf16x8, w_); } while (0)
            PK4(p0, 0, pa0); PK4(p0, 8, pa1); PK4(p1, 0, pa2); PK4(p1, 8, pa3);
#undef PK4
            if (__any(alpha < 1.f)) { if (hi == 0) al_l[r32] = alpha; asm volatile("s_waitcnt lgkmcnt(0)" ::: "memory");
#pragma unroll
                for (int r = 0; r < 16; ++r) { const float a = al_l[crow(r, hi)];
#pragma unroll
                    for (int d = 0; d < 4; ++d) o[d][r] *= a; } }
            const int vb = vb0 + buf * BUF;
            if constexpr (ABL != 2) pv_all(o, vb, pa0, pa1, pa2, pa3); else asm volatile("" :: "v"(pa0), "v"(pa1), "v"(pa2), "v"(pa3), "v"(vb));
        }
        asm volatile("s_waitcnt lgkmcnt(0)" ::: "memory");
        if (j + 2 < NT) STAGE_WAIT1(); else STAGE_WAIT0();
        buf = buf == 2 ? 0 : buf + 1;
    }
#undef STAGE
#undef STAGE_WAIT0
#undef STAGE_WAIT1
    if (active) {
        if (hi == 0) li_l[r32] = l_reg;
        asm volatile("s_waitcnt lgkmcnt(0)" ::: "memory");
        int le = lane; asm volatile("" : "+v"(le));
        const int r32e = le & 31, hie = le >> 5;
        bf16* Owl = Ow + r32e;
#pragma unroll
        for (int r = 0; r < 16; ++r) { const int orow = crow(r, hie); const float rl = __builtin_amdgcn_rcpf(li_l[orow]); bf16* orp = Owl + (size_t)orow * ldo;
#pragma unroll
            for (int d0 = 0; d0 < 4; ++d0) orp[d0 * 32] = f2bf(o[d0][r] * rl); }
    }
    __syncthreads();
}
}

namespace ssd {
constexpr int RSC = 272, RSX = 144;
constexpr int CS = 0, BS = CS + 64 * RSC, XD = BS + 64 * RSC, XW = XD + 64 * RSX, TSET = XW + 64 * RSX, LS = 2 * TSET, HS = LS + 64 * RSX, HSET = 64 * RSC, END = HS + 2 * HSET;
typedef short v4i16_t __attribute__((ext_vector_type(4)));
DI s16x4 vtr(const LAS unsigned char* p) { return __builtin_bit_cast(s16x4, __builtin_amdgcn_ds_read_tr16_b64_v4i16((LAS v4i16_t*)p)); }
DI bf16x8 tr_frag(const LAS unsigned char* tile, int rsb, int jb, int col0, int lane) {
    const int g = lane >> 4, q = (lane & 15) >> 2, pp = lane & 3;
    const LAS unsigned char* a = tile + (jb + 8 * g + q) * rsb + (col0 + 4 * pp) * 2;
    const s16x4 lo = vtr(a), hi = vtr(a + 4 * rsb);
    return (bf16x8){lo[0], lo[1], lo[2], lo[3], hi[0], hi[1], hi[2], hi[3]};
}
DI bf16x8 row_frag(const LAS unsigned char* tile, int rsb, int row, int k0, int lane) {
    return *(const LAS bf16x8*)(tile + row * rsb + (k0 + 8 * (lane >> 4)) * 2);
}
DI float wave_iscan(float v) {
#define SSD_DPP_ADD(ctrl_, rmask_) v += __builtin_bit_cast(float, __builtin_amdgcn_update_dpp(0, __builtin_bit_cast(int, v), (ctrl_), (rmask_), 0xf, false))
    SSD_DPP_ADD(0x111, 0xf); SSD_DPP_ADD(0x112, 0xf); SSD_DPP_ADD(0x114, 0xf); SSD_DPP_ADD(0x118, 0xf);
    SSD_DPP_ADD(0x142, 0xa);
    SSD_DPP_ADD(0x143, 0xc);
#undef SSD_DPP_ADD
    return v;
}
#define MFMA16(a, b, c) __builtin_amdgcn_mfma_f32_16x16x32_bf16((a), (b), (c), 0, 0, 0)

DI void ssd_unit(LAS unsigned char* lds, const bf16* XBC, const float* DT, const bf16* PROJ, bf16* YG, int rb, int NC, int h, float A, float Dsk, const float* h0, float* hout, int tid) {
    const int wid = tid >> 6, lane = tid & 63, l15 = lane & 15, quad = lane >> 4;
    const int g = h >> 2;
    const int pbk = wid & 3, nb0 = 4 * (wid >> 2);
    f32x4 hacc[4];
#pragma unroll
    for (int t = 0; t < 4; ++t) {
        hacc[t] = h0 ? *(const f32x4*)(h0 + (16 * pbk + l15) * 128 + 16 * (nb0 + t) + 4 * quad) : (f32x4){0.f, 0.f, 0.f, 0.f};
        u32x2 w; w.x = pkbf(hacc[t][0], hacc[t][1]); w.y = pkbf(hacc[t][2], hacc[t][3]);
        *(LAS u32x2*)(lds + HS + (16 * pbk + l15) * RSC + (16 * (nb0 + t) + 4 * quad) * 2) = w;
    }
    const int srow = tid >> 3, sc16 = (tid & 7) * 16, sc8 = (tid & 7) * 8;
    u32x4 rC0, rC1, rB0, rB1, rX; float rdt;
#define SSD_LOAD(c_) do { const size_t row_ = (size_t)rb + (size_t)(c_) * 64 + srow; const bf16* xr_ = XBC + row_ * 4096; \
        rX = *(const u32x4*)(xr_ + h * 64 + sc8); rB0 = *(const u32x4*)(xr_ + 2048 + g * 128 + sc16); rB1 = *(const u32x4*)(xr_ + 2048 + g * 128 + sc16 + 8); \
        rC0 = *(const u32x4*)(xr_ + 3072 + g * 128 + sc16); rC1 = *(const u32x4*)(xr_ + 3072 + g * 128 + sc16 + 8); \
        rdt = DT[((size_t)rb + (size_t)(c_) * 64 + lane) * 32 + h]; } while (0)
#define SSD_STAGE(ts_, acn_, atn_) do { acn_ = rdt * A; \
        acn_ = wave_iscan(acn_); \
        atn_ = __builtin_bit_cast(float, __builtin_amdgcn_readlane(__builtin_bit_cast(int, acn_), 63)); const float dtj_ = __shfl(rdt, srow), acj_ = __shfl(acn_, srow), wj_ = __expf(atn_ - acj_); \
        LAS unsigned char* tb_ = lds + (ts_) * TSET; \
        *(LAS u32x4*)(tb_ + CS + srow * RSC + sc16 * 2) = rC0; *(LAS u32x4*)(tb_ + CS + srow * RSC + sc16 * 2 + 16) = rC1; \
        *(LAS u32x4*)(tb_ + BS + srow * RSC + sc16 * 2) = rB0; *(LAS u32x4*)(tb_ + BS + srow * RSC + sc16 * 2 + 16) = rB1; \
        { float f_[8], fw_[8]; unpack8(rX, f_); _Pragma("unroll") for (int j_ = 0; j_ < 8; ++j_) { f_[j_] *= dtj_; fw_[j_] = f_[j_] * wj_; } \
          *(LAS u32x4*)(tb_ + XD + srow * RSX + sc8 * 2) = pack8(f_); *(LAS u32x4*)(tb_ + XW + srow * RSX + sc8 * 2) = pack8(fw_); } } while (0)
    float ac, atot;
    SSD_LOAD(0);
    SSD_STAGE(0, ac, atot);
    if (NC > 1) SSD_LOAD(1);
    __syncthreads();
    const int ib = wid >> 1;
    u32x2 ngx[2], ngz[2];
#define SSD_GLOAD(c_) do { const size_t gr_ = (size_t)rb + (size_t)(c_) * 64 + 16 * ib + l15; _Pragma("unroll") for (int pt = 0; pt < 2; ++pt) { const int p0 = 16 * (2 * (wid & 1) + pt) + 4 * quad; \
        ngx[pt] = *(const u32x2*)(XBC + gr_ * 4096 + h * 64 + p0); ngz[pt] = *(const u32x2*)(PROJ + gr_ * NIN + PC_Z + h * 64 + p0); } } while (0)
    SSD_GLOAD(0);
    for (int c = 0; c < NC; ++c) {
        const int row0 = rb + c * 64, ts = c & 1;
        const LAS unsigned char* T = lds + ts * TSET;
        const LAS unsigned char* Hc = lds + HS + ts * HSET; LAS unsigned char* Hn = lds + HS + (ts ^ 1) * HSET;
        const int i = 16 * ib + l15; const float ac_i = __shfl(ac, i);
        u32x2 gx[2], gz[2];
#pragma unroll
        for (int pt = 0; pt < 2; ++pt) { gx[pt] = ngx[pt]; gz[pt] = ngz[pt]; }
        if (c + 1 < NC) SSD_GLOAD(c + 1);
        bf16x8 cf[4];
#pragma unroll
        for (int s = 0; s < 4; ++s) cf[s] = row_frag(T + CS, RSC, 16 * ib + l15, 32 * s, lane);
#pragma unroll
        for (int jt = 0; jt < 2; ++jt) {
            const int jb = 2 * (wid & 1) + jt; u32x2 w = {0u, 0u};
            if (jb <= ib) {
                f32x4 acc = {0.f, 0.f, 0.f, 0.f};
#pragma unroll
                for (int s = 0; s < 4; ++s) acc = MFMA16(row_frag(T + BS, RSC, 16 * jb + l15, 32 * s, lane), cf[s], acc);
                float v[4];
#pragma unroll
                for (int r = 0; r < 4; ++r) { const int j = 16 * jb + 4 * quad + r; const float ac_j = __shfl(ac, j); v[r] = (j <= i) ? acc[r] * __expf(ac_i - ac_j) : 0.f; }
                w.x = pkbf(v[0], v[1]); w.y = pkbf(v[2], v[3]);
            }
            *(LAS u32x2*)(lds + LS + i * RSX + (16 * jb + 4 * quad) * 2) = w;
        }
        float acn = 0.f, atn = 0.f;
        if (c + 1 < NC) { SSD_STAGE(ts ^ 1, acn, atn); if (c + 2 < NC) SSD_LOAD(c + 2); }
        __syncthreads();
        const float ei = __expf(ac_i);
        bf16x8 lf[2];
#pragma unroll
        for (int s = 0; s < 2; ++s) if (32 * s <= 16 * ib + 15) lf[s] = row_frag(lds + LS, RSX, 16 * ib + l15, 32 * s, lane);
#pragma unroll
        for (int pt = 0; pt < 2; ++pt) {
            const int pb = 2 * (wid & 1) + pt; f32x4 y = {0.f, 0.f, 0.f, 0.f};
#pragma unroll
            for (int s = 0; s < 4; ++s) y = MFMA16(row_frag(Hc, RSC, 16 * pb + l15, 32 * s, lane), cf[s], y);
            y *= ei;
#pragma unroll
            for (int s = 0; s < 2; ++s) if (32 * s <= 16 * ib + 15) y = MFMA16(tr_frag(T + XD, RSX, 32 * s, 16 * pb, lane), lf[s], y);
            const float x0 = bf_lo(gx[pt].x), x1 = bf_hi(gx[pt].x), x2 = bf_lo(gx[pt].y), x3 = bf_hi(gx[pt].y);
            const float z0 = bf_lo(gz[pt].x), z1 = bf_hi(gz[pt].x), z2 = bf_lo(gz[pt].y), z3 = bf_hi(gz[pt].y);
            u32x2 w; w.x = pkbf((y[0] + Dsk * x0) * silu_f(z0), (y[1] + Dsk * x1) * silu_f(z1)); w.y = pkbf((y[2] + Dsk * x2) * silu_f(z2), (y[3] + Dsk * x3) * silu_f(z3));
            *(u32x2*)(YG + (size_t)(row0 + i) * 2048 + h * 64 + 16 * pb + 4 * quad) = w;
        }
        const float et = __expf(atot);
#pragma unroll
        for (int t = 0; t < 4; ++t) hacc[t] *= et;
#pragma unroll
        for (int s = 0; s < 2; ++s) {
            const bf16x8 xf = tr_frag(T + XW, RSX, 32 * s, 16 * pbk, lane);
#pragma unroll
            for (int t = 0; t < 4; ++t) hacc[t] = MFMA16(tr_frag(T + BS, RSC, 32 * s, 16 * (nb0 + t), lane), xf, hacc[t]);
        }
#pragma unroll
        for (int t = 0; t < 4; ++t) { u32x2 w; w.x = pkbf(hacc[t][0], hacc[t][1]); w.y = pkbf(hacc[t][2], hacc[t][3]);
            *(LAS u32x2*)(Hn + (16 * pbk + l15) * RSC + (16 * (nb0 + t) + 4 * quad) * 2) = w; }
        ac = acn; atot = atn;
        __syncthreads();
    }
#undef SSD_LOAD
#undef SSD_STAGE
#undef SSD_GLOAD
#pragma unroll
    for (int t = 0; t < 4; ++t) *(f32x4*)(hout + (16 * pbk + l15) * 128 + 16 * (nb0 + t) + 4 * quad) = hacc[t];
}
}

#ifndef PHMASK
#define PHMASK 0xFFFFFFF
#endif
#define PHON(k) (((PHMASK) >> (k)) & 1)
#ifndef PHREP
#define PHREP 0
#endif
#ifndef PG8_SP2V
#define PG8_SP2V true
#endif
#define NREP(k) (1 + (((PHREP) >> (k)) & 1))
__global__ void __launch_bounds__(512, 2) mk_fwd(Args args) {
    {
        LAS unsigned char* lds0 = (LAS unsigned char*)lds_raw;
        for (int u = threadIdx.x; u < (LDS_BYTES - RING_BYTES) / 4; u += 512) ((LAS unsigned*)(lds0 + RING_BYTES))[u] = 0u;
        __syncthreads();
    }
    const int lo = args.ph_lo, hi = args.ph_hi;
    const bool multi = (hi - lo) > 1;
    unsigned* const barw = (unsigned*)(args.ws + WS_CTL) + CW_BAR;
    XcdBarrier bar; bar.bar = barw; bar.x = 0; bar.st = nullptr;
    if (multi) bar = xcd_barrier_post(barw, (volatile LAS unsigned*)((LAS unsigned char*)lds_raw + MISC_OFF) + 8);
#define IN(k) (lo <= (k) && (k) < hi)
#define SEAM(k) do { if (IN(k) && IN((k) + 1)) xcd_barrier(bar); } while (0)
#define RUN_GEMM(EpiT, Ap, Bp, M_, N_, K_, cid, ...) do { pg8::Gemm g_{(const pg8::bf16_t*)(Ap), (const pg8::bf16_t*)(Bp), M_, N_, K_}; pg8::SplitOrder S_; S_.init(M_, N_, K_, F.G, (cid), EpiT::SPLITK && (K_) >= 8192);     \
        const EpiT E_{__VA_ARGS__}; pg8::gemm_phase<EpiT, pg8::SplitOrder, true, PG8_SP2V>(F.lds, g_, S_, E_); } while (0)
#define SPCNT(k_) ((unsigned*)F.ctl + CW_SPLIT + (l * NPH + (k_)) * 256)
#define SSP(i_) ((float*)F.ctl + CW_SS + (size_t)(i_) * R)

    if (PHON(13) && IN(0)) { const Ctx F = make_ctx(); p_prologue(F); }
    for (int l = 0; l < NLAYER; ++l) {
        const int pb = 1 + NPH * l;
        const bool cv_skip = l > 0 && l + 1 == NLAYER && gridDim.x == 256;
        if (PHON(0) && IN(pb + 0) && !cv_skip) for (int rep_ = 0; rep_ < NREP(0); ++rep_) { if (rep_) xcd_barrier(bar); const Ctx F = make_ctx(); p_convw(F, l); }
        if (!cv_skip) SEAM(pb + 0);
        if (PHON(1) && IN(pb + 1)) for (int rep_ = 0; rep_ < NREP(1); ++rep_) { if (rep_) xcd_barrier(bar);
            { const Ctx F = make_ctx(); unsigned char* ws = F.ws; RUN_GEMM(pg8::EpiScaleBf16, ws + A_XB, ws + W_IN, R, NIN, 4096, F.bid, (pg8::bf16_t*)(ws + A_PROJ), NIN, SSP(3 * l)); }
        }
        SEAM(pb + 1);
        if (PHON(2) && IN(pb + 2)) for (int rep_ = 0; rep_ < NREP(2); ++rep_) { if (rep_) xcd_barrier(bar); const Ctx F = make_ctx(); p_post1(F, l); }
        SEAM(pb + 2);
        if (PHON(3) && IN(pb + 3)) for (int rep_ = 0; rep_ < NREP(3); ++rep_) { if (rep_) xcd_barrier(bar);
            { const Ctx F = make_ctx(); unsigned char* ws = F.ws; RUN_GEMM(pg8::EpiScaleBf16, ws + A_CQN, ws + W_UQ, R, 3072, 1024, F.G - 1 - F.bid, (pg8::bf16_t*)(ws + A_Q), 3072, nullptr); }
            { const Ctx F = make_ctx(); unsigned char* ws = F.ws; RUN_GEMM(pg8::EpiKVNorm, ws + A_CKV, ws + W_UKV, KVROWS, 4096, 512, F.bid, (pg8::bf16_t*)(ws + A_KV), F.in[I_KNN] + l * 128, KVROWS); }
        }
        SEAM(pb + 3);
        if (PHON(5) && IN(pb + 5)) for (int rep_ = 0; rep_ < NREP(5); ++rep_) { if (rep_) xcd_barrier(bar); const int F0g = gridDim.x;
#ifndef NO_SSD
            for (int r2_ = 0; r2_ < NREP(14); ++r2_) {   const Ctx F = make_ctx(); unsigned char* ws = F.ws;
                const bf16* XBC = (const bf16*)(ws + A_XBC); const float* DT = (const float*)(ws + A_DT); const bf16* PROJ = (const bf16*)(ws + A_PROJ); bf16* YG = (bf16*)(ws + A_YG);
                for (int it = F.bid; it < 512; it += F.G) {
                    const int k = it >> 8, u = it & 255, b = u >> 5, h = u & 31;
                    const float A = -__expf(F.in[I_ALOG][l * 32 + h]), Dsk = F.in[I_DSKIP][l * 32 + h];
                    const size_t so = ((size_t)(l * 8 + b) * 32 + h) * 8192;
                    ssd::ssd_unit(F.lds, XBC, DT, PROJ, YG, k ? RP + b * DSEQ : b * SEQ, k ? 1 : SEQ / 64, h, A, Dsk, k ? F.in[I_SSSM] + so : nullptr, F.out + (k ? O_SSM_S : O_SSM_P) + so, F.tid);
                }
            }
#endif
#ifndef NO_ATT
            for (int r2_ = 0; r2_ < NREP(15); ++r2_) {   const Ctx F = make_ctx(); unsigned char* ws = F.ws;
                const bf16* Q = (const bf16*)(ws + A_Q); const bf16* KV = (const bf16*)(ws + A_KV); const bf16* KPE = (const bf16*)(ws + A_KPE); bf16* MIX = (bf16*)(ws + A_MIX);
                const float* ctab = (const float*)(ws + WS_ROPE); const float* stab = ctab + KVS * 32;
                const float* qnn = F.in[I_QNN] + l * 128; const float* qnp = F.in[I_QNP] + l * 64;
                const float scale = 0.07216878364870322f;
                const int wid = F.wave, r32 = F.lane & 31;
                for (int it = F.bid; it < 1280; it += F.G) {
                    const int slot = it >> 8, w = it & 255, xcd = w & 7, r = w >> 3, g = r >> 2, k = r & 3;
                    const bool smp = slot == 4;
                    if (smp && k >= 2) continue;
                    const int bh = (xcd * 8 + g) * 2 + (smp ? k : (slot >> 1));
                    const int qb = (slot & 1) ? k : 7 - k;
                    const int b = bh >> 4, h = bh & 15;
                    const bool act = smp ? wid < 2 : true; const int wo = act ? wid * 32 : 0;
                    const int row0 = smp ? RP + b * DSEQ : b * SEQ + qb * 256; const size_t kr0 = smp ? (size_t)RP + (size_t)b * KVS : (size_t)b * SEQ;
                    const int NT = smp ? KVS / 64 : 4 * qb + 4, wnt = smp ? KVS / 64 : 4 * qb + (wid >> 1) + 1, pos = (smp ? PAST : qb * 256) + wid * 32 + r32;
#if defined(PROBE_ATT_ABL)
                    if (r2_) att::attn_unit<64, PROBE_ATT_ABL>(F.lds, Q + (size_t)(row0 + wo + (act ? r32 : 0)) * 3072 + h * 192, KV + ((size_t)h * KVROWS + kr0) * 256, 256, KPE + kr0 * 64,
                                       KV + ((size_t)h * KVROWS + kr0) * 256 + 128, 256, (bf16*)(ws + A_CQN) + (size_t)wo * 128, 128, NT, wnt, act, scale, qnn, qnp, ctab, stab, pos, F.tid); else
#endif
                    att::attn_unit<64>(F.lds, Q + (size_t)(row0 + wo + (act ? r32 : 0)) * 3072 + h * 192, KV + ((size_t)h * KVROWS + kr0) * 256, 256, KPE + kr0 * 64,
                                       KV + ((size_t)h * KVROWS + kr0) * 256 + 128, 256, MIX + (size_t)(row0 + wo) * 4096 + h * 128, 4096, NT, wnt, act, scale, qnn, qnp, ctab, stab, pos, F.tid);
                }
            }
#endif
            if (rep_ == 0 && F0g == 256 && ((blockIdx.x >> 3) & 3) >= 2) { __syncthreads();     const Ctx F3 = make_ctx(); const int rk = ((F3.bid >> 5) << 4) | ((((F3.bid >> 3) & 3) - 2) << 3) | (F3.bid & 7);
                p_convw_range(F3, l, CV_A0, CV_E3 - CV_A0, l, 0, 0, 0, 128, 8, rk); }
        }
        SEAM(pb + 5);
        if (PHON(6) && IN(pb + 6)) for (int rep_ = 0; rep_ < NREP(6); ++rep_) { if (rep_) xcd_barrier(bar); const Ctx F = make_ctx(); p_gnorm(F, l); }
        SEAM(pb + 6);
        if (PHON(7) && IN(pb + 7)) for (int rep_ = 0; rep_ < NREP(7); ++rep_) { if (rep_) xcd_barrier(bar); const Ctx F = make_ctx(); unsigned char* ws = F.ws;
#if defined(PROBE_NULLEPI)
            if (rep_) RUN_GEMM(pg8::EpiNull, ws + A_MIX, ws + W_O, R, 4096, 4096, F.bid); else
#endif
            RUN_GEMM(pg8::EpiResid, ws + A_MIX, ws + W_O, R, 4096, 4096, F.bid, (float*)nullptr, (pg8::bf16_t*)(ws + A_XB), SSP(3 * l + 1), SPCNT(7), ws + A_KV);
            if (F.G == 256 && F.bid >= 32) { const Ctx F3 = make_ctx(); p_convw_range(F3, l, CV_GU0, CV_GU1 - CV_GU0, l, CV_GU3 + CV_DX, (l + 1 < NLAYER) ? CV_DO : 0, 32, 224, CV_TAILW); } }
        SEAM(pb + 7);
        if (PHON(8) && IN(pb + 8)) for (int rep_ = 0; rep_ < NREP(8); ++rep_) { if (rep_) xcd_barrier(bar); const Ctx F = make_ctx(); unsigned char* ws = F.ws; RUN_GEMM(pg8::EpiScaleBf16, ws + A_XB, ws + W_XQ, R, 512, 4096, F.bid, (pg8::bf16_t*)(ws + A_XQ), 512, SSP(3 * l + 1));
            { const Ctx F2 = make_ctx(); unsigned char* ws2 = F2.ws; pg8::Gemm g2{(const pg8::bf16_t*)(ws2 + A_MB), (const pg8::bf16_t*)(ws2 + W_XKV), 2048, 1024, 4096}; pg8::SplitOrder S2; S2.init(2048, 1024, 4096, F2.G, (F2.bid + F2.G - 132) % F2.G, false);
              const pg8::EpiMemKV E2{(const float*)F2.ctl + CW_SSM, F2.in[I_XNK] + l * 128, F2.out + O_MK_P + (size_t)l * 2048 * 512, F2.out + O_MV_P + (size_t)l * 2048 * 512, (pg8::bf16_t*)(ws2 + A_MEMK), (pg8::bf16_t*)(ws2 + A_MEMV)};
              pg8::gemm_phase<pg8::EpiMemKV, pg8::SplitOrder, true, true>(F2.lds, g2, S2, E2); }
            if (F.G == 256 && F.bid >= 164) { const Ctx F3 = make_ctx(); p_convw_range(F3, l, CV_GU1, CV_GU3 - CV_GU1, l, 0, 0, 164, 92, CV_TAILW); } }
        SEAM(pb + 8);
        if (PHON(9) && IN(pb + 9)) for (int rep_ = 0; rep_ < NREP(9); ++rep_) { if (rep_) xcd_barrier(bar);
            const Ctx F = make_ctx(); unsigned char* ws = F.ws;
            const bf16* XQ = (const bf16*)(ws + A_XQ); const bf16* MEMK = (const bf16*)(ws + A_MEMK); const bf16* MEMV = (const bf16*)(ws + A_MEMV); bf16* XO = (bf16*)(ws + A_XO);
            const float* xnq = F.in[I_XNQ] + l * 128; const float scale = 0.08838834764831845f;
            const int wid = F.wave, r32 = F.lane & 31;
            for (int it = F.bid; it < 512; it += F.G) {
                if (it >= 288) continue;
                const bool smp = it >= 256; const int u = it & 255;
                const int b = smp ? u >> 2 : u >> 5, h = smp ? u & 3 : (u >> 3) & 3, qb = u & 7;
                const bool act = smp ? wid < 2 : true; const int wo = act ? wid * 32 : 0;
                const int row0 = smp ? RP + b * DSEQ : b * SEQ + qb * 256; const size_t mr0 = (size_t)(smp ? 2048 : 0) + (size_t)b * NMEM;
                att::attn_unit<0>(F.lds, XQ + (size_t)(row0 + wo + (act ? r32 : 0)) * 512 + h * 128, MEMK + mr0 * 512 + h * 128, 512, nullptr,
                                  MEMV + mr0 * 512 + h * 128, 512, XO + (size_t)(row0 + wo) * 512 + h * 128, 512, 4, 4, act, scale, xnq, nullptr, nullptr, nullptr, 0, F.tid);
            }
        }
        SEAM(pb + 9);
        if (PHON(10) && IN(pb + 10)) for (int rep_ = 0; rep_ < NREP(10); ++rep_) { if (rep_) xcd_barrier(bar); const Ctx F = make_ctx(); unsigned char* ws = F.ws; RUN_GEMM(pg8::EpiResid, ws + A_XO, ws + W_XO, R, 4096, 512, F.bid, (float*)nullptr, (pg8::bf16_t*)(ws + A_XB), SSP(3 * l + 2), SPCNT(10), ws + A_KV);
            if (F.G == 256 && F.bid >= 32) { const Ctx F3 = make_ctx(); p_convw_range(F3, l, CV_GU3, CV_DX, l, 0, 0, 32, 224, CV_TAILW); } }
        SEAM(pb + 10);
        if (PHON(11) && IN(pb + 11)) for (int rep_ = 0; rep_ < NREP(11); ++rep_) { if (rep_) xcd_barrier(bar); const Ctx F = make_ctx(); unsigned char* ws = F.ws;
#if defined(PROBE_NULLEPI)
            if (rep_) RUN_GEMM(pg8::EpiNull, ws + A_XB, ws + ((l & 1) ? A_WGU2 : W_GU), R, 22016, 4096, F.bid); else
#endif
            RUN_GEMM(pg8::EpiGU, ws + A_XB, ws + ((l & 1) ? A_WGU2 : W_GU), R, 22016, 4096, F.bid, (pg8::bf16_t*)(ws + A_H), SSP(3 * l + 2), SPCNT(11), ws + A_KV);
            if (F.G == 256 && F.bid >= 44) { const Ctx F3 = make_ctx(); const bool more = l + 1 < NLAYER; p_convw_range(F3, l + 1, 0, more ? CV_A0 : 0, l, CV_GU3 + CV_DX + (more ? CV_DO : 0), more ? CV_DG : CV_NITEMS - CV_GU3 - CV_DX, 44, 212, CV_TAILW); } }
        SEAM(pb + 11);
        if (PHON(12) && IN(pb + 12)) for (int rep_ = 0; rep_ < NREP(12); ++rep_) { if (rep_) xcd_barrier(bar); const Ctx F = make_ctx(); unsigned char* ws = F.ws; const bool more = l + 1 < NLAYER;
#if defined(PROBE_NULLEPI)
            if (rep_) RUN_GEMM(pg8::EpiNull, ws + A_H, ws + W_DN, R, 4096, DFF, F.bid); else
#endif
            RUN_GEMM(pg8::EpiResid, ws + A_H, ws + W_DN, R, 4096, DFF, F.bid, more ? (float*)nullptr : F.out + O_Y, (pg8::bf16_t*)(ws + A_XB), SSP(3 * l + 3), SPCNT(12), ws + A_KV); }
        SEAM(pb + 12);
    }
#undef IN
#undef SEAM
#undef RUN_GEMM
#undef SSP
#undef SPCNT
}

#ifndef MK_SPLIT
#define MK_SPLIT 0
#endif
extern "C" void kernel_launch(void* const* d_in, const int* in_sizes, int n_in, void* d_out, int out_size, void* d_ws, size_t ws_size, hipStream_t stream) {
    static int grid = 0;
    if (grid == 0) {
        if (n_in != 38 || out_size < (int)O_END || ws_size < WS_NEED) { fprintf(stderr, "kernel_launch: n_in %d out %d ws %zu (need 38, %zu, >= %zu): nothing launched\n", n_in, out_size, ws_size, (size_t)O_END, (size_t)WS_NEED); grid = -1; return; }
        int dev = 0, cus = 0, per_cu = 0;
        if (hipGetDevice(&dev) != hipSuccess || hipDeviceGetAttribute(&cus, hipDeviceAttributeMultiprocessorCount, dev) != hipSuccess) { grid = -1; return; }
        if (hipFuncSetAttribute((const void*)mk_fwd, hipFuncAttributeMaxDynamicSharedMemorySize, LDS_BYTES) != hipSuccess) { fprintf(stderr, "kernel_launch: hipFuncSetAttribute failed\n"); grid = -1; return; }
        if (hipOccupancyMaxActiveBlocksPerMultiprocessor(&per_cu, (const void*)mk_fwd, 512, LDS_BYTES) != hipSuccess || per_cu < 1) fprintf(stderr, "kernel_launch: occupancy query says %d\n", per_cu);
        (void)hipGetLastError();
        grid = cus;
    }
    if (grid < 0) return;
    if (hipMemsetAsync((char*)d_ws + WS_CTL, 0, CTL_ZERO_BYTES, stream) != hipSuccess) return;
    Args a{};
    for (int i = 0; i < 38; ++i) a.in[i] = (const float*)d_in[i];
    a.out = (float*)d_out; a.ws = (unsigned char*)d_ws;
    constexpr int NPHASE = 1 + NLAYER * NPH;
#if MK_SPLIT
    for (int p = 0; p < NPHASE; ++p) { a.ph_lo = p; a.ph_hi = p + 1; hipLaunchKernelGGL(mk_fwd, dim3(grid), dim3(512), LDS_BYTES, stream, a); }
#else
    a.ph_lo = 0; a.ph_hi = NPHASE; hipLaunchKernelGGL(mk_fwd, dim3(grid), dim3(512), LDS_BYTES, stream, a);
#endif
    const hipError_t le = hipPeekAtLastError();
    if (le != hipSuccess) fprintf(stderr, "kernel_launch: launch failed: %s\n", hipGetErrorName(le));
}
```
